# Optimizing an MI355X kernel written in HIP

```python
import math
import jax, jax.numpy as jnp
from jax import lax
import numpy as np

D_MODEL = 1024
BATCH = 2
SEQ = 8192
DEPTH = 1

GRID_W = 64
CTX_LEN = 256
ATTN_WIDTH = 512
HYENA_WIDTH = 512
MIX_WIDTH = ATTN_WIDTH + HYENA_WIDTH
HEAD_DIM = 64
N_Q_HEADS = ATTN_WIDTH // HEAD_DIM
N_KV_HEADS = 2
Q_PER_KV = N_Q_HEADS // N_KV_HEADS
KV_WIDTH = N_KV_HEADS * HEAD_DIM
HYENA_GROUPS = 8
IN_WIDTH = ATTN_WIDTH + 2 * KV_WIDTH + 3 * HYENA_WIDTH
SHORT_CONV = 3
FILTER_EMB = 33
FILTER_ORDER = 64
DECAY_TARGET = 1e-2
FAST_DECAY_PCT = 0.3
SLOW_DECAY_PCT = 1.5
N_EXPERTS = 16
CAPACITY_FACTOR = 2
D_EXPERT = 2752
ROPE_THETA = 10000.0
Q_BLOCK = 128
EPS = 1e-6

kernel_name = "hybrid_hyena_gqa_ec_moe_dit_layer"

F32 = jnp.float32


def rms_norm(x, g):
    xf = x.astype(F32)
    y = xf * lax.rsqrt(jnp.mean(xf * xf, axis=-1, keepdims=True) + EPS)
    return (y * g.astype(F32)).astype(x.dtype)


def modulate(h, shift, scale):
    return h * (1.0 + scale) + shift


def axial_rope_tables(n):
    rows = n // GRID_W
    row_id, col_id = jnp.meshgrid(jnp.arange(rows, dtype=F32), jnp.arange(GRID_W, dtype=F32), indexing="ij")
    pos = jnp.stack([row_id.reshape(-1), col_id.reshape(-1)], axis=-1)
    quarter = HEAD_DIM // 4
    inv_freq = ROPE_THETA ** (-jnp.arange(quarter, dtype=F32) / quarter)
    ang = pos[..., None] * inv_freq
    return jnp.cos(ang), jnp.sin(ang)


def apply_axial_rope(x, cos, sin):
    B, n, H, d = x.shape
    xf = x.astype(F32).reshape(B, n, H, 2, d // 2)
    x1, x2 = xf[..., : d // 4], xf[..., d // 4:]
    c = cos[:, None]
    s = sin[:, None]
    out = jnp.concatenate([x1 * c - x2 * s, x1 * s + x2 * c], axis=-1)
    return out.reshape(B, n, H, d).astype(x.dtype)


def attend(q, k_all, v_all):
    s = jnp.einsum("bqgrd,bkgd->bgrqk", q, k_all, preferred_element_type=F32) * (HEAD_DIM ** -0.5)
    p = jax.nn.softmax(s, axis=-1).astype(v_all.dtype)
    return jnp.einsum("bgrqk,bkgd->bqgrd", p, v_all)


def latent_attention(q, k, v, kc, vc):
    B, S = q.shape[:2]
    k_all = jnp.concatenate([k, kc], axis=1)
    v_all = jnp.concatenate([v, vc], axis=1)
    nb = S // Q_BLOCK
    qb = q.reshape(B, nb, Q_BLOCK, N_KV_HEADS, Q_PER_KV, HEAD_DIM).transpose(1, 0, 2, 3, 4, 5)
    out = lax.map(lambda qblk: attend(qblk, k_all, v_all), qb)
    return out.transpose(1, 0, 2, 3, 4, 5).reshape(B, S, ATTN_WIDTH)


def context_attention(qc, kc, vc):
    B, L = qc.shape[:2]
    q = qc.reshape(B, L, N_KV_HEADS, Q_PER_KV, HEAD_DIM)
    return attend(q, kc, vc).reshape(B, L, ATTN_WIDTH)


def implicit_filter(L, w1, b1, w2, b2, w3, freq):
    t = jnp.linspace(0.0, 1.0, L, dtype=F32)[:, None]
    bands = (FILTER_EMB - 1) // 2
    w = 2.0 * math.pi * jnp.arange(L, dtype=F32) / L
    f = jnp.linspace(1e-4, bands - 1, bands, dtype=F32)
    fw = w[:, None] * f[None, :]
    z = jnp.concatenate([t, jnp.cos(fw), -jnp.sin(fw)], axis=-1)
    fr = freq.astype(F32)
    h = jnp.sin(fr * (z @ w1.astype(F32) + b1.astype(F32)))
    h = jnp.sin(fr * (h @ w2.astype(F32) + b2.astype(F32)))
    h = h @ w3.astype(F32)
    max_decay = math.log(DECAY_TARGET) / FAST_DECAY_PCT
    min_decay = math.log(DECAY_TARGET) / SLOW_DECAY_PCT
    deltas = jnp.tile(jnp.linspace(min_decay, max_decay, HYENA_WIDTH, dtype=F32), 2)
    h = h * jnp.exp(-t * jnp.abs(deltas))
    h_fwd, h_bwd = h[:, :HYENA_WIDTH], h[:, HYENA_WIDTH:]
    kern = jnp.concatenate([h_fwd, jnp.zeros((1, HYENA_WIDTH), F32), h_bwd[1:][::-1]], axis=0)
    return kern / jnp.sum(jnp.abs(kern), axis=0, keepdims=True)


def hyena_mixer(p, kern, conv_w, conv_b, bias):
    L = p.shape[1]
    C3 = p.shape[-1]
    pad = SHORT_CONV // 2
    pc = lax.conv_general_dilated(p, conv_w[:, None, :].astype(p.dtype), window_strides=(1,),
                                  padding=((pad, pad),), dimension_numbers=("NWC", "WIO", "NWC"),
                                  feature_group_count=C3) + conv_b
    x1, x2, v = jnp.split(pc, 3, axis=-1)
    u = (v * x1).astype(F32)
    U = jnp.fft.rfft(u, n=2 * L, axis=1)
    K = jnp.fft.rfft(kern, axis=0)
    y = jnp.fft.irfft(U * K[None], n=2 * L, axis=1)[:, :L]
    y = (y + u * bias.astype(F32)) * x2.astype(F32)
    return y.astype(p.dtype)


def expert_choice_ffn(h, w_router, w_gate, w_up, w_down):
    B, N, D = h.shape
    cap = CAPACITY_FACTOR * N // N_EXPERTS
    logits = jnp.einsum("bnd,de->ben", h, w_router, preferred_element_type=F32)
    aff = jax.nn.softmax(logits, axis=1)
    gates, idx = lax.top_k(aff, cap)
    xg = jax.vmap(lambda hb, ib: hb[ib])(h, idx)
    a = jnp.einsum("becd,edf->becf", xg, w_gate)
    u = jnp.einsum("becd,edf->becf", xg, w_up)
    y = jnp.einsum("becf,efd->becd", jax.nn.silu(a) * u, w_down)
    y = y * gates[..., None].astype(y.dtype)
    return jax.vmap(lambda ib, yb: jnp.zeros((N, D), yb.dtype).at[ib.reshape(-1)].add(yb.reshape(-1, D)))(idx, y)


def setup_inputs(seed: int = 0) -> dict:
    key = jax.random.key(seed)
    ks = jax.random.split(key, 25)
    nrm = jax.random.normal
    C3 = 3 * HYENA_WIDTH
    return {
        "x": nrm(ks[0], (BATCH, SEQ, D_MODEL), F32),
        "c": nrm(ks[1], (BATCH, D_MODEL), F32),
        "ctx": nrm(ks[2], (BATCH, CTX_LEN, D_MODEL), F32),
        "c_ctx": nrm(ks[3], (D_MODEL,), F32),
        "w_mod": nrm(ks[4], (DEPTH, D_MODEL, 6 * D_MODEL), F32) * (0.5 * D_MODEL ** -0.5),
        "b_mod": nrm(ks[5], (DEPTH, 6 * D_MODEL), F32) * 0.02,
        "norm1_g": 1.0 + 0.02 * nrm(ks[6], (DEPTH, D_MODEL), F32),
        "norm2_g": 1.0 + 0.02 * nrm(ks[7], (DEPTH, D_MODEL), F32),
        "w_in": nrm(ks[8], (DEPTH, D_MODEL, IN_WIDTH), F32) * D_MODEL ** -0.5,
        "w_out": nrm(ks[9], (DEPTH, MIX_WIDTH, D_MODEL), F32) * MIX_WIDTH ** -0.5,
        "q_norm_g": 1.0 + 0.02 * nrm(ks[10], (DEPTH, HEAD_DIM), F32),
        "k_norm_g": 1.0 + 0.02 * nrm(ks[11], (DEPTH, HEAD_DIM), F32),
        "conv_w": nrm(ks[12], (DEPTH, SHORT_CONV, C3), F32) * SHORT_CONV ** -0.5,
        "conv_b": nrm(ks[13], (DEPTH, C3), F32) * 0.02,
        "filt_w1": nrm(ks[14], (DEPTH, FILTER_EMB, FILTER_ORDER), F32) * FILTER_EMB ** -0.5,
        "filt_b1": nrm(ks[15], (DEPTH, FILTER_ORDER), F32) * 0.1,
        "filt_w2": nrm(ks[16], (DEPTH, FILTER_ORDER, FILTER_ORDER), F32) * FILTER_ORDER ** -0.5,
        "filt_b2": nrm(ks[17], (DEPTH, FILTER_ORDER), F32) * 0.1,
        "filt_w3": nrm(ks[18], (DEPTH, FILTER_ORDER, 2 * HYENA_WIDTH), F32) * FILTER_ORDER ** -0.5,
        "filt_freq": 1.0 + 0.1 * nrm(ks[19], (DEPTH, FILTER_ORDER), F32),
        "hyena_bias": nrm(ks[20], (DEPTH, HYENA_WIDTH), F32),
        "w_router": nrm(ks[21], (DEPTH, D_MODEL, N_EXPERTS), F32) * D_MODEL ** -0.5,
        "w_gate": nrm(ks[22], (DEPTH, N_EXPERTS, D_MODEL, D_EXPERT), F32) * D_MODEL ** -0.5,
        "w_up": nrm(ks[23], (DEPTH, N_EXPERTS, D_MODEL, D_EXPERT), F32) * D_MODEL ** -0.5,
        "w_down": nrm(ks[24], (DEPTH, N_EXPERTS, D_EXPERT, D_MODEL), F32) * D_EXPERT ** -0.5,
    }


def reference(x, c, ctx, c_ctx, w_mod, b_mod, norm1_g, norm2_g, w_in, w_out, q_norm_g, k_norm_g,
              conv_w, conv_b, filt_w1, filt_b1, filt_w2, filt_b2, filt_w3, filt_freq, hyena_bias,
              w_router, w_gate, w_up, w_down):
    B, S, _ = x.shape
    Lc = ctx.shape[1]
    cos, sin = axial_rope_tables(S)
    silu_c = jax.nn.silu(c)
    silu_cc = jax.nn.silu(c_ctx)
    splits = [ATTN_WIDTH, ATTN_WIDTH + KV_WIDTH, ATTN_WIDTH + 2 * KV_WIDTH]
    for l in range(DEPTH):
        last = l == DEPTH - 1
        mod = silu_c @ w_mod[l] + b_mod[l]
        mod_c = silu_cc @ w_mod[l] + b_mod[l]
        sh1, sc1, g1, sh2, sc2, g2 = jnp.split(mod[:, None, :], 6, axis=-1)
        csh1, csc1, cg1, csh2, csc2, cg2 = jnp.split(mod_c, 6)
        w_q, w_k, w_v, w_h = jnp.split(w_in[l], splits, axis=1)
        hx = modulate(rms_norm(x, norm1_g[l]), sh1, sc1)
        hc = modulate(rms_norm(ctx, norm1_g[l]), csh1, csc1)
        kc = rms_norm((hc @ w_k).reshape(B, Lc, N_KV_HEADS, HEAD_DIM), k_norm_g[l])
        vc = (hc @ w_v).reshape(B, Lc, N_KV_HEADS, HEAD_DIM)
        q = apply_axial_rope(rms_norm((hx @ w_q).reshape(B, S, N_Q_HEADS, HEAD_DIM), q_norm_g[l]), cos, sin)
        k = apply_axial_rope(rms_norm((hx @ w_k).reshape(B, S, N_KV_HEADS, HEAD_DIM), k_norm_g[l]), cos, sin)
        v = (hx @ w_v).reshape(B, S, N_KV_HEADS, HEAD_DIM)
        attn_x = latent_attention(q, k, v, kc, vc)
        kern_x = implicit_filter(S, filt_w1[l], filt_b1[l], filt_w2[l], filt_b2[l], filt_w3[l], filt_freq[l])
        hy_x = hyena_mixer(hx @ w_h, kern_x, conv_w[l], conv_b[l], hyena_bias[l])
        mix_x = jnp.concatenate([attn_x, hy_x], axis=-1) @ w_out[l]
        if not last:
            qc = rms_norm((hc @ w_q).reshape(B, Lc, N_Q_HEADS, HEAD_DIM), q_norm_g[l])
            attn_c = context_attention(qc, kc, vc)
            kern_c = implicit_filter(Lc, filt_w1[l], filt_b1[l], filt_w2[l], filt_b2[l], filt_w3[l], filt_freq[l])
            hy_c = hyena_mixer(hc @ w_h, kern_c, conv_w[l], conv_b[l], hyena_bias[l])
            ctx = ctx + cg1 * (jnp.concatenate([attn_c, hy_c], axis=-1) @ w_out[l])
            hc2 = modulate(rms_norm(ctx, norm2_g[l]), csh2, csc2)
            ctx = ctx + cg2 * expert_choice_ffn(hc2, w_router[l], w_gate[l], w_up[l], w_down[l])
        x = x + g1 * mix_x
        hx2 = modulate(rms_norm(x, norm2_g[l]), sh2, sc2)
        x = x + g2 * expert_choice_ffn(hx2, w_router[l], w_gate[l], w_up[l], w_down[l])
    return x
```

```cpp
#include <hip/hip_runtime.h>
#include <cstdio>
#include <cstdint>
#include <cmath>

constexpr int DM = 1024, NB = 2, SEQ = 8192, CTXL = 256, LK = SEQ + CTXL;
constexpr int MTOK = NB * SEQ, MCTX = NB * CTXL, MALL = MTOK + MCTX;
constexpr int INW = 2304, NEXP = 16, CAP = 1024, DEXP = 2752, DEXP_P = 2816;
constexpr int NFFT = 16384;
constexpr float EPS = 1e-6f;
constexpr float C2 = 0.125f * 1.4426950408889634f;

typedef unsigned short bf16_t;

constexpr size_t MiB = 1u << 20;
constexpr size_t OFF_CTL = 0, CTL_BYTES = 1 * MiB;
constexpr size_t OFF_MODV = 1 * MiB;
constexpr size_t OFF_ROPE = 1 * MiB + 128 * 1024;
constexpr size_t OFF_H2 = 2 * MiB;
constexpr size_t OFF_AFF = 4 * MiB;
constexpr size_t OFF_INV = 5 * MiB;
constexpr size_t OFF_IDX = 6 * MiB;
constexpr size_t OFF_GATE = 6 * MiB + 128 * 1024;
constexpr size_t OFF_WIN = 8 * MiB, OFF_WOUT = 13 * MiB, OFF_WGU = 16 * MiB, OFF_WD = 192 * MiB;
constexpr size_t OFF_XN2 = 280 * MiB;
constexpr size_t OFF_XN = 312 * MiB;
constexpr size_t OFF_Q = 345 * MiB;
constexpr size_t OFF_K = 361 * MiB;
constexpr size_t OFF_V = 366 * MiB;
constexpr size_t OFF_PT = 371 * MiB;
constexpr size_t OFF_HT = 467 * MiB;
constexpr size_t OFF_H = 312 * MiB;
constexpr size_t OFF_AO = 499 * MiB;
constexpr size_t OFF_HYT = 531 * MiB;
constexpr size_t OFF_Y = 499 * MiB;
constexpr size_t OFF_PROJ = 563 * MiB;
constexpr size_t OFF_KF = 613 * MiB;
constexpr size_t WS_END = 645 * MiB;

struct P {
    const float *x, *c, *ctx, *c_ctx, *w_mod, *b_mod, *n1g, *n2g, *w_in, *w_out, *qng, *kng, *conv_w, *conv_b;
    const float *fw1, *fb1, *fw2, *fb2, *fw3, *ffreq, *hbias, *w_router, *w_gate, *w_up, *w_down;
    float* out; unsigned char* ws;
    double invf[16];
};

#define WSP(T, off) ((T*)(p.ws + (off)))

__device__ __forceinline__ unsigned f2bf(float f) { unsigned u = __float_as_uint(f); return (u + 0x7fffu + ((u >> 16) & 1u)) >> 16; }
__device__ __forceinline__ float bf2f(unsigned h) { return __uint_as_float(h << 16); }
__device__ __forceinline__ unsigned pk2(float lo, float hi) { return f2bf(lo) | (f2bf(hi) << 16); }
__device__ __forceinline__ float hw_sin_rev(float r) { return __builtin_amdgcn_sinf(r); }
__device__ __forceinline__ float hw_cos_rev(float r) { return __builtin_amdgcn_cosf(r); }
__device__ __forceinline__ float wave_sum(float v) {
#pragma unroll
    for (int o = 1; o < 64; o <<= 1) v += __shfl_xor(v, o);
    return v;
}

constexpr int NTHR = 512, NWAVE = 8;
constexpr int LDS_BYTES = 147456;

__device__ __forceinline__ void ph_mod(const P& p, float* lf) {
    const int tid = threadIdx.x, lane = tid & 63, wave = tid >> 6;
    float* sil = lf; float* red = lf + 3072;
    if ((int)blockIdx.x < 96) {
        for (int i = tid; i < 3072; i += NTHR) { const int r = i >> 10, k = i & 1023; const float v = r < 2 ? p.c[r * 1024 + k] : p.c_ctx[k]; sil[i] = v / (1.0f + expf(-v)); }
        __syncthreads();
        float* modv = WSP(float, OFF_MODV);
        for (int item = blockIdx.x; item < 96; item += gridDim.x) {
            const int col = item * 64 + lane, kb = wave * 128;
            float a0 = 0.f, a1 = 0.f, a2 = 0.f;
#pragma unroll 8
            for (int kk = 0; kk < 128; ++kk) { const float w = p.w_mod[(size_t)(kb + kk) * 6144 + col]; a0 += sil[kb + kk] * w; a1 += sil[1024 + kb + kk] * w; a2 += sil[2048 + kb + kk] * w; }
            red[(wave * 3 + 0) * 64 + lane] = a0; red[(wave * 3 + 1) * 64 + lane] = a1; red[(wave * 3 + 2) * 64 + lane] = a2;
            __syncthreads();
            if (wave < 3) { float s = p.b_mod[col];
#pragma unroll
                for (int w2 = 0; w2 < 8; ++w2) s += red[(w2 * 3 + wave) * 64 + lane];
                modv[wave * 6144 + col] = s; }
            __syncthreads();
        }
    }
}
__device__ __forceinline__ void ph_rope(const P& p) {
    float* rope = WSP(float, OFF_ROPE);
    for (int i = blockIdx.x * NTHR + threadIdx.x; i < 2048; i += gridDim.x * NTHR) {
        const int pos = i >> 4, f = i & 15;
        double r = (double)pos * p.invf[f] * 0.15915494309189535; r -= floor(r);
        rope[2 * i] = hw_cos_rev((float)r); rope[2 * i + 1] = hw_sin_rev((float)r);
    }
}
__device__ __forceinline__ void ph_h2(const P& p, float* lf) {
    const int tid = threadIdx.x, lane = tid & 63, wave = tid >> 6;
    float* zf = lf + wave * 40; float* h1 = lf + 8 * 40 + wave * 64;
    float* h2 = WSP(float, OFF_H2);
    const float fr = p.ffreq[lane];
    for (int item = blockIdx.x; item < 1024; item += gridDim.x) {
        const int t = item * 8 + wave;
        if (lane < 33) {
            float z;
            if (lane == 0) z = (float)t / 8191.0f;
            else { const int k = (lane - 1) & 15; const double fk = 1e-4 + (double)k * ((15.0 - 1e-4) / 15.0); double r = (double)t * fk / 8192.0; r -= floor(r);
                   z = lane <= 16 ? hw_cos_rev((float)r) : -hw_sin_rev((float)r); }
            zf[lane] = z;
        }
        __syncthreads();
        float a = p.fb1[lane];
#pragma unroll
        for (int i = 0; i < 33; ++i) a += zf[i] * p.fw1[i * 64 + lane];
        h1[lane] = hw_sin_rev(fr * a * 0.15915494309189535f);
        __syncthreads();
        float b = p.fb2[lane];
#pragma unroll 16
        for (int i = 0; i < 64; ++i) b += h1[i] * p.fw2[i * 64 + lane];
        h2[(size_t)t * 64 + lane] = hw_sin_rev(fr * b * 0.15915494309189535f);
        __syncthreads();
    }
}

__device__ __forceinline__ void ph_xn(const P& p) {
    const int tid = threadIdx.x, lane = tid & 63, wave = tid >> 6;
    const float* modv = WSP(float, OFF_MODV); bf16_t* xn = WSP(bf16_t, OFF_XN);
    for (int row = blockIdx.x * NWAVE + wave; row < MALL; row += gridDim.x * NWAVE) {
        const float* src = row < MTOK ? p.x + (size_t)row * DM : p.ctx + (size_t)(row - MTOK) * DM;
        const float* mv = modv + (row < MTOK ? (row >> 13) : 2) * 6144;
        float4 v[4]; float ss = 0.f;
#pragma unroll
        for (int j = 0; j < 4; ++j) { v[j] = *(const float4*)(src + 4 * lane + 256 * j); ss += v[j].x * v[j].x + v[j].y * v[j].y + v[j].z * v[j].z + v[j].w * v[j].w; }
        const float rstd = rsqrtf(wave_sum(ss) * (1.0f / DM) + EPS);
#pragma unroll
        for (int j = 0; j < 4; ++j) {
            const int c0 = 4 * lane + 256 * j;
            const float4 g = *(const float4*)(p.n1g + c0), sh = *(const float4*)(mv + c0), sc = *(const float4*)(mv + 1024 + c0);
            const float y0 = v[j].x * rstd * g.x * (1.f + sc.x) + sh.x, y1 = v[j].y * rstd * g.y * (1.f + sc.y) + sh.y;
            const float y2 = v[j].z * rstd * g.z * (1.f + sc.z) + sh.z, y3 = v[j].w * rstd * g.w * (1.f + sc.w) + sh.w;
            uint2 o; o.x = pk2(y0, y1); o.y = pk2(y2, y3);
            *(uint2*)(xn + (size_t)row * DM + c0) = o;
        }
    }
}
__device__ __forceinline__ void ph_ht(const P& p) {
    const int tid = threadIdx.x, lane = tid & 63, wave = __builtin_amdgcn_readfirstlane(tid >> 6);
    const float* h2 = WSP(float, OFF_H2); float* ht = WSP(float, OFF_HT);
    const float MIN_D = -3.0701134573253945f, MAX_D = -15.350567286626973f;
    for (int item = blockIdx.x; item < 2048; item += gridDim.x) {
        const int tg = item >> 4, cg = item & 15, t = tg * 64 + lane;
        float h[64];
#pragma unroll
        for (int j = 0; j < 16; ++j) { const float4 q = *(const float4*)(h2 + (size_t)t * 64 + 4 * j); h[4 * j] = q.x; h[4 * j + 1] = q.y; h[4 * j + 2] = q.z; h[4 * j + 3] = q.w; }
        const float tn = (float)t / 8191.0f;
        for (int cc = 0; cc < 8; ++cc) {
            const int col = cg * 64 + wave * 8 + cc;
            float acc = 0.f;
#pragma unroll
            for (int j = 0; j < 64; ++j) acc += h[j] * p.fw3[j * 1024 + col];
            const float dl = MIN_D + (MAX_D - MIN_D) * (float)(col & 511) / 511.0f;
            ht[(size_t)col * 8192 + t] = acc * expf(-tn * fabsf(dl));
        }
    }
}

struct c2 { float x, y; };
__device__ __forceinline__ c2 cmul(c2 a, c2 b) { return c2{a.x * b.x - a.y * b.y, a.x * b.y + a.y * b.x}; }
template <int LOGS> __device__ __forceinline__ void r4_compute(const c2* X, c2 (&y)[8][4], int tid) {
#pragma unroll
    for (int i = 0; i < 8; ++i) {
        const int j = tid + 512 * i;
        const c2 a = X[j], b = X[j + 4096], c = X[j + 8192], d = X[j + 12288];
        const c2 apc{a.x + c.x, a.y + c.y}, amc{a.x - c.x, a.y - c.y}, bpd{b.x + d.x, b.y + d.y}, bmd{b.x - d.x, b.y - d.y};
        const c2 jb{-bmd.y, bmd.x};
        c2 t0{apc.x + bpd.x, apc.y + bpd.y}, t1{amc.x - jb.x, amc.y - jb.y}, t2{apc.x - bpd.x, apc.y - bpd.y}, t3{amc.x + jb.x, amc.y + jb.y};
        if (LOGS < 12) {
            const int ps = (j >> LOGS) << LOGS;
            float r = (float)ps * (1.0f / 16384.0f);
            asm volatile("" : "+v"(r));
            const c2 w1{hw_cos_rev(r), -hw_sin_rev(r)};
            const c2 w2 = cmul(w1, w1), w3 = cmul(w1, w2);
            t1 = cmul(t1, w1); t2 = cmul(t2, w2); t3 = cmul(t3, w3);
        }
        y[i][0] = t0; y[i][1] = t1; y[i][2] = t2; y[i][3] = t3;
    }
}
template <int LOGS> __device__ __forceinline__ void r4_write(c2* X, const c2 (&y)[8][4], int tid) {
    constexpr int S = 1 << LOGS;
#pragma unroll
    for (int i = 0; i < 8; ++i) {
        const int j = tid + 512 * i, q = j & (S - 1), base = 4 * j - 3 * q;
#pragma unroll
        for (int k = 0; k < 4; ++k) X[base + k * S] = y[i][k];
    }
}
#define FFT_PASS(L) do { asm volatile("" : "+v"(tid)); r4_compute<L>(X, y, tid); __syncthreads(); asm volatile("" : "+v"(tid)); r4_write<L>(X, y, tid); __syncthreads(); } while (0)
__device__ __forceinline__ void fft16k(c2* X, c2 (&y)[8][4], int tid) {
    FFT_PASS(0); FFT_PASS(2); FFT_PASS(4); FFT_PASS(6); FFT_PASS(8); FFT_PASS(10);
    asm volatile("" : "+v"(tid));
    r4_compute<12>(X, y, tid);
}
__device__ __forceinline__ float conv3(const float* base, int t, float w0, float w1, float w2, float cb) {
    const float pm = t > 0 ? base[t - 1] : 0.f, pc = base[t], pp = t < SEQ - 1 ? base[t + 1] : 0.f;
    return w0 * pm + w1 * pc + w2 * pp + cb;
}
#define LAUNDER(v) asm volatile("" : "+v"(v))
__device__ __forceinline__ void ph_fft(const P& p, unsigned char* lds) {
    int tid = threadIdx.x; const int lane = tid & 63, wave = tid >> 6;
    c2* X = (c2*)lds; float* red = (float*)(lds + 131072);
    const float* ht = WSP(float, OFF_HT); const float* pt = WSP(float, OFF_PT); bf16_t* hyt = WSP(bf16_t, OFF_HYT);
    for (int ch = blockIdx.x; ch < 512; ch += gridDim.x) {
        LAUNDER(tid);
        const float* hf = ht + (size_t)ch * 8192; const float* hb = ht + (size_t)(512 + ch) * 8192;
        float asum = 0.f;
#pragma unroll 4
        for (int m = 0; m < 32; ++m) {
            const int n = tid + 512 * m; float v;
            if (n < 8192) v = hf[n]; else if (n == 8192) v = 0.f; else v = hb[16384 - n];
            asum += fabsf(v); X[n] = c2{v, 0.f};
        }
        asum = wave_sum(asum); if (lane == 0) red[wave] = asum;
        __syncthreads();
        float tot = 0.f;
#pragma unroll
        for (int w = 0; w < 8; ++w) tot += red[w];
        const float scale = 1.0f / (tot * 16384.0f);
        c2 y[8][4];
        LAUNDER(tid);
        fft16k(X, y, tid);
        LAUNDER(tid);
        c2* kfg = WSP(c2, OFF_KF) + (size_t)blockIdx.x * NFFT + tid;
#pragma unroll
        for (int i = 0; i < 8; ++i) { c2* kq = kfg + i * 2048; asm volatile("" : "+v"(kq));
#pragma unroll
            for (int k = 0; k < 4; ++k) kq[k * 512] = y[i][k]; }
        __syncthreads();
        const float wa0 = p.conv_w[ch], wa1 = p.conv_w[1536 + ch], wa2 = p.conv_w[3072 + ch], ba = p.conv_b[ch];
        const float wx0 = p.conv_w[512 + ch], wx1 = p.conv_w[1536 + 512 + ch], wx2 = p.conv_w[3072 + 512 + ch], bx = p.conv_b[512 + ch];
        const float wv0 = p.conv_w[1024 + ch], wv1 = p.conv_w[1536 + 1024 + ch], wv2 = p.conv_w[3072 + 1024 + ch], bv = p.conv_b[1024 + ch];
        LAUNDER(tid);
        const float* p1 = pt + (size_t)ch * MTOK; const float* px = pt + (size_t)(512 + ch) * MTOK; const float* pv = pt + (size_t)(1024 + ch) * MTOK;
#pragma unroll 2
        for (int m = 0; m < 16; ++m) {
            const int n = tid + 512 * m;
            const float u0 = conv3(pv, n, wv0, wv1, wv2, bv) * conv3(p1, n, wa0, wa1, wa2, ba);
            const float u1 = conv3(pv + SEQ, n, wv0, wv1, wv2, bv) * conv3(p1 + SEQ, n, wa0, wa1, wa2, ba);
            X[n] = c2{u0, u1}; X[n + 8192] = c2{0.f, 0.f};
        }
        __syncthreads();
        LAUNDER(tid);
        fft16k(X, y, tid);
        __syncthreads();
        LAUNDER(tid);
#pragma unroll
        for (int i = 0; i < 8; ++i) { const c2* kq = kfg + i * 2048; asm volatile("" : "+v"(kq));
#pragma unroll
            for (int k = 0; k < 4; ++k) { const c2 w = cmul(y[i][k], kq[k * 512]); X[tid + 512 * i + 4096 * k] = c2{w.x, -w.y}; } }
        __syncthreads();
        LAUNDER(tid);
        fft16k(X, y, tid);
        LAUNDER(tid);
        const float bias = p.hbias[ch];
#pragma unroll
        for (int i = 0; i < 8; ++i)
#pragma unroll
            for (int k = 0; k < 2; ++k) {
                const int t = tid + 512 * i + 4096 * k;
                const float y0 = y[i][k].x * scale, y1 = -y[i][k].y * scale;
                const float u0 = conv3(pv, t, wv0, wv1, wv2, bv) * conv3(p1, t, wa0, wa1, wa2, ba);
                const float u1 = conv3(pv + SEQ, t, wv0, wv1, wv2, bv) * conv3(p1 + SEQ, t, wa0, wa1, wa2, ba);
                const float x20 = conv3(px, t, wx0, wx1, wx2, bx), x21 = conv3(px + SEQ, t, wx0, wx1, wx2, bx);
                hyt[(size_t)ch * MTOK + t] = (bf16_t)f2bf((y0 + u0 * bias) * x20);
                hyt[(size_t)ch * MTOK + SEQ + t] = (bf16_t)f2bf((y1 + u1 * bias) * x21);
                asm volatile("" ::: "memory");
            }
        __syncthreads();
    }
}

__device__ __forceinline__ void ph_hyt(const P& p, unsigned char* lds) {
    const int tid = threadIdx.x;
    bf16_t* tile = (bf16_t*)lds;
    const bf16_t* hyt = WSP(bf16_t, OFF_HYT); bf16_t* ao = WSP(bf16_t, OFF_AO);
    for (int item = blockIdx.x; item < 2048; item += gridDim.x) {
        const int cg = item & 7, mg = item >> 3, c0 = cg * 64, m0 = mg * 64;
        { const int c = tid >> 3, ch = tid & 7; const uint4 v = *(const uint4*)(hyt + (size_t)(c0 + c) * MTOK + m0 + ch * 8); *(uint4*)(tile + c * 72 + ch * 8) = v; }
        __syncthreads();
        { const int m = tid >> 3, ch = tid & 7; unsigned w[4];
#pragma unroll
          for (int k = 0; k < 4; ++k) { const unsigned lo = tile[(ch * 8 + 2 * k) * 72 + m], hi = tile[(ch * 8 + 2 * k + 1) * 72 + m]; w[k] = lo | (hi << 16); }
          uint4 o; o.x = w[0]; o.y = w[1]; o.z = w[2]; o.w = w[3];
          *(uint4*)(ao + (size_t)(m0 + m) * DM + 512 + c0 + ch * 8) = o; }
        __syncthreads();
    }
}

__device__ __forceinline__ void ph_router(const P& p, unsigned char* lds) {
    const int tid = threadIdx.x, lane = tid & 63, wave = tid >> 6;
    float* wt = (float*)lds;
    float* rowb = (float*)(lds + 16 * 1028 * 4);
    const float* modv = WSP(float, OFF_MODV); bf16_t* xn2 = WSP(bf16_t, OFF_XN2); float* aff = WSP(float, OFF_AFF);
    for (int i = tid; i < 16384; i += NTHR) { const int k = i >> 4, e = i & 15; wt[e * 1028 + k] = p.w_router[i]; }
    __syncthreads();
    for (int item = blockIdx.x; item < MTOK / 8; item += gridDim.x) {
        const int row = item * 8 + wave, b = row >> 13, t = row & 8191;
        const float* src = p.out + (size_t)row * DM; const float* mv = modv + b * 6144;
        float4 v[4]; float ss = 0.f;
#pragma unroll
        for (int j = 0; j < 4; ++j) { v[j] = *(const float4*)(src + 4 * lane + 256 * j); ss += v[j].x * v[j].x + v[j].y * v[j].y + v[j].z * v[j].z + v[j].w * v[j].w; }
        const float rstd = rsqrtf(wave_sum(ss) * (1.0f / DM) + EPS);
        float* rb = rowb + wave * 1024;
#pragma unroll
        for (int j = 0; j < 4; ++j) {
            const int c0 = 4 * lane + 256 * j;
            const float4 g = *(const float4*)(p.n2g + c0), sh = *(const float4*)(mv + 3072 + c0), sc = *(const float4*)(mv + 4096 + c0);
            float4 y; y.x = v[j].x * rstd * g.x * (1.f + sc.x) + sh.x; y.y = v[j].y * rstd * g.y * (1.f + sc.y) + sh.y;
            y.z = v[j].z * rstd * g.z * (1.f + sc.z) + sh.z; y.w = v[j].w * rstd * g.w * (1.f + sc.w) + sh.w;
            uint2 o; o.x = pk2(y.x, y.y); o.y = pk2(y.z, y.w);
            *(uint2*)(xn2 + (size_t)row * DM + c0) = o;
            *(float4*)(rb + c0) = y;
        }
        __syncthreads();
        const int e = lane & 15, kq = lane >> 4;
        float acc = 0.f;
#pragma unroll 8
        for (int j = 0; j < 64; ++j) {
            const int k = 16 * j + 4 * kq;
            const float4 xv = *(const float4*)(rb + k), wv = *(const float4*)(wt + e * 1028 + k);
            acc += xv.x * wv.x + xv.y * wv.y + xv.z * wv.z + xv.w * wv.w;
        }
        acc += __shfl_xor(acc, 16); acc += __shfl_xor(acc, 32);
        float mx = acc;
#pragma unroll
        for (int o = 1; o < 16; o <<= 1) mx = fmaxf(mx, __shfl_xor(mx, o));
        const float ex = expf(acc - mx);
        float sm = ex;
#pragma unroll
        for (int o = 1; o < 16; o <<= 1) sm += __shfl_xor(sm, o);
        if (kq == 0) aff[(size_t)(b * 16 + e) * 8192 + t] = ex / sm;
        __syncthreads();
    }
}

__device__ __forceinline__ void ph_topk(const P& p, unsigned char* lds) {
    const int tid = threadIdx.x, lane = tid & 63, wave = tid >> 6;
    unsigned* hist = (unsigned*)lds; unsigned* wtot = hist + 256; unsigned* sel = hist + 272;
    const float* aff = WSP(float, OFF_AFF); int* idx = WSP(int, OFF_IDX); float* gate = WSP(float, OFF_GATE); int* inv = WSP(int, OFF_INV);
    for (int prob = blockIdx.x; prob < 32; prob += gridDim.x) {
        const float* a = aff + (size_t)prob * 8192 + tid * 16;
        float v[16]; unsigned key[16];
#pragma unroll
        for (int j = 0; j < 4; ++j) { const float4 q = *(const float4*)(a + 4 * j); v[4 * j] = q.x; v[4 * j + 1] = q.y; v[4 * j + 2] = q.z; v[4 * j + 3] = q.w; }
#pragma unroll
        for (int i = 0; i < 16; ++i) key[i] = __float_as_uint(v[i]);
        unsigned prefix = 0u, kk = CAP;
#pragma unroll
        for (int pass = 0; pass < 4; ++pass) {
            const int shift = 24 - 8 * pass;
            const unsigned mhi = pass == 0 ? 0u : (0xFFFFFFFFu << (shift + 8));
            if (tid < 256) hist[tid] = 0u;
            __syncthreads();
#pragma unroll
            for (int i = 0; i < 16; ++i) if ((key[i] & mhi) == prefix) atomicAdd(&hist[(key[i] >> shift) & 255u], 1u);
            __syncthreads();
            unsigned h = 0u, s = 0u;
            if (tid < 256) {
                h = hist[tid]; s = h;
#pragma unroll
                for (int o = 1; o < 64; o <<= 1) { const unsigned n = __shfl_down(s, o); if (lane + o < 64) s += n; }
                if (lane == 0) wtot[wave] = s;
            }
            __syncthreads();
            if (tid < 256) {
                for (int w2 = wave + 1; w2 < 4; ++w2) s += wtot[w2];
                const unsigned sex = s - h;
                if (s >= kk && sex < kk) { sel[0] = (unsigned)tid; sel[1] = kk - sex; }
            }
            __syncthreads();
            prefix |= sel[0] << shift; kk = sel[1];
            __syncthreads();
        }
        const unsigned thr = prefix, krem = kk;
        unsigned cnt = 0u;
#pragma unroll
        for (int i = 0; i < 16; ++i) cnt += (key[i] > thr ? 1u : 0u) + (key[i] == thr ? 0x10000u : 0u);
        unsigned inc = cnt;
#pragma unroll
        for (int o = 1; o < 64; o <<= 1) { const unsigned n = __shfl_up(inc, o); if (lane >= o) inc += n; }
        if (lane == 63) wtot[wave] = inc;
        __syncthreads();
        unsigned before = inc - cnt;
        for (int w2 = 0; w2 < wave; ++w2) before += wtot[w2];
        unsigned gtr = before & 0xFFFFu, eqr = before >> 16;
#pragma unroll
        for (int i = 0; i < 16; ++i) {
            const int t = tid * 16 + i;
            const bool g = key[i] > thr, q = key[i] == thr;
            const bool s = g || (q && eqr < krem);
            const unsigned pos = gtr + (eqr < krem ? eqr : krem);
            if (s) { idx[prob * CAP + pos] = t; gate[prob * CAP + pos] = v[i]; }
            inv[(size_t)prob * 8192 + t] = s ? (int)pos : -1;
            gtr += g ? 1u : 0u; eqr += q ? 1u : 0u;
        }
        __syncthreads();
    }
}

__device__ __forceinline__ void ph_combine(const P& p) {
    const int tid = threadIdx.x, lane = tid & 63, wave = tid >> 6;
    const float* modv = WSP(float, OFF_MODV); const int* inv = WSP(int, OFF_INV); const bf16_t* Y = WSP(bf16_t, OFF_Y);
    for (int row = blockIdx.x * NWAVE + wave; row < MTOK; row += gridDim.x * NWAVE) {
        const int b = row >> 13, t = row & 8191;
        const int myinv = lane < 16 ? inv[(size_t)(b * 16 + lane) * 8192 + t] : -1;
        unsigned long long mask = __ballot(myinv >= 0);
        float acc[16];
#pragma unroll
        for (int i = 0; i < 16; ++i) acc[i] = 0.f;
        while (mask) {
            const int e = __ffsll((long long)mask) - 1; mask &= mask - 1;
            const int pos = __shfl(myinv, e);
            const bf16_t* yr = Y + ((size_t)(e * 2048 + b * 1024 + pos)) * DM;
            const uint4 u0 = *(const uint4*)(yr + 8 * lane), u1 = *(const uint4*)(yr + 512 + 8 * lane);
            acc[0] += bf2f(u0.x & 0xFFFFu); acc[1] += bf2f(u0.x >> 16); acc[2] += bf2f(u0.y & 0xFFFFu); acc[3] += bf2f(u0.y >> 16);
            acc[4] += bf2f(u0.z & 0xFFFFu); acc[5] += bf2f(u0.z >> 16); acc[6] += bf2f(u0.w & 0xFFFFu); acc[7] += bf2f(u0.w >> 16);
            acc[8] += bf2f(u1.x & 0xFFFFu); acc[9] += bf2f(u1.x >> 16); acc[10] += bf2f(u1.y & 0xFFFFu); acc[11] += bf2f(u1.y >> 16);
            acc[12] += bf2f(u1.z & 0xFFFFu); acc[13] += bf2f(u1.z >> 16); acc[14] += bf2f(u1.w & 0xFFFFu); acc[15] += bf2f(u1.w >> 16);
        }
        const float* g2 = modv + b * 6144 + 5120;
        float* orow = p.out + (size_t)row * DM;
#pragma unroll
        for (int j = 0; j < 2; ++j)
#pragma unroll
            for (int h = 0; h < 2; ++h) {
                const int c0 = 512 * j + 8 * lane + 4 * h;
                const float4 xv = *(const float4*)(orow + c0), gv = *(const float4*)(g2 + c0);
                float4 o; o.x = xv.x + gv.x * acc[8 * j + 4 * h]; o.y = xv.y + gv.y * acc[8 * j + 4 * h + 1]; o.z = xv.z + gv.z * acc[8 * j + 4 * h + 2]; o.w = xv.w + gv.w * acc[8 * j + 4 * h + 3];
                *(float4*)(orow + c0) = o;
            }
    }
}

enum { PH_P0 = 0, PH_P1, PH_INPROJ, PH_MIX, PH_HYT, PH_OUTPROJ, PH_ROUTER, PH_TOPK, PH_GATEUP, PH_DOWN, PH_COMBINE, PH_N };
__global__ void __launch_bounds__(NTHR, 2) k_phases(P p, int lo, int hi) {
    extern __shared__ __attribute__((aligned(16))) unsigned char lds[];
#define IN(k) (lo <= (k) && (k) < hi)
    if (IN(PH_P0)) { ph_mod(p, (float*)lds); __syncthreads(); ph_rope(p); ph_h2(p, (float*)lds); }
    if (IN(PH_P1)) { ph_xn(p); ph_ht(p); }
    if (IN(PH_MIX)) { ph_fft(p, lds); }
    if (IN(PH_HYT)) { ph_hyt(p, lds); }
    if (IN(PH_ROUTER)) { ph_router(p, lds); }
    if (IN(PH_TOPK)) { ph_topk(p, lds); }
    if (IN(PH_COMBINE)) { ph_combine(p); }
#undef IN
}

template <class AL, class BL, class EP, bool DUAL>
__global__ void __launch_bounds__(256) naive_gemm(AL al, BL bl, BL bl2, EP ep, int K) {
    __shared__ float As[16][68], Bs[16][68], Bs2[16][68];
    const int tid = threadIdx.x, tx = tid & 15, ty = tid >> 4;
    const int m0 = blockIdx.y * 64, n0 = blockIdx.x * 64, z = blockIdx.z;
    float acc[4][4], acc2[4][4];
#pragma unroll
    for (int i = 0; i < 4; ++i)
#pragma unroll
        for (int j = 0; j < 4; ++j) { acc[i][j] = 0.f; acc2[i][j] = 0.f; }
    for (int k0 = 0; k0 < K; k0 += 16) {
#pragma unroll
        for (int i = 0; i < 4; ++i) { const int id = tid + 256 * i; { const int m = id >> 4, k = id & 15; As[k][m] = al(z, m0 + m, k0 + k); }
            { const int k = id >> 6, n = id & 63; Bs[k][n] = bl(z, k0 + k, n0 + n); if (DUAL) Bs2[k][n] = bl2(z, k0 + k, n0 + n); } }
        __syncthreads();
#pragma unroll
        for (int k = 0; k < 16; ++k) {
            const float4 a = *(const float4*)&As[k][4 * ty], b = *(const float4*)&Bs[k][4 * tx];
            const float av[4] = {a.x, a.y, a.z, a.w}, bv[4] = {b.x, b.y, b.z, b.w};
#pragma unroll
            for (int i = 0; i < 4; ++i)
#pragma unroll
                for (int j = 0; j < 4; ++j) acc[i][j] += av[i] * bv[j];
            if (DUAL) { const float4 b2 = *(const float4*)&Bs2[k][4 * tx]; const float bw[4] = {b2.x, b2.y, b2.z, b2.w};
#pragma unroll
                for (int i = 0; i < 4; ++i)
#pragma unroll
                    for (int j = 0; j < 4; ++j) acc2[i][j] += av[i] * bw[j]; }
        }
        __syncthreads();
    }
#pragma unroll
    for (int i = 0; i < 4; ++i)
#pragma unroll
        for (int j = 0; j < 4; ++j) ep(z, m0 + 4 * ty + i, n0 + 4 * tx + j, acc[i][j], acc2[i][j]);
}
struct ALbf { const bf16_t* A; size_t lda; size_t zs; __device__ float operator()(int z, int m, int k) const { return bf2f(A[zs * z + (size_t)m * lda + k]); } };
struct BLf { const float* B; size_t ldb; size_t zs; __device__ float operator()(int z, int k, int n) const { return B[zs * z + (size_t)k * ldb + n]; } };
struct EPinproj { float* proj; float* pt; __device__ void operator()(int, int m, int n, float a, float) const { if (n < 768) proj[(size_t)m * 768 + n] = a; else if (m < MTOK) pt[(size_t)(n - 768) * MTOK + m] = a; } };
struct EPoutproj { const float* x; const float* modv; float* out; __device__ void operator()(int, int m, int n, float a, float) const { out[(size_t)m * DM + n] = x[(size_t)m * DM + n] + modv[(m >> 13) * 6144 + 2048 + n] * a; } };
struct ALgather { const bf16_t* xn2; const int* idx; __device__ float operator()(int e, int m, int k) const { const int b = m >> 10, tok = idx[(b * 16 + e) * CAP + (m & 1023)]; return bf2f(xn2[((size_t)(b * SEQ + tok)) * DM + k]); } };
struct EPgateup { bf16_t* H; __device__ void operator()(int e, int m, int n, float g, float u) const { const float s = g / (1.0f + expf(-g)); H[((size_t)(e * 2048 + m)) * DEXP_P + n] = (bf16_t)f2bf(s * u); } };
struct EPdown { bf16_t* Y; const float* gate; __device__ void operator()(int e, int m, int n, float a, float) const { const int b = m >> 10; Y[((size_t)(e * 2048 + m)) * DM + n] = (bf16_t)f2bf(a * gate[(b * 16 + e) * CAP + (m & 1023)]); } };

__global__ void __launch_bounds__(256) naive_hpad(P p) {
    bf16_t* H = WSP(bf16_t, OFF_H);
    const int i = blockIdx.x * 256 + threadIdx.x;
    if (i < 32768 * 64) H[(size_t)(i >> 6) * DEXP_P + DEXP + (i & 63)] = 0;
}
__global__ void __launch_bounds__(256) naive_post(P p) {
    const int gw = blockIdx.x * 4 + (threadIdx.x >> 6), d = threadIdx.x & 63;
    if (gw >= MALL * 12) return;
    const int row = gw / 12, hh = gw % 12;
    if (row >= MTOK && hh < 8) return;
    const float* proj = WSP(float, OFF_PROJ); const float* rope = WSP(float, OFF_ROPE);
    float v = proj[(size_t)row * 768 + hh * 64 + d];
    if (hh < 10) {
        const float ss = wave_sum(v * v);
        v = v * rsqrtf(ss * (1.0f / 64.0f) + EPS) * (hh < 8 ? p.qng[d] : p.kng[d]);
        const float other = __shfl_xor(v, 16);
        if (row < MTOK) {
            const int t = row & 8191, pos = d < 32 ? (t >> 6) : (t & 63), f = d & 15;
            const float cs = rope[(pos * 16 + f) * 2], sn = rope[(pos * 16 + f) * 2 + 1];
            v = (d & 16) ? (other * sn + v * cs) : (v * cs - other * sn);
        }
    }
    if (hh < 8) WSP(bf16_t, OFF_Q)[(size_t)row * 512 + hh * 64 + d] = (bf16_t)f2bf(v * C2);
    else {
        size_t r2; if (row < MTOK) r2 = (size_t)(row >> 13) * LK + (row & 8191); else { const int j = row - MTOK; r2 = (size_t)(j >> 8) * LK + SEQ + (j & 255); }
        bf16_t* dst = hh < 10 ? WSP(bf16_t, OFF_K) : WSP(bf16_t, OFF_V);
        dst[r2 * 128 + (hh & 1) * 64 + d] = (bf16_t)f2bf(v);
    }
}
__global__ void __launch_bounds__(256) naive_attn(P p) {
    __shared__ float Qs[64][65], Ks[32][65], Vs[32][64], Ps[64][33];
    const int tid = threadIdx.x, tx = tid & 15, ty = tid >> 4;
    const int q0 = blockIdx.x * 64, bh = blockIdx.y, b = bh >> 3, h = bh & 7, kvh = h >> 2;
    const bf16_t* Q = WSP(bf16_t, OFF_Q); const bf16_t* K = WSP(bf16_t, OFF_K); const bf16_t* V = WSP(bf16_t, OFF_V); bf16_t* AO = WSP(bf16_t, OFF_AO);
    for (int i = tid; i < 4096; i += 256) { const int r = i >> 6, d = i & 63; Qs[r][d] = bf2f(Q[((size_t)(b * SEQ + q0 + r)) * 512 + h * 64 + d]); }
    float m[4], l[4], o[4][4];
#pragma unroll
    for (int i = 0; i < 4; ++i) { m[i] = -1e30f; l[i] = 0.f;
#pragma unroll
        for (int j = 0; j < 4; ++j) o[i][j] = 0.f; }
    for (int kt = 0; kt < LK / 32; ++kt) {
        __syncthreads();
        for (int i = tid; i < 2048; i += 256) { const int r = i >> 6, d = i & 63; const size_t g = ((size_t)(b * LK + kt * 32 + r)) * 128 + kvh * 64 + d; Ks[r][d] = bf2f(K[g]); Vs[r][d] = bf2f(V[g]); }
        __syncthreads();
        float s[4][2];
#pragma unroll
        for (int i = 0; i < 4; ++i) { s[i][0] = 0.f; s[i][1] = 0.f; }
        for (int d = 0; d < 64; ++d) {
            const float k0 = Ks[2 * tx][d], k1 = Ks[2 * tx + 1][d];
#pragma unroll
            for (int i = 0; i < 4; ++i) { const float q = Qs[4 * ty + i][d]; s[i][0] += q * k0; s[i][1] += q * k1; }
        }
#pragma unroll
        for (int i = 0; i < 4; ++i) {
            float mx = fmaxf(s[i][0], s[i][1]);
#pragma unroll
            for (int oo = 1; oo < 16; oo <<= 1) mx = fmaxf(mx, __shfl_xor(mx, oo));
            const float mn = fmaxf(m[i], mx), al = exp2f(m[i] - mn);
            const float p0 = exp2f(s[i][0] - mn), p1 = exp2f(s[i][1] - mn);
            float rs = p0 + p1;
#pragma unroll
            for (int oo = 1; oo < 16; oo <<= 1) rs += __shfl_xor(rs, oo);
            l[i] = l[i] * al + rs; m[i] = mn;
#pragma unroll
            for (int j = 0; j < 4; ++j) o[i][j] *= al;
            Ps[4 * ty + i][2 * tx] = p0; Ps[4 * ty + i][2 * tx + 1] = p1;
        }
        __syncthreads();
        for (int k = 0; k < 32; ++k) {
            const float4 vv = *(const float4*)&Vs[k][4 * tx];
#pragma unroll
            for (int i = 0; i < 4; ++i) { const float pp = Ps[4 * ty + i][k]; o[i][0] += pp * vv.x; o[i][1] += pp * vv.y; o[i][2] += pp * vv.z; o[i][3] += pp * vv.w; }
        }
    }
#pragma unroll
    for (int i = 0; i < 4; ++i) { const float il = 1.0f / l[i]; bf16_t* dst = AO + ((size_t)(b * SEQ + q0 + 4 * ty + i)) * DM + h * 64 + 4 * tx;
#pragma unroll
        for (int j = 0; j < 4; ++j) dst[j] = (bf16_t)f2bf(o[i][j] * il); }
}

extern "C" void kernel_launch(void* const* d_in, const int* in_sizes, int n_in, void* d_out, int out_size, void* d_ws, size_t ws_size, hipStream_t stream) {
    static int init = 0;
    if (!init) {
        if (n_in != 25 || ws_size < WS_END) { fprintf(stderr, "kernel_launch: unexpected n_in %d / ws_size %zu\n", n_in, ws_size); init = -1; return; }
        if (hipFuncSetAttribute((const void*)k_phases, hipFuncAttributeMaxDynamicSharedMemorySize, LDS_BYTES) != hipSuccess) { fprintf(stderr, "hipFuncSetAttribute failed\n"); init = -1; return; }
        init = 1;
    }
    if (init < 0) return;
    P p{};
    const float** f = (const float**)&p.x;
    for (int i = 0; i < 25; ++i) f[i] = (const float*)d_in[i];
    p.out = (float*)d_out; p.ws = (unsigned char*)d_ws;
    for (int i = 0; i < 16; ++i) p.invf[i] = pow(10000.0, -(double)i / 16.0);
    (void)hipMemsetAsync((char*)d_ws + OFF_CTL, 0, CTL_BYTES, stream);
    const int G = 256;
#define PHASES(lo, hi) hipLaunchKernelGGL(k_phases, dim3(G), dim3(NTHR), LDS_BYTES, stream, p, (lo), (hi))
    PHASES(PH_P0, PH_P0 + 1);
    PHASES(PH_P1, PH_P1 + 1);
    {
        ALbf al{WSP(bf16_t, OFF_XN), DM, 0}; BLf bl{p.w_in, INW, 0}; EPinproj ep{WSP(float, OFF_PROJ), WSP(float, OFF_PT)};
        hipLaunchKernelGGL((naive_gemm<ALbf, BLf, EPinproj, false>), dim3(INW / 64, MALL / 64, 1), dim3(256), 0, stream, al, bl, bl, ep, DM);
        hipLaunchKernelGGL(naive_post, dim3((MALL * 12 + 3) / 4), dim3(256), 0, stream, p);
    }
    hipLaunchKernelGGL(naive_attn, dim3(SEQ / 64, 16), dim3(256), 0, stream, p);
    PHASES(PH_MIX, PH_MIX + 1);
    PHASES(PH_HYT, PH_HYT + 1);
    {
        ALbf al{WSP(bf16_t, OFF_AO), DM, 0}; BLf bl{p.w_out, DM, 0}; EPoutproj ep{p.x, WSP(float, OFF_MODV), p.out};
        hipLaunchKernelGGL((naive_gemm<ALbf, BLf, EPoutproj, false>), dim3(DM / 64, MTOK / 64, 1), dim3(256), 0, stream, al, bl, bl, ep, DM);
    }
    PHASES(PH_ROUTER, PH_ROUTER + 1);
    PHASES(PH_TOPK, PH_TOPK + 1);
    {
        ALgather al{WSP(bf16_t, OFF_XN2), WSP(int, OFF_IDX)}; BLf bg{p.w_gate, DEXP, (size_t)DM * DEXP}, bu{p.w_up, DEXP, (size_t)DM * DEXP}; EPgateup ep{WSP(bf16_t, OFF_H)};
        hipLaunchKernelGGL((naive_gemm<ALgather, BLf, EPgateup, true>), dim3(DEXP / 64, 2048 / 64, NEXP), dim3(256), 0, stream, al, bg, bu, ep, DM);
        hipLaunchKernelGGL(naive_hpad, dim3(32768 * 64 / 256), dim3(256), 0, stream, p);
        ALbf al2{WSP(bf16_t, OFF_H), DEXP_P, (size_t)2048 * DEXP_P}; BLf bd{p.w_down, DM, (size_t)DEXP * DM}; EPdown ep2{WSP(bf16_t, OFF_Y), WSP(float, OFF_GATE)};
        hipLaunchKernelGGL((naive_gemm<ALbf, BLf, EPdown, false>), dim3(DM / 64, 2048 / 64, NEXP), dim3(256), 0, stream, al2, bd, bd, ep2, DEXP);
    }
    PHASES(PH_COMBINE, PH_COMBINE + 1);
}
```

```cpp
#include <hip/hip_runtime.h>
#include <cstdio>
#include <cstdint>
#include <cmath>

#define ONE_LAUNCH 1
constexpr int DM = 1024, NB = 2, SEQ = 8192, CTXL = 256, LK = SEQ + CTXL;
constexpr int MTOK = NB * SEQ, MCTX = NB * CTXL, MALL = MTOK + MCTX;
constexpr int INW = 2304, NEXP = 16, CAP = 1024, DEXP = 2752, DEXP_P = 2816;
constexpr int NFFT = 16384;
constexpr float EPS = 1e-6f;
constexpr float C2 = 0.125f * 1.4426950408889634f;

typedef unsigned short bf16_t;

constexpr size_t MiB = 1u << 20;
constexpr size_t OFF_CTL = 0, CTL_BYTES = 1 * MiB;
constexpr size_t OFF_MODV = 1 * MiB;
constexpr size_t OFF_ROPE = 1 * MiB + 128 * 1024;
constexpr size_t OFF_H2 = 2 * MiB;
constexpr size_t OFF_AFF = 4 * MiB;
constexpr size_t OFF_INV = 5 * MiB;
constexpr size_t OFF_IDX = 6 * MiB;
constexpr size_t OFF_GATE = 6 * MiB + 128 * 1024;
constexpr size_t OFF_WIN = 8 * MiB, OFF_WOUT = 13 * MiB, OFF_WGU = 16 * MiB, OFF_WD = 192 * MiB;
constexpr size_t OFF_XN2 = 280 * MiB;
constexpr size_t OFF_XN = 312 * MiB;
constexpr size_t OFF_Q = 345 * MiB;
constexpr size_t OFF_K = 361 * MiB;
constexpr size_t OFF_V = 366 * MiB;
constexpr size_t OFF_PT = 371 * MiB;
constexpr size_t OFF_HT = 467 * MiB;
constexpr size_t OFF_H = 312 * MiB;
constexpr size_t OFF_AO = 499 * MiB;
constexpr size_t OFF_HYT = 531 * MiB;
constexpr size_t OFF_Y = 499 * MiB;
constexpr size_t OFF_PROJ = 563 * MiB;
constexpr size_t OFF_KF = 613 * MiB;
constexpr size_t WS_END = 645 * MiB;

struct P {
    const float *x, *c, *ctx, *c_ctx, *w_mod, *b_mod, *n1g, *n2g, *w_in, *w_out, *qng, *kng, *conv_w, *conv_b;
    const float *fw1, *fb1, *fw2, *fb2, *fw3, *ffreq, *hbias, *w_router, *w_gate, *w_up, *w_down;
    float* out; unsigned char* ws;
    double invf[16];
};

#define WSP(T, off) ((T*)(p.ws + (off)))

__device__ __forceinline__ unsigned f2bf(float f) { unsigned u = __float_as_uint(f); return (u + 0x7fffu + ((u >> 16) & 1u)) >> 16; }
__device__ __forceinline__ float bf2f(unsigned h) { return __uint_as_float(h << 16); }
__device__ __forceinline__ unsigned pk2(float lo, float hi) { return f2bf(lo) | (f2bf(hi) << 16); }
__device__ __forceinline__ float hw_sin_rev(float r) { return __builtin_amdgcn_sinf(r); }
__device__ __forceinline__ float hw_cos_rev(float r) { return __builtin_amdgcn_cosf(r); }
__device__ __forceinline__ float wave_sum(float v) {
#pragma unroll
    for (int o = 1; o < 64; o <<= 1) v += __shfl_xor(v, o);
    return v;
}

constexpr int NTHR = 512, NWAVE = 8;
constexpr int LDS_BYTES = 147456;

__device__ __forceinline__ void ph_mod(const P& p, float* lf) {
    const int tid = threadIdx.x, lane = tid & 63, wave = tid >> 6;
    float* sil = lf; float* red = lf + 3072;
    if ((int)blockIdx.x < 96) {
        for (int i = tid; i < 3072; i += NTHR) { const int r = i >> 10, k = i & 1023; const float v = r < 2 ? p.c[r * 1024 + k] : p.c_ctx[k]; sil[i] = v / (1.0f + expf(-v)); }
        __syncthreads();
        float* modv = WSP(float, OFF_MODV);
        for (int item = blockIdx.x; item < 96; item += gridDim.x) {
            const int col = item * 64 + lane, kb = wave * 128;
            float a0 = 0.f, a1 = 0.f, a2 = 0.f;
#pragma unroll 8
            for (int kk = 0; kk < 128; ++kk) { const float w = p.w_mod[(size_t)(kb + kk) * 6144 + col]; a0 += sil[kb + kk] * w; a1 += sil[1024 + kb + kk] * w; a2 += sil[2048 + kb + kk] * w; }
            red[(wave * 3 + 0) * 64 + lane] = a0; red[(wave * 3 + 1) * 64 + lane] = a1; red[(wave * 3 + 2) * 64 + lane] = a2;
            __syncthreads();
            if (wave < 3) { float s = p.b_mod[col];
#pragma unroll
                for (int w2 = 0; w2 < 8; ++w2) s += red[(w2 * 3 + wave) * 64 + lane];
                modv[wave * 6144 + col] = s; }
            __syncthreads();
        }
    }
}
__device__ __forceinline__ void ph_rope(const P& p) {
    float* rope = WSP(float, OFF_ROPE);
    for (int i = blockIdx.x * NTHR + threadIdx.x; i < 2048; i += gridDim.x * NTHR) {
        const int pos = i >> 4, f = i & 15;
        double r = (double)pos * p.invf[f] * 0.15915494309189535; r -= floor(r);
        rope[2 * i] = hw_cos_rev((float)r); rope[2 * i + 1] = hw_sin_rev((float)r);
    }
}
__device__ __forceinline__ void ph_h2(const P& p, float* lf) {
    const int tid = threadIdx.x, lane = tid & 63, wave = tid >> 6;
    float* zf = lf + wave * 40; float* h1 = lf + 8 * 40 + wave * 64;
    float* h2 = WSP(float, OFF_H2);
    const float fr = p.ffreq[lane];
    for (int item = blockIdx.x; item < 1024; item += gridDim.x) {
        const int t = item * 8 + wave;
        if (lane < 33) {
            float z;
            if (lane == 0) z = (float)t / 8191.0f;
            else { const int k = (lane - 1) & 15; const double fk = 1e-4 + (double)k * ((15.0 - 1e-4) / 15.0); double r = (double)t * fk / 8192.0; r -= floor(r);
                   z = lane <= 16 ? hw_cos_rev((float)r) : -hw_sin_rev((float)r); }
            zf[lane] = z;
        }
        __syncthreads();
        float a = p.fb1[lane];
#pragma unroll
        for (int i = 0; i < 33; ++i) a += zf[i] * p.fw1[i * 64 + lane];
        h1[lane] = hw_sin_rev(fr * a * 0.15915494309189535f);
        __syncthreads();
        float b = p.fb2[lane];
#pragma unroll 16
        for (int i = 0; i < 64; ++i) b += h1[i] * p.fw2[i * 64 + lane];
        h2[(size_t)t * 64 + lane] = hw_sin_rev(fr * b * 0.15915494309189535f);
        __syncthreads();
    }
}

__device__ __forceinline__ void ph_xn(const P& p) {
    const int tid = threadIdx.x, lane = tid & 63, wave = tid >> 6;
    const float* modv = WSP(float, OFF_MODV); bf16_t* xn = WSP(bf16_t, OFF_XN);
    for (int row = blockIdx.x * NWAVE + wave; row < MALL; row += gridDim.x * NWAVE) {
        const float* src = row < MTOK ? p.x + (size_t)row * DM : p.ctx + (size_t)(row - MTOK) * DM;
        const float* mv = modv + (row < MTOK ? (row >> 13) : 2) * 6144;
        float4 v[4]; float ss = 0.f;
#pragma unroll
        for (int j = 0; j < 4; ++j) { v[j] = *(const float4*)(src + 4 * lane + 256 * j); ss += v[j].x * v[j].x + v[j].y * v[j].y + v[j].z * v[j].z + v[j].w * v[j].w; }
        const float rstd = rsqrtf(wave_sum(ss) * (1.0f / DM) + EPS);
#pragma unroll
        for (int j = 0; j < 4; ++j) {
            const int c0 = 4 * lane + 256 * j;
            const float4 g = *(const float4*)(p.n1g + c0), sh = *(const float4*)(mv + c0), sc = *(const float4*)(mv + 1024 + c0);
            const float y0 = v[j].x * rstd * g.x * (1.f + sc.x) + sh.x, y1 = v[j].y * rstd * g.y * (1.f + sc.y) + sh.y;
            const float y2 = v[j].z * rstd * g.z * (1.f + sc.z) + sh.z, y3 = v[j].w * rstd * g.w * (1.f + sc.w) + sh.w;
            uint2 o; o.x = pk2(y0, y1); o.y = pk2(y2, y3);
            *(uint2*)(xn + (size_t)row * DM + c0) = o;
        }
    }
}
__device__ __forceinline__ void ph_ht(const P& p) {
    const int tid = threadIdx.x, lane = tid & 63, wave = __builtin_amdgcn_readfirstlane(tid >> 6);
    const float* h2 = WSP(float, OFF_H2); float* ht = WSP(float, OFF_HT);
    const float MIN_D = -3.0701134573253945f, MAX_D = -15.350567286626973f;
    for (int item = blockIdx.x; item < 2048; item += gridDim.x) {
        const int tg = item >> 4, cg = item & 15, t = tg * 64 + lane;
        float h[64];
#pragma unroll
        for (int j = 0; j < 16; ++j) { const float4 q = *(const float4*)(h2 + (size_t)t * 64 + 4 * j); h[4 * j] = q.x; h[4 * j + 1] = q.y; h[4 * j + 2] = q.z; h[4 * j + 3] = q.w; }
        const float tn = (float)t / 8191.0f;
        for (int cc = 0; cc < 8; ++cc) {
            const int col = cg * 64 + wave * 8 + cc;
            float acc = 0.f;
#pragma unroll
            for (int j = 0; j < 64; ++j) acc += h[j] * p.fw3[j * 1024 + col];
            const float dl = MIN_D + (MAX_D - MIN_D) * (float)(col & 511) / 511.0f;
            ht[(size_t)col * 8192 + t] = acc * expf(-tn * fabsf(dl));
        }
    }
}

struct c2 { float x, y; };
__device__ __forceinline__ c2 cmul(c2 a, c2 b) { return c2{a.x * b.x - a.y * b.y, a.x * b.y + a.y * b.x}; }
template <int LOGS> __device__ __forceinline__ void r4_compute(const c2* X, c2 (&y)[8][4], int tid) {
#pragma unroll
    for (int i = 0; i < 8; ++i) {
        const int j = tid + 512 * i;
        const c2 a = X[j], b = X[j + 4096], c = X[j + 8192], d = X[j + 12288];
        const c2 apc{a.x + c.x, a.y + c.y}, amc{a.x - c.x, a.y - c.y}, bpd{b.x + d.x, b.y + d.y}, bmd{b.x - d.x, b.y - d.y};
        const c2 jb{-bmd.y, bmd.x};
        c2 t0{apc.x + bpd.x, apc.y + bpd.y}, t1{amc.x - jb.x, amc.y - jb.y}, t2{apc.x - bpd.x, apc.y - bpd.y}, t3{amc.x + jb.x, amc.y + jb.y};
        if (LOGS < 12) {
            const int ps = (j >> LOGS) << LOGS;
            float r = (float)ps * (1.0f / 16384.0f);
            asm volatile("" : "+v"(r));
            const c2 w1{hw_cos_rev(r), -hw_sin_rev(r)};
            const c2 w2 = cmul(w1, w1), w3 = cmul(w1, w2);
            t1 = cmul(t1, w1); t2 = cmul(t2, w2); t3 = cmul(t3, w3);
        }
        y[i][0] = t0; y[i][1] = t1; y[i][2] = t2; y[i][3] = t3;
    }
}
template <int LOGS> __device__ __forceinline__ void r4_write(c2* X, const c2 (&y)[8][4], int tid) {
    constexpr int S = 1 << LOGS;
#pragma unroll
    for (int i = 0; i < 8; ++i) {
        const int j = tid + 512 * i, q = j & (S - 1), base = 4 * j - 3 * q;
#pragma unroll
        for (int k = 0; k < 4; ++k) X[base + k * S] = y[i][k];
    }
}
#define FFT_PASS(L) do { asm volatile("" : "+v"(tid)); r4_compute<L>(X, y, tid); __syncthreads(); asm volatile("" : "+v"(tid)); r4_write<L>(X, y, tid); __syncthreads(); } while (0)
__device__ __forceinline__ void fft16k(c2* X, c2 (&y)[8][4], int tid) {
    FFT_PASS(0); FFT_PASS(2); FFT_PASS(4); FFT_PASS(6); FFT_PASS(8); FFT_PASS(10);
    asm volatile("" : "+v"(tid));
    r4_compute<12>(X, y, tid);
}
__device__ __forceinline__ float conv3(const float* base, int t, float w0, float w1, float w2, float cb) {
    const float pm = t > 0 ? base[t - 1] : 0.f, pc = base[t], pp = t < SEQ - 1 ? base[t + 1] : 0.f;
    return w0 * pm + w1 * pc + w2 * pp + cb;
}
#define LAUNDER(v) asm volatile("" : "+v"(v))
__device__ __forceinline__ void ph_fft(const P& p, unsigned char* lds) {
    int tid = threadIdx.x; const int lane = tid & 63, wave = tid >> 6;
    c2* X = (c2*)lds; float* red = (float*)(lds + 131072);
    const float* ht = WSP(float, OFF_HT); const float* pt = WSP(float, OFF_PT); bf16_t* hyt = WSP(bf16_t, OFF_HYT);
    for (int ch = blockIdx.x; ch < 512; ch += gridDim.x) {
        LAUNDER(tid);
        const float* hf = ht + (size_t)ch * 8192; const float* hb = ht + (size_t)(512 + ch) * 8192;
        float asum = 0.f;
#pragma unroll 4
        for (int m = 0; m < 32; ++m) {
            const int n = tid + 512 * m; float v;
            if (n < 8192) v = hf[n]; else if (n == 8192) v = 0.f; else v = hb[16384 - n];
            asum += fabsf(v); X[n] = c2{v, 0.f};
        }
        asum = wave_sum(asum); if (lane == 0) red[wave] = asum;
        __syncthreads();
        float tot = 0.f;
#pragma unroll
        for (int w = 0; w < 8; ++w) tot += red[w];
        const float scale = 1.0f / (tot * 16384.0f);
        c2 y[8][4];
        LAUNDER(tid);
        fft16k(X, y, tid);
        LAUNDER(tid);
        c2* kfg = WSP(c2, OFF_KF) + (size_t)blockIdx.x * NFFT + tid;
#pragma unroll
        for (int i = 0; i < 8; ++i) { c2* kq = kfg + i * 2048; asm volatile("" : "+v"(kq));
#pragma unroll
            for (int k = 0; k < 4; ++k) kq[k * 512] = y[i][k]; }
        __syncthreads();
        const float wa0 = p.conv_w[ch], wa1 = p.conv_w[1536 + ch], wa2 = p.conv_w[3072 + ch], ba = p.conv_b[ch];
        const float wx0 = p.conv_w[512 + ch], wx1 = p.conv_w[1536 + 512 + ch], wx2 = p.conv_w[3072 + 512 + ch], bx = p.conv_b[512 + ch];
        const float wv0 = p.conv_w[1024 + ch], wv1 = p.conv_w[1536 + 1024 + ch], wv2 = p.conv_w[3072 + 1024 + ch], bv = p.conv_b[1024 + ch];
        LAUNDER(tid);
        const float* p1 = pt + (size_t)ch * MTOK; const float* px = pt + (size_t)(512 + ch) * MTOK; const float* pv = pt + (size_t)(1024 + ch) * MTOK;
#pragma unroll 2
        for (int m = 0; m < 16; ++m) {
            const int n = tid + 512 * m;
            const float u0 = conv3(pv, n, wv0, wv1, wv2, bv) * conv3(p1, n, wa0, wa1, wa2, ba);
            const float u1 = conv3(pv + SEQ, n, wv0, wv1, wv2, bv) * conv3(p1 + SEQ, n, wa0, wa1, wa2, ba);
            X[n] = c2{u0, u1}; X[n + 8192] = c2{0.f, 0.f};
        }
        __syncthreads();
        LAUNDER(tid);
        fft16k(X, y, tid);
        __syncthreads();
        LAUNDER(tid);
#pragma unroll
        for (int i = 0; i < 8; ++i) { const c2* kq = kfg + i * 2048; asm volatile("" : "+v"(kq));
#pragma unroll
            for (int k = 0; k < 4; ++k) { const c2 w = cmul(y[i][k], kq[k * 512]); X[tid + 512 * i + 4096 * k] = c2{w.x, -w.y}; } }
        __syncthreads();
        LAUNDER(tid);
        fft16k(X, y, tid);
        LAUNDER(tid);
        const float bias = p.hbias[ch];
#pragma unroll
        for (int i = 0; i < 8; ++i)
#pragma unroll
            for (int k = 0; k < 2; ++k) {
                const int t = tid + 512 * i + 4096 * k;
                const float y0 = y[i][k].x * scale, y1 = -y[i][k].y * scale;
                const float u0 = conv3(pv, t, wv0, wv1, wv2, bv) * conv3(p1, t, wa0, wa1, wa2, ba);
                const float u1 = conv3(pv + SEQ, t, wv0, wv1, wv2, bv) * conv3(p1 + SEQ, t, wa0, wa1, wa2, ba);
                const float x20 = conv3(px, t, wx0, wx1, wx2, bx), x21 = conv3(px + SEQ, t, wx0, wx1, wx2, bx);
                hyt[(size_t)ch * MTOK + t] = (bf16_t)f2bf((y0 + u0 * bias) * x20);
                hyt[(size_t)ch * MTOK + SEQ + t] = (bf16_t)f2bf((y1 + u1 * bias) * x21);
                asm volatile("" ::: "memory");
            }
        __syncthreads();
    }
}

__device__ __forceinline__ void ph_hyt(const P& p, unsigned char* lds) {
    const int tid = threadIdx.x;
    bf16_t* tile = (bf16_t*)lds;
    const bf16_t* hyt = WSP(bf16_t, OFF_HYT); bf16_t* ao = WSP(bf16_t, OFF_AO);
    for (int item = blockIdx.x; item < 2048; item += gridDim.x) {
        const int cg = item & 7, mg = item >> 3, c0 = cg * 64, m0 = mg * 64;
        { const int c = tid >> 3, ch = tid & 7; const uint4 v = *(const uint4*)(hyt + (size_t)(c0 + c) * MTOK + m0 + ch * 8); *(uint4*)(tile + c * 72 + ch * 8) = v; }
        __syncthreads();
        { const int m = tid >> 3, ch = tid & 7; unsigned w[4];
#pragma unroll
          for (int k = 0; k < 4; ++k) { const unsigned lo = tile[(ch * 8 + 2 * k) * 72 + m], hi = tile[(ch * 8 + 2 * k + 1) * 72 + m]; w[k] = lo | (hi << 16); }
          uint4 o; o.x = w[0]; o.y = w[1]; o.z = w[2]; o.w = w[3];
          *(uint4*)(ao + (size_t)(m0 + m) * DM + 512 + c0 + ch * 8) = o; }
        __syncthreads();
    }
}

__device__ __forceinline__ void ph_router(const P& p, unsigned char* lds) {
    const int tid = threadIdx.x, lane = tid & 63, wave = tid >> 6;
    float* wt = (float*)lds;
    float* rowb = (float*)(lds + 16 * 1028 * 4);
    const float* modv = WSP(float, OFF_MODV); bf16_t* xn2 = WSP(bf16_t, OFF_XN2); float* aff = WSP(float, OFF_AFF);
    for (int i = tid; i < 16384; i += NTHR) { const int k = i >> 4, e = i & 15; wt[e * 1028 + k] = p.w_router[i]; }
    __syncthreads();
    for (int item = blockIdx.x; item < MTOK / 8; item += gridDim.x) {
        const int row = item * 8 + wave, b = row >> 13, t = row & 8191;
        const float* src = p.out + (size_t)row * DM; const float* mv = modv + b * 6144;
        float4 v[4]; float ss = 0.f;
#pragma unroll
        for (int j = 0; j < 4; ++j) { v[j] = *(const float4*)(src + 4 * lane + 256 * j); ss += v[j].x * v[j].x + v[j].y * v[j].y + v[j].z * v[j].z + v[j].w * v[j].w; }
        const float rstd = rsqrtf(wave_sum(ss) * (1.0f / DM) + EPS);
        float* rb = rowb + wave * 1024;
#pragma unroll
        for (int j = 0; j < 4; ++j) {
            const int c0 = 4 * lane + 256 * j;
            const float4 g = *(const float4*)(p.n2g + c0), sh = *(const float4*)(mv + 3072 + c0), sc = *(const float4*)(mv + 4096 + c0);
            float4 y; y.x = v[j].x * rstd * g.x * (1.f + sc.x) + sh.x; y.y = v[j].y * rstd * g.y * (1.f + sc.y) + sh.y;
            y.z = v[j].z * rstd * g.z * (1.f + sc.z) + sh.z; y.w = v[j].w * rstd * g.w * (1.f + sc.w) + sh.w;
            uint2 o; o.x = pk2(y.x, y.y); o.y = pk2(y.z, y.w);
            *(uint2*)(xn2 + (size_t)row * DM + c0) = o;
            *(float4*)(rb + c0) = y;
        }
        __syncthreads();
        const int e = lane & 15, kq = lane >> 4;
        float acc = 0.f;
#pragma unroll 8
        for (int j = 0; j < 64; ++j) {
            const int k = 16 * j + 4 * kq;
            const float4 xv = *(const float4*)(rb + k), wv = *(const float4*)(wt + e * 1028 + k);
            acc += xv.x * wv.x + xv.y * wv.y + xv.z * wv.z + xv.w * wv.w;
        }
        acc += __shfl_xor(acc, 16); acc += __shfl_xor(acc, 32);
        float mx = acc;
#pragma unroll
        for (int o = 1; o < 16; o <<= 1) mx = fmaxf(mx, __shfl_xor(mx, o));
        const float ex = expf(acc - mx);
        float sm = ex;
#pragma unroll
        for (int o = 1; o < 16; o <<= 1) sm += __shfl_xor(sm, o);
        if (kq == 0) aff[(size_t)(b * 16 + e) * 8192 + t] = ex / sm;
        __syncthreads();
    }
}

__device__ __forceinline__ void ph_topk(const P& p, unsigned char* lds) {
    const int tid = threadIdx.x, lane = tid & 63, wave = tid >> 6;
    unsigned* hist = (unsigned*)lds; unsigned* wtot = hist + 256; unsigned* sel = hist + 272;
    const float* aff = WSP(float, OFF_AFF); int* idx = WSP(int, OFF_IDX); float* gate = WSP(float, OFF_GATE); int* inv = WSP(int, OFF_INV);
    for (int prob = blockIdx.x; prob < 32; prob += gridDim.x) {
        const float* a = aff + (size_t)prob * 8192 + tid * 16;
        float v[16]; unsigned key[16];
#pragma unroll
        for (int j = 0; j < 4; ++j) { const float4 q = *(const float4*)(a + 4 * j); v[4 * j] = q.x; v[4 * j + 1] = q.y; v[4 * j + 2] = q.z; v[4 * j + 3] = q.w; }
#pragma unroll
        for (int i = 0; i < 16; ++i) key[i] = __float_as_uint(v[i]);
        unsigned prefix = 0u, kk = CAP;
#pragma unroll
        for (int pass = 0; pass < 4; ++pass) {
            const int shift = 24 - 8 * pass;
            const unsigned mhi = pass == 0 ? 0u : (0xFFFFFFFFu << (shift + 8));
            if (tid < 256) hist[tid] = 0u;
            __syncthreads();
#pragma unroll
            for (int i = 0; i < 16; ++i) if ((key[i] & mhi) == prefix) atomicAdd(&hist[(key[i] >> shift) & 255u], 1u);
            __syncthreads();
            unsigned h = 0u, s = 0u;
            if (tid < 256) {
                h = hist[tid]; s = h;
#pragma unroll
                for (int o = 1; o < 64; o <<= 1) { const unsigned n = __shfl_down(s, o); if (lane + o < 64) s += n; }
                if (lane == 0) wtot[wave] = s;
            }
            __syncthreads();
            if (tid < 256) {
                for (int w2 = wave + 1; w2 < 4; ++w2) s += wtot[w2];
                const unsigned sex = s - h;
                if (s >= kk && sex < kk) { sel[0] = (unsigned)tid; sel[1] = kk - sex; }
            }
            __syncthreads();
            prefix |= sel[0] << shift; kk = sel[1];
            __syncthreads();
        }
        const unsigned thr = prefix, krem = kk;
        unsigned cnt = 0u;
#pragma unroll
        for (int i = 0; i < 16; ++i) cnt += (key[i] > thr ? 1u : 0u) + (key[i] == thr ? 0x10000u : 0u);
        unsigned inc = cnt;
#pragma unroll
        for (int o = 1; o < 64; o <<= 1) { const unsigned n = __shfl_up(inc, o); if (lane >= o) inc += n; }
        if (lane == 63) wtot[wave] = inc;
        __syncthreads();
        unsigned before = inc - cnt;
        for (int w2 = 0; w2 < wave; ++w2) before += wtot[w2];
        unsigned gtr = before & 0xFFFFu, eqr = before >> 16;
#pragma unroll
        for (int i = 0; i < 16; ++i) {
            const int t = tid * 16 + i;
            const bool g = key[i] > thr, q = key[i] == thr;
            const bool s = g || (q && eqr < krem);
            const unsigned pos = gtr + (eqr < krem ? eqr : krem);
            if (s) { idx[prob * CAP + pos] = t; gate[prob * CAP + pos] = v[i]; }
            inv[(size_t)prob * 8192 + t] = s ? (int)pos : -1;
            gtr += g ? 1u : 0u; eqr += q ? 1u : 0u;
        }
        __syncthreads();
    }
}

__device__ __forceinline__ void ph_combine(const P& p) {
    const int tid = threadIdx.x, lane = tid & 63, wave = tid >> 6;
    const float* modv = WSP(float, OFF_MODV); const int* inv = WSP(int, OFF_INV); const bf16_t* Y = WSP(bf16_t, OFF_Y);
    for (int row = blockIdx.x * NWAVE + wave; row < MTOK; row += gridDim.x * NWAVE) {
        const int b = row >> 13, t = row & 8191;
        const int myinv = lane < 16 ? inv[(size_t)(b * 16 + lane) * 8192 + t] : -1;
        unsigned long long mask = __ballot(myinv >= 0);
        float acc[16];
#pragma unroll
        for (int i = 0; i < 16; ++i) acc[i] = 0.f;
        while (mask) {
            const int e = __ffsll((long long)mask) - 1; mask &= mask - 1;
            const int pos = __shfl(myinv, e);
            const bf16_t* yr = Y + ((size_t)(e * 2048 + b * 1024 + pos)) * DM;
            const uint4 u0 = *(const uint4*)(yr + 8 * lane), u1 = *(const uint4*)(yr + 512 + 8 * lane);
            acc[0] += bf2f(u0.x & 0xFFFFu); acc[1] += bf2f(u0.x >> 16); acc[2] += bf2f(u0.y & 0xFFFFu); acc[3] += bf2f(u0.y >> 16);
            acc[4] += bf2f(u0.z & 0xFFFFu); acc[5] += bf2f(u0.z >> 16); acc[6] += bf2f(u0.w & 0xFFFFu); acc[7] += bf2f(u0.w >> 16);
            acc[8] += bf2f(u1.x & 0xFFFFu); acc[9] += bf2f(u1.x >> 16); acc[10] += bf2f(u1.y & 0xFFFFu); acc[11] += bf2f(u1.y >> 16);
            acc[12] += bf2f(u1.z & 0xFFFFu); acc[13] += bf2f(u1.z >> 16); acc[14] += bf2f(u1.w & 0xFFFFu); acc[15] += bf2f(u1.w >> 16);
        }
        const float* g2 = modv + b * 6144 + 5120;
        float* orow = p.out + (size_t)row * DM;
#pragma unroll
        for (int j = 0; j < 2; ++j)
#pragma unroll
            for (int h = 0; h < 2; ++h) {
                const int c0 = 512 * j + 8 * lane + 4 * h;
                const float4 xv = *(const float4*)(orow + c0), gv = *(const float4*)(g2 + c0);
                float4 o; o.x = xv.x + gv.x * acc[8 * j + 4 * h]; o.y = xv.y + gv.y * acc[8 * j + 4 * h + 1]; o.z = xv.z + gv.z * acc[8 * j + 4 * h + 2]; o.w = xv.w + gv.w * acc[8 * j + 4 * h + 3];
                *(float4*)(orow + c0) = o;
            }
    }
}


namespace pg8 {
#define PG8_LAS __attribute__((address_space(3)))
typedef short bf16x8 __attribute__((ext_vector_type(8)));
typedef float f32x4 __attribute__((ext_vector_type(4)));
typedef unsigned u32x4 __attribute__((ext_vector_type(4)));
constexpr int BM = 256, BK = 64, HALF = 128, HTB = HALF * BK * 2, STAGE_BYTES = 8 * HTB;
__host__ __device__ __forceinline__ int lds_byte(int r, int c) { const int st = (r >> 4) * 2 + (c >> 5), rr = r & 15, cc = c & 31, ob = rr * 64 + cc * 2; return st * 1024 + (ob ^ (((ob >> 9) & 1) << 5)); }
__host__ __device__ __forceinline__ void stage_rc(int b, int& R, int& C) { const int st = b / 1024, sb = b % 1024, swz = sb ^ (((sb >> 9) & 1) << 5); R = (st >> 1) * 16 + swz / 64; C = (st & 1) * 32 + (swz % 64) / 2; }
__host__ __device__ __forceinline__ int perm32(int rho) { const int n = rho >> 4, i = rho & 15; return 8 * (i >> 2) + 4 * n + (i & 3); }
struct Unit { int pm, pn, am, bn, e; };
struct Gemm { const bf16_t* A; const bf16_t* Bt; int K; const int* idx; };
__device__ __forceinline__ unsigned cvt_pk_bf16(float lo, float hi) { unsigned r; asm volatile("v_cvt_pk_bf16_f32 %0, %1, %2" : "=v"(r) : "v"(lo), "v"(hi)); return r; }

template <class Epi, class Sched, bool GATHER, bool ALIGN_EPI, bool SP2>
__device__ __forceinline__ void gemm_phase(PG8_LAS unsigned char* lds, const Gemm g, const Sched& S, const Epi& E) {
    const int tid = threadIdx.x, wid = __builtin_amdgcn_readfirstlane(tid >> 6), lane = tid & 63, wr = wid >> 2, wc = wid & 3, fr = lane & 15, fq = lane >> 4;
    const int K = g.K, nt = K / BK;
    unsigned voffA[2], voffB[2]; int Rr[2], Cc[2];
#pragma unroll
    for (int i = 0; i < 2; ++i) { int R, C; stage_rc(tid * 16 + i * 8192, R, C); const int Rb = Epi::PERM ? ((R & ~31) + perm32(R & 31)) : R;
        voffA[i] = (unsigned)(R * K + C) * 2u; voffB[i] = (unsigned)(Rb * K + C) * 2u; Rr[i] = R; Cc[i] = C; }
    const size_t kstep = (size_t)(BK * 2);
    const size_t hstep = (size_t)HALF * K * 2;
    const size_t tstep = 2 * hstep;
    const unsigned ldsw = (unsigned)wid * 1024u;
    const int aoff = lds_byte(wr * 64 + fr, fq * 8), boff = lds_byte(wc * 32 + fr, fq * 8);
    unsigned vg[2][2], nvg[2][2];
#define PG8_GV(dst, u) do { _Pragma("unroll") for (int h_ = 0; h_ < 2; ++h_) _Pragma("unroll") for (int i_ = 0; i_ < 2; ++i_) { const int m_ = (u).pm * 256 + h_ * 128 + Rr[i_]; const int b_ = m_ >> 10; \
        const int tok_ = g.idx[(b_ * 16 + (u).e) * 1024 + (m_ & 1023)]; dst[h_][i_] = (unsigned)((b_ * 8192 + tok_) * K + Cc[i_]) * 2u; } } while (0)
#define PG8_SA(b, h) (((b) * 2 + (h)) * HTB)
#define PG8_SB(b, h) ((4 + (b) * 2 + (h)) * HTB)
#define PG8_STAGE(bufoff, gbase, voff) do { _Pragma("unroll") for (int _i = 0; _i < 2; ++_i) \
        __builtin_amdgcn_global_load_lds((const unsigned*)((const char*)(gbase) + (voff)[_i]), (PG8_LAS unsigned*)(lds + (bufoff) + ldsw + _i * 8192), 16, 0, 0); } while (0)
#define PG8_STAGE_A(bufoff, kb, h, GV) do { if constexpr (GATHER) { PG8_STAGE(bufoff, kb, GV[h]); } else { PG8_STAGE(bufoff, (kb) + (h) * hstep, voffA); } } while (0)
#define PG8_LDA(dst, b, h) do { _Pragma("unroll") for (int m = 0; m < 4; ++m) _Pragma("unroll") for (int k = 0; k < 2; ++k) dst[m][k] = *(const PG8_LAS bf16x8*)(lds + PG8_SA(b, h) + aoff + m * 2048 + k * 1024); } while (0)
#define PG8_LDB(dst, b, h) do { _Pragma("unroll") for (int n = 0; n < 2; ++n) _Pragma("unroll") for (int k = 0; k < 2; ++k) dst[n][k] = *(const PG8_LAS bf16x8*)(lds + PG8_SB(b, h) + boff + n * 2048 + k * 1024); } while (0)
#define PG8_MMA(ai, bj, At, Bt) do { __builtin_amdgcn_s_setprio(1); _Pragma("unroll") for (int m = 0; m < 4; ++m) _Pragma("unroll") for (int n = 0; n < 2; ++n) _Pragma("unroll") for (int k = 0; k < 2; ++k) \
        acc[ai][bj][m][n] = __builtin_amdgcn_mfma_f32_16x16x32_bf16(Bt[n][k], At[m][k], acc[ai][bj][m][n], 0, 0, 0); __builtin_amdgcn_s_setprio(0); } while (0)
#define PG8_WAIT_V(n) asm volatile("s_waitcnt vmcnt(" #n ")" ::: "memory")
#define PG8_WAIT_L(n) asm volatile("s_waitcnt lgkmcnt(" #n ")" ::: "memory")
#define PG8_BAR __builtin_amdgcn_s_barrier()
#define PG8_SCHED __builtin_amdgcn_sched_barrier(0)
    Unit cur, nxt; int ui = 0;
    if (!S.next(0, cur)) return;
    f32x4 acc[2][2][4][2];
#pragma unroll
    for (int a = 0; a < 2; ++a)
#pragma unroll
        for (int b = 0; b < 2; ++b)
#pragma unroll
            for (int m = 0; m < 4; ++m)
#pragma unroll
                for (int n = 0; n < 2; ++n) acc[a][b][m][n] = (f32x4){0.f, 0.f, 0.f, 0.f};
    bf16x8 At[4][2], B0[2][2], B1[2][2];
    const char* cA = GATHER ? (const char*)g.A : (const char*)g.A + (size_t)cur.am * tstep; const char* cB = (const char*)g.Bt + (size_t)cur.bn * tstep;
    if constexpr (GATHER) { PG8_GV(vg, cur); }
    if constexpr (SP2) {
        PG8_STAGE(PG8_SB(0, 0), cB, voffB); PG8_STAGE(PG8_SB(0, 1), cB + hstep, voffB); PG8_STAGE_A(PG8_SA(0, 0), cA, 0, vg); PG8_STAGE_A(PG8_SA(0, 1), cA, 1, vg);
        if (wr == 1) PG8_BAR;
        PG8_WAIT_V(2); PG8_BAR;
        PG8_STAGE(PG8_SB(1, 0), cB + kstep, voffB); PG8_STAGE_A(PG8_SA(1, 0), cA + kstep, 0, vg); PG8_STAGE(PG8_SB(1, 1), cB + hstep + kstep, voffB);
        PG8_WAIT_V(6); PG8_BAR;
    } else {
        PG8_STAGE(PG8_SB(0, 0), cB, voffB); PG8_STAGE_A(PG8_SA(0, 0), cA, 0, vg); PG8_STAGE(PG8_SB(0, 1), cB + hstep, voffB); PG8_STAGE_A(PG8_SA(0, 1), cA, 1, vg);
        if (wr == 1) PG8_BAR;
        PG8_WAIT_V(4); PG8_BAR;
        PG8_STAGE(PG8_SB(1, 0), cB + kstep, voffB); PG8_STAGE_A(PG8_SA(1, 0), cA + kstep, 0, vg); PG8_STAGE(PG8_SB(1, 1), cB + hstep + kstep, voffB);
        PG8_WAIT_V(6); PG8_BAR;
    }
    for (;;) {
        const bool has_next = S.next(ui + 1, nxt);
        const char* nA = GATHER ? cA : (has_next ? (const char*)g.A + (size_t)nxt.am * tstep : cA); const char* nB = has_next ? (const char*)g.Bt + (size_t)nxt.bn * tstep : cB;
        if constexpr (GATHER) { if (has_next) { PG8_GV(nvg, nxt); } else { _Pragma("unroll") for (int h_ = 0; h_ < 2; ++h_) _Pragma("unroll") for (int i_ = 0; i_ < 2; ++i_) nvg[h_][i_] = vg[h_][i_]; } }
        for (int t = 0; t < nt; t += 2) {
            const bool last = (t == nt - 2);
            const char* a1 = cA + (size_t)(t + 1) * kstep;
            const char* a2 = last ? nA : cA + (size_t)(t + 2) * kstep; const char* b2 = last ? nB : cB + (size_t)(t + 2) * kstep;
            const char* a3 = a2 + kstep; const char* b3 = b2 + kstep;
            unsigned sv[2][2];
            if constexpr (GATHER) { _Pragma("unroll") for (int h_ = 0; h_ < 2; ++h_) _Pragma("unroll") for (int i_ = 0; i_ < 2; ++i_) sv[h_][i_] = last ? nvg[h_][i_] : vg[h_][i_]; }
            if constexpr (SP2) {
            PG8_LDB(B0, 0, 0); PG8_LDB(B1, 0, 1); PG8_SCHED; PG8_LDA(At, 0, 0); PG8_STAGE_A(PG8_SA(1, 1), a1, 1, vg);
            PG8_WAIT_V(8); PG8_WAIT_L(0); PG8_BAR; PG8_MMA(0, 0, At, B0); PG8_MMA(0, 1, At, B1); PG8_BAR; PG8_SCHED;
            PG8_LDA(At, 0, 1); PG8_STAGE(PG8_SB(0, 0), b2, voffB); PG8_STAGE(PG8_SB(0, 1), b2 + hstep, voffB); PG8_STAGE_A(PG8_SA(0, 0), a2, 0, sv);
            PG8_WAIT_V(8); PG8_WAIT_L(0); PG8_BAR; PG8_MMA(1, 0, At, B0); PG8_MMA(1, 1, At, B1); PG8_BAR; PG8_SCHED;
            PG8_LDB(B0, 1, 0); PG8_LDB(B1, 1, 1); PG8_SCHED; PG8_LDA(At, 1, 0); PG8_STAGE_A(PG8_SA(0, 1), a2, 1, sv);
            PG8_WAIT_V(8); PG8_WAIT_L(0); PG8_BAR; PG8_MMA(0, 0, At, B0); PG8_MMA(0, 1, At, B1); PG8_BAR; PG8_SCHED;
            PG8_LDA(At, 1, 1); PG8_STAGE(PG8_SB(1, 0), b3, voffB); PG8_STAGE(PG8_SB(1, 1), b3 + hstep, voffB); PG8_STAGE_A(PG8_SA(1, 0), a3, 0, sv);
            PG8_WAIT_V(8); PG8_WAIT_L(0); PG8_BAR; PG8_MMA(1, 0, At, B0); PG8_MMA(1, 1, At, B1); PG8_BAR; PG8_SCHED;
            } else {
            PG8_LDB(B0, 0, 0); PG8_SCHED; PG8_LDA(At, 0, 0); PG8_STAGE_A(PG8_SA(1, 1), a1, 1, vg);
            PG8_WAIT_L(8); PG8_BAR; PG8_WAIT_L(0); PG8_MMA(0, 0, At, B0); PG8_BAR; PG8_SCHED;
            PG8_LDB(B1, 0, 1); PG8_STAGE(PG8_SB(0, 0), b2, voffB);
            PG8_BAR; PG8_WAIT_L(0); PG8_MMA(0, 1, At, B1); PG8_BAR;
            PG8_LDA(At, 0, 1); PG8_STAGE_A(PG8_SA(0, 0), a2, 0, sv);
            PG8_BAR; PG8_WAIT_L(0); PG8_MMA(1, 0, At, B0); PG8_BAR; PG8_SCHED;
            PG8_STAGE(PG8_SB(0, 1), b2 + hstep, voffB);
            PG8_WAIT_V(6); PG8_BAR; PG8_MMA(1, 1, At, B1); PG8_BAR;
            PG8_LDB(B0, 1, 0); PG8_SCHED; PG8_LDA(At, 1, 0); PG8_STAGE_A(PG8_SA(0, 1), a2, 1, sv);
            PG8_WAIT_L(8); PG8_BAR; PG8_WAIT_L(0); PG8_MMA(0, 0, At, B0); PG8_BAR; PG8_SCHED;
            PG8_LDB(B1, 1, 1); PG8_STAGE(PG8_SB(1, 0), b3, voffB);
            PG8_BAR; PG8_WAIT_L(0); PG8_MMA(0, 1, At, B1); PG8_BAR;
            PG8_LDA(At, 1, 1); PG8_STAGE_A(PG8_SA(1, 0), a3, 0, sv);
            PG8_BAR; PG8_WAIT_L(0); PG8_MMA(1, 0, At, B0); PG8_BAR; PG8_SCHED;
            PG8_STAGE(PG8_SB(1, 1), b3 + hstep, voffB);
            PG8_WAIT_V(6); PG8_BAR; PG8_MMA(1, 1, At, B1); PG8_BAR;
            }
        }
        if constexpr (ALIGN_EPI) { if (wr == 0) PG8_BAR; }
        E(acc, cur, wr, wc, fr, fq);
        if (!has_next) break;
#pragma unroll
        for (int a = 0; a < 2; ++a)
#pragma unroll
            for (int b = 0; b < 2; ++b)
#pragma unroll
                for (int m = 0; m < 4; ++m)
#pragma unroll
                    for (int n = 0; n < 2; ++n) acc[a][b][m][n] = (f32x4){0.f, 0.f, 0.f, 0.f};
        cur = nxt; cA = nA; cB = nB; ++ui;
        if constexpr (GATHER) { _Pragma("unroll") for (int h_ = 0; h_ < 2; ++h_) _Pragma("unroll") for (int i_ = 0; i_ < 2; ++i_) vg[h_][i_] = nvg[h_][i_]; }
        if constexpr (ALIGN_EPI) { if (wr == 1) PG8_BAR; }
    }
    PG8_WAIT_V(0);
    if constexpr (!ALIGN_EPI) { if (wr == 0) PG8_BAR; }
    PG8_BAR;
#undef PG8_GV
#undef PG8_SA
#undef PG8_SB
#undef PG8_STAGE
#undef PG8_STAGE_A
#undef PG8_LDA
#undef PG8_LDB
#undef PG8_MMA
#undef PG8_WAIT_V
#undef PG8_WAIT_L
#undef PG8_BAR
#undef PG8_SCHED
}
}


struct SchedGrid {
    int nM, nN, nwg, G, c, extra;
    __device__ void init(int nM_, int nN_, int G_, int c_, int extra_) { nM = nM_; nN = nN_; nwg = nM * nN; G = G_; c = c_; extra = extra_; }
    __device__ bool next(int i, pg8::Unit& u) const {
        const int L = i * G + c; if (L >= nwg + extra) return false;
        if (L >= nwg) { u.pm = nM + (L - nwg); u.pn = 2; }
        else { int wgid = L; { const int q = nwg / 8, r = nwg % 8, xcd = wgid % 8, off = wgid / 8; wgid = (xcd < r ? xcd * (q + 1) : r * (q + 1) + (xcd - r) * q) + off; }
               const int nig = 8 * nN, gid = wgid / nig, fm = gid * 8, gsz = (nM - fm) < 8 ? (nM - fm) : 8;
               u.pm = fm + ((wgid % nig) % gsz); u.pn = (wgid % nig) / gsz; }
        u.am = u.pm; u.bn = u.pn; u.e = 0; return true;
    }
};
struct SchedGateUp {
    int G, c;
    __device__ bool next(int i, pg8::Unit& u) const {
        int bt, pm;
        if (G == 256) { if (i >= 11) return false; const int x = c & 7, s = c >> 3; bt = i * 32 + x * 4 + (s >> 3); pm = s & 7; }
        else { const int L = i * G + c; if (L >= 2816) return false; bt = L >> 3; pm = L & 7; }
        u.e = bt / 22; u.pn = bt % 22; u.pm = pm; u.am = 0; u.bn = bt; return true;
    }
};
struct SchedDown {
    int G, c;
    __device__ bool next(int i, pg8::Unit& u) const {
        if (G == 256) { if (i >= 2) return false; const int x = c & 7, s = c >> 3; u.e = i * 8 + x; u.pm = s & 7; u.pn = s >> 3; }
        else { const int L = i * G + c; if (L >= 512) return false; u.e = L >> 5; u.pm = L & 7; u.pn = (L >> 3) & 3; }
        u.am = u.e * 8 + u.pm; u.bn = u.e * 4 + u.pn; return true;
    }
};

using pg8::f32x4; using pg8::u32x4;
__device__ __forceinline__ u32x4 pack8(const f32x4& a, const f32x4& b) { u32x4 w; w.x = pg8::cvt_pk_bf16(a[0], a[1]); w.y = pg8::cvt_pk_bf16(a[2], a[3]); w.z = pg8::cvt_pk_bf16(b[0], b[1]); w.w = pg8::cvt_pk_bf16(b[2], b[3]); return w; }
struct EpiInproj {
    static constexpr bool PERM = true;
    bf16_t *Q, *Kb, *Vb; float* PT; const float *rope, *qng, *kng;
    __device__ __forceinline__ void operator()(const f32x4 (&acc)[2][2][4][2], const pg8::Unit& u, int wr, int wc, int fr, int fq) const {
        const int row0 = u.pm * 256 + wr * 64 + fr;
        if (u.pn >= 3) {
            const int colb = u.pn * 256 + wc * 32 + fq * 8 - 768;
#pragma unroll
            for (int ai = 0; ai < 2; ++ai)
#pragma unroll
                for (int m = 0; m < 4; ++m) { const int row = row0 + ai * 128 + m * 16;
#pragma unroll
                    for (int bj = 0; bj < 2; ++bj)
#pragma unroll
                        for (int n = 0; n < 2; ++n)
#pragma unroll
                            for (int e = 0; e < 4; ++e) PT[(size_t)(colb + bj * 128 + n * 4 + e) * MTOK + row] = acc[ai][bj][m][n][e]; }
        } else if (u.pn == 2 && wc >= 2) {
#pragma unroll
            for (int ai = 0; ai < 2; ++ai)
#pragma unroll
                for (int m = 0; m < 4; ++m) { const int row = row0 + ai * 128 + m * 16;
                    size_t kvrow; if (row < MTOK) kvrow = (size_t)(row >> 13) * LK + (row & 8191); else { const int j = row - MTOK; kvrow = (size_t)(j >> 8) * LK + SEQ + (j & 255); }
#pragma unroll
                    for (int bj = 0; bj < 2; ++bj) *(u32x4*)(Vb + kvrow * 128 + (wc - 2) * 64 + bj * 32 + fq * 8) = pack8(acc[ai][bj][m][0], acc[ai][bj][m][1]); }
        } else {
            const bool isq = u.pn < 2; const float* gn = isq ? qng : kng;
            f32x4 g[2][2];
#pragma unroll
            for (int bj = 0; bj < 2; ++bj)
#pragma unroll
                for (int n = 0; n < 2; ++n) g[bj][n] = *(const f32x4*)(gn + bj * 32 + n * 16 + fq * 4);
#pragma unroll
            for (int ai = 0; ai < 2; ++ai)
#pragma unroll
                for (int m = 0; m < 4; ++m) { const int row = row0 + ai * 128 + m * 16; const bool tok = row < MTOK; const int t = row & 8191;
                    float ss = 0.f;
#pragma unroll
                    for (int bj = 0; bj < 2; ++bj)
#pragma unroll
                        for (int n = 0; n < 2; ++n) { const f32x4 v = acc[ai][bj][m][n]; ss += v[0] * v[0] + v[1] * v[1] + v[2] * v[2] + v[3] * v[3]; }
                    ss += __shfl_xor(ss, 16); ss += __shfl_xor(ss, 32);
                    const float rstd = rsqrtf(ss * (1.0f / 64.0f) + EPS);
                    bf16_t* dst; if (isq) dst = Q + (size_t)row * 512 + (4 * u.pn + wc) * 64;
                    else { size_t kvrow; if (tok) kvrow = (size_t)(row >> 13) * LK + t; else { const int j = row - MTOK; kvrow = (size_t)(j >> 8) * LK + SEQ + (j & 255); } dst = Kb + kvrow * 128 + wc * 64; }
#pragma unroll
                    for (int bj = 0; bj < 2; ++bj) {
                        f32x4 x1 = acc[ai][bj][m][0] * rstd * g[bj][0], x2 = acc[ai][bj][m][1] * rstd * g[bj][1];
                        if (tok) { const int pos = bj == 0 ? (t >> 6) : (t & 63);
                            const f32x4 ra = *(const f32x4*)(rope + (pos * 16 + fq * 4) * 2), rb = *(const f32x4*)(rope + (pos * 16 + fq * 4) * 2 + 4);
                            const f32x4 cs = {ra[0], ra[2], rb[0], rb[2]}, sn = {ra[1], ra[3], rb[1], rb[3]};
                            const f32x4 o1 = x1 * cs - x2 * sn, o2 = x1 * sn + x2 * cs; x1 = o1; x2 = o2; }
                        if (isq) { x1 = x1 * C2; x2 = x2 * C2; }
                        *(u32x4*)(dst + bj * 32 + fq * 8) = pack8(x1, x2);
                    } }
        }
    }
};
struct EpiOutproj {
    static constexpr bool PERM = false;
    const float* x; const float* modv; float* out;
    __device__ __forceinline__ void operator()(const f32x4 (&acc)[2][2][4][2], const pg8::Unit& u, int wr, int wc, int fr, int fq) const {
#pragma unroll
        for (int ai = 0; ai < 2; ++ai)
#pragma unroll
            for (int m = 0; m < 4; ++m) { const int row = u.pm * 256 + ai * 128 + wr * 64 + m * 16 + fr; const float* g1 = modv + (row >> 13) * 6144 + 2048;
#pragma unroll
                for (int bj = 0; bj < 2; ++bj)
#pragma unroll
                    for (int n = 0; n < 2; ++n) { const int col = u.pn * 256 + bj * 128 + wc * 32 + n * 16 + fq * 4;
                        const f32x4 xv = *(const f32x4*)(x + (size_t)row * DM + col), gv = *(const f32x4*)(g1 + col);
                        *(f32x4*)(out + (size_t)row * DM + col) = xv + gv * acc[ai][bj][m][n]; } }
    }
};
struct EpiGateUp {
    static constexpr bool PERM = true;
    bf16_t* H;
    __device__ __forceinline__ void operator()(const f32x4 (&acc)[2][2][4][2], const pg8::Unit& u, int wr, int wc, int fr, int fq) const {
#pragma unroll
        for (int ai = 0; ai < 2; ++ai)
#pragma unroll
            for (int m = 0; m < 4; ++m) { const int row = u.pm * 256 + ai * 128 + wr * 64 + m * 16 + fr;
                f32x4 o[2];
#pragma unroll
                for (int n = 0; n < 2; ++n)
#pragma unroll
                    for (int e = 0; e < 4; ++e) { const float gv = acc[ai][0][m][n][e]; o[n][e] = gv * __builtin_amdgcn_rcpf(1.0f + __builtin_amdgcn_exp2f(-1.4426950408889634f * gv)) * acc[ai][1][m][n][e]; }
                *(u32x4*)(H + ((size_t)(u.e * 2048 + row)) * DEXP_P + u.pn * 128 + wc * 32 + fq * 8) = pack8(o[0], o[1]); }
    }
};
struct EpiDown {
    static constexpr bool PERM = true;
    bf16_t* Y; const float* gate;
    __device__ __forceinline__ void operator()(const f32x4 (&acc)[2][2][4][2], const pg8::Unit& u, int wr, int wc, int fr, int fq) const {
#pragma unroll
        for (int ai = 0; ai < 2; ++ai)
#pragma unroll
            for (int m = 0; m < 4; ++m) { const int row = u.pm * 256 + ai * 128 + wr * 64 + m * 16 + fr;
                const float gt = gate[((row >> 10) * 16 + u.e) * CAP + (row & 1023)];
#pragma unroll
                for (int bj = 0; bj < 2; ++bj)
                    *(u32x4*)(Y + ((size_t)(u.e * 2048 + row)) * DM + u.pn * 256 + bj * 128 + wc * 32 + fq * 8) = pack8(acc[ai][bj][m][0] * gt, acc[ai][bj][m][1] * gt); }
    }
};

__device__ __forceinline__ int win_src_col(int g) {
    const int pn = g >> 8;
    if (pn >= 3) return g;
    const int bj = (g >> 7) & 1, wc = (g >> 5) & 3, ci = g & 31, fq = ci >> 3, n = (ci >> 2) & 1, j = ci & 3;
    const int dim = bj * 32 + n * 16 + fq * 4 + j;
    if (pn < 2) return (4 * pn + wc) * 64 + dim;
    if (wc < 2) return 512 + wc * 64 + dim;
    return 640 + (wc - 2) * 64 + bj * 32 + ci;
}
template <bool GATHERCOL>
__device__ __forceinline__ void cvt_item(const float* W, size_t ldn, int k0, int n0, bf16_t* dst, size_t ldk, float* scr, int lane) {
    if (GATHERCOL) {
        const int sc = win_src_col(n0 + lane);
#pragma unroll 16
        for (int k = 0; k < 64; ++k) scr[k * 65 + lane] = W[(size_t)(k0 + k) * ldn + sc];
    } else {
        const int kq = lane >> 4, n4 = 4 * (lane & 15);
        float4 v[16];
#pragma unroll
        for (int i = 0; i < 16; ++i) v[i] = *(const float4*)(W + (size_t)(k0 + 4 * i + kq) * ldn + n0 + n4);
#pragma unroll
        for (int i = 0; i < 16; ++i) { float* d = scr + (4 * i + kq) * 65 + n4; d[0] = v[i].x; d[1] = v[i].y; d[2] = v[i].z; d[3] = v[i].w; }
    }
    asm volatile("s_waitcnt lgkmcnt(0)" ::: "memory");
    const int c = lane >> 3, np = lane & 7;
#pragma unroll
    for (int j = 0; j < 8; ++j) { const int n = np + 8 * j; const float* sp = scr + (8 * c) * 65 + n;
        uint4 o; o.x = pk2(sp[0], sp[65]); o.y = pk2(sp[2 * 65], sp[3 * 65]); o.z = pk2(sp[4 * 65], sp[5 * 65]); o.w = pk2(sp[6 * 65], sp[7 * 65]);
        *(uint4*)(dst + (size_t)n * ldk + k0 + 8 * c) = o; }
    asm volatile("s_waitcnt lgkmcnt(0)" ::: "memory");
}
__device__ __forceinline__ void ph_convert(const P& p, unsigned char* lds) {
    const int tid = threadIdx.x, lane = tid & 63, wave = tid >> 6;
    float* scr = (float*)lds + wave * (64 * 65);
    const int gw = blockIdx.x * NWAVE + wave, NGW = gridDim.x * NWAVE;
    bf16_t* wgu = WSP(bf16_t, OFF_WGU); bf16_t* wd = WSP(bf16_t, OFF_WD); bf16_t* win = WSP(bf16_t, OFF_WIN); bf16_t* wout = WSP(bf16_t, OFF_WOUT);
    constexpr int I_G = 16 * 16 * 43, I_D = 16 * 43 * 16, I_O = 16 * 16, I_I = 16 * 36;
    for (int it = gw; it < 2 * I_G + I_D + I_O + I_I; it += NGW) {
        int r = it;
        if (r < 2 * I_G) { const int up = r >= I_G; if (up) r -= I_G; const int e = r / (16 * 43), q = r % (16 * 43), kb = q / 43, nb = q % 43;
            const float* W = (up ? p.w_up : p.w_gate) + (size_t)e * DM * DEXP;
            cvt_item<false>(W, DEXP, kb * 64, nb * 64, wgu + ((size_t)e * 5632 + (nb >> 1) * 256 + up * 128 + (nb & 1) * 64) * DM, DM, scr, lane); continue; }
        r -= 2 * I_G;
        if (r < I_D) { const int e = r / (43 * 16), q = r % (43 * 16), kb = q / 16, nb = q % 16;
            cvt_item<false>(p.w_down + (size_t)e * DEXP * DM, DM, kb * 64, nb * 64, wd + ((size_t)e * 1024 + nb * 64) * DEXP_P, DEXP_P, scr, lane); continue; }
        r -= I_D;
        if (r < I_O) { const int kb = r / 16, nb = r % 16; cvt_item<false>(p.w_out, DM, kb * 64, nb * 64, wout + (size_t)(nb * 64) * DM, DM, scr, lane); continue; }
        r -= I_O;
        { const int kb = r / 36, nb = r % 36; cvt_item<true>(p.w_in, INW, kb * 64, nb * 64, win + (size_t)(nb * 64) * DM, DM, scr, lane); }
    }
    const uint4 z = {0u, 0u, 0u, 0u};
    for (int i = blockIdx.x * NTHR + tid; i < 16 * 128 * 128; i += gridDim.x * NTHR) {
        const int e = i >> 14, rr = (i >> 7) & 127, ch = i & 127, row = 21 * 256 + (rr < 64 ? 64 + rr : 192 + (rr - 64));
        *(uint4*)(wgu + ((size_t)e * 5632 + row) * DM + ch * 8) = z; }
    for (int i = blockIdx.x * NTHR + tid; i < 16 * 1024 * 8; i += gridDim.x * NTHR) {
        *(uint4*)(wd + (size_t)(i >> 3) * DEXP_P + DEXP + (i & 7) * 8) = z; }
}

#define PG8_SP2 true
__device__ __forceinline__ void ph_inproj(const P& p, unsigned char* lds) {
    pg8::Gemm g{WSP(bf16_t, OFF_XN), WSP(bf16_t, OFF_WIN), DM, nullptr};
    SchedGrid S; S.init(64, 9, gridDim.x, blockIdx.x, 2);
    EpiInproj E{WSP(bf16_t, OFF_Q), WSP(bf16_t, OFF_K), WSP(bf16_t, OFF_V), WSP(float, OFF_PT), WSP(float, OFF_ROPE), p.qng, p.kng};
    pg8::gemm_phase<EpiInproj, SchedGrid, false, true, PG8_SP2>((PG8_LAS unsigned char*)lds, g, S, E);
}
__device__ __forceinline__ void ph_outproj(const P& p, unsigned char* lds) {
    pg8::Gemm g{WSP(bf16_t, OFF_AO), WSP(bf16_t, OFF_WOUT), DM, nullptr};
    SchedGrid S; S.init(64, 4, gridDim.x, blockIdx.x, 0);
    EpiOutproj E{p.x, WSP(float, OFF_MODV), p.out};
    pg8::gemm_phase<EpiOutproj, SchedGrid, false, true, PG8_SP2>((PG8_LAS unsigned char*)lds, g, S, E);
}
__device__ __forceinline__ void ph_gateup(const P& p, unsigned char* lds) {
    pg8::Gemm g{WSP(bf16_t, OFF_XN2), WSP(bf16_t, OFF_WGU), DM, WSP(int, OFF_IDX)};
    SchedGateUp S{(int)gridDim.x, (int)blockIdx.x};
    EpiGateUp E{WSP(bf16_t, OFF_H)};
    pg8::gemm_phase<EpiGateUp, SchedGateUp, true, true, PG8_SP2>((PG8_LAS unsigned char*)lds, g, S, E);
}
__device__ __forceinline__ void ph_down(const P& p, unsigned char* lds) {
    pg8::Gemm g{WSP(bf16_t, OFF_H), WSP(bf16_t, OFF_WD), DEXP_P, nullptr};
    SchedDown S{(int)gridDim.x, (int)blockIdx.x};
    EpiDown E{WSP(bf16_t, OFF_Y), WSP(float, OFF_GATE)};
    pg8::gemm_phase<EpiDown, SchedDown, false, true, PG8_SP2>((PG8_LAS unsigned char*)lds, g, S, E);
}


namespace attn_body {
using bf16x8 = __attribute__((ext_vector_type(8))) short;
using s16x4 = __attribute__((ext_vector_type(4))) short;
using f32x16 = __attribute__((ext_vector_type(16))) float;
using u32x4 = __attribute__((ext_vector_type(4))) unsigned;
constexpr int D = 64, QP = 512, KP = 128, OP = 1024;
constexpr int NW = 8, QBLK = 32, QB = QBLK * NW, KVBLK = 64;
__device__ __forceinline__ int crow(int r, int hi) { return (r & 3) + 8 * (r >> 2) + 4 * hi; }
#define SBAR() __builtin_amdgcn_sched_barrier(0)
constexpr int NSLOT = 3, SLOTB = 8192;
constexpr int LDS_K = 0, LDS_V = NSLOT * SLOTB, LDS_WS = 2 * NSLOT * SLOTB, LDS_OST = LDS_WS + NW * 64 * 4, ATTN_LDS_BYTES = LDS_OST + NW * 4096;
__device__ __forceinline__ void glds16(const void* gsrc, unsigned lds_dst) { unsigned keep;
    asm volatile("s_mov_b32 %0, m0\n\ts_mov_b32 m0, %2\n\ts_nop 0\n\tglobal_load_lds_dwordx4 %1, off\n\ts_mov_b32 m0, %0" : "=&s"(keep) : "v"(gsrc), "s"(lds_dst) : "memory"); }
__device__ __forceinline__ float max3f(float a, float b, float c) { float r; asm("v_max3_f32 %0, %1, %2, %3" : "=v"(r) : "v"(a), "v"(b), "v"(c)); return r; }
__device__ __forceinline__ float max2f(float a, float b) { float r; asm("v_max_f32_e32 %0, %1, %2" : "=v"(r) : "v"(a), "v"(b)); return r; }
__device__ __forceinline__ float fadd_s(float a, float b) { float r; asm("v_add_f32_e32 %0, %1, %2" : "=v"(r) : "v"(a), "v"(b)); return r; }
__device__ __forceinline__ float fsub_s(float a, float b) { float r; asm("v_sub_f32_e32 %0, %1, %2" : "=v"(r) : "v"(a), "v"(b)); return r; }
typedef float f32x2_t __attribute__((ext_vector_type(2))); typedef __bf16 bf16x2_t __attribute__((ext_vector_type(2)));
__device__ __forceinline__ unsigned cvtpk_s(float lo, float hi) { f32x2_t v = {lo, hi}; bf16x2_t b = __builtin_convertvector(v, bf16x2_t); return __builtin_bit_cast(unsigned, b); }
#define WAIT_BAR(N) asm volatile("s_waitcnt vmcnt(" #N ") lgkmcnt(0)\n\ts_barrier" ::: "memory")
__device__ __forceinline__ void qkt(f32x16& p0, f32x16& p1, const char* Kslot, const bf16x8* qr, const f32x16& negm, int r32, int hi) {
    const char* kb = Kslot + hi * 1024 + r32 * 16;
#pragma unroll
    for (int d0 = 0; d0 < 4; ++d0) {
        const bf16x8 b0 = *reinterpret_cast<const bf16x8*>(kb + d0 * 2048);
        const bf16x8 b1 = *reinterpret_cast<const bf16x8*>(kb + d0 * 2048 + 512);
        if (d0 == 0) { p0 = __builtin_amdgcn_mfma_f32_32x32x16_bf16(b0, qr[0], negm, 0, 0, 0); p1 = __builtin_amdgcn_mfma_f32_32x32x16_bf16(b1, qr[0], negm, 0, 0, 0); }
        else { p0 = __builtin_amdgcn_mfma_f32_32x32x16_bf16(b0, qr[d0], p0, 0, 0, 0); p1 = __builtin_amdgcn_mfma_f32_32x32x16_bf16(b1, qr[d0], p1, 0, 0, 0); } }
}
typedef __attribute__((address_space(3))) const char* lds_cptr;
typedef short v4i16_t __attribute__((ext_vector_type(4)));
__device__ __forceinline__ void kload8(bf16x8* kf, lds_cptr kp) {
    kf[0] = *(const __attribute__((address_space(3))) bf16x8*)(kp);        kf[1] = *(const __attribute__((address_space(3))) bf16x8*)(kp + 512);
    kf[2] = *(const __attribute__((address_space(3))) bf16x8*)(kp + 2048); kf[3] = *(const __attribute__((address_space(3))) bf16x8*)(kp + 2560);
    kf[4] = *(const __attribute__((address_space(3))) bf16x8*)(kp + 4096); kf[5] = *(const __attribute__((address_space(3))) bf16x8*)(kp + 4608);
    kf[6] = *(const __attribute__((address_space(3))) bf16x8*)(kp + 6144); kf[7] = *(const __attribute__((address_space(3))) bf16x8*)(kp + 6656);
}
__device__ __forceinline__ void kload2(bf16x8* kf, lds_cptr kp, int j) { kf[2 * j] = *(const __attribute__((address_space(3))) bf16x8*)(kp + j * 2048); kf[2 * j + 1] = *(const __attribute__((address_space(3))) bf16x8*)(kp + j * 2048 + 512); }
__device__ __forceinline__ s16x4 vtr(lds_cptr p) { return __builtin_bit_cast(s16x4, __builtin_amdgcn_ds_read_tr16_b64_v4i16((__attribute__((address_space(3))) v4i16_t*)p)); }
__device__ __forceinline__ float rowmax(const f32x16& p0, const f32x16& p1) {
    float a = max3f(p0[0], p0[1], p1[0]), b = max3f(p0[2], p0[3], p1[1]); a = max3f(a, p1[2], p1[3]);
#pragma unroll
    for (int r = 4; r < 16; r += 4) { a = max3f(a, p0[r], p0[r + 1]); b = max3f(b, p0[r + 2], p0[r + 3]); a = max3f(a, p1[r], p1[r + 1]); b = max3f(b, p1[r + 2], p1[r + 3]); }
    const float m = max2f(a, b);
    auto rr = __builtin_amdgcn_permlane32_swap(__float_as_uint(m), __float_as_uint(m), false, false);
    return max2f(__uint_as_float(rr[0]), __uint_as_float(rr[1]));
}
__device__ __forceinline__ void pv(f32x16* o, int vb, bf16x8 pa0, bf16x8 pa1, bf16x8 pa2, bf16x8 pa3) {
#pragma unroll
    for (int d0 = 0; d0 < 2; ++d0) { s16x4 lo[4], hi[4];
#pragma unroll
        for (int ks = 0; ks < 4; ++ks) {
            asm volatile("ds_read_b64_tr_b16 %0,%1 offset:%c2" : "=&v"(lo[ks]) : "v"(vb), "i"(d0 * 4096 + ks * 1024) : "memory");
            asm volatile("ds_read_b64_tr_b16 %0,%1 offset:%c2" : "=&v"(hi[ks]) : "v"(vb), "i"(d0 * 4096 + ks * 1024 + 512) : "memory"); }
        asm volatile("s_waitcnt lgkmcnt(0)" ::: "memory"); SBAR();
#define PK(k) (bf16x8){lo[k][0], lo[k][1], lo[k][2], lo[k][3], hi[k][0], hi[k][1], hi[k][2], hi[k][3]}
        o[d0] = __builtin_amdgcn_mfma_f32_32x32x16_bf16(pa0, PK(0), o[d0], 0, 0, 0);
        o[d0] = __builtin_amdgcn_mfma_f32_32x32x16_bf16(pa1, PK(1), o[d0], 0, 0, 0);
        o[d0] = __builtin_amdgcn_mfma_f32_32x32x16_bf16(pa2, PK(2), o[d0], 0, 0, 0);
        o[d0] = __builtin_amdgcn_mfma_f32_32x32x16_bf16(pa3, PK(3), o[d0], 0, 0, 0);
#undef PK
    }
}
template <int THRL> __device__ __forceinline__ void attn_unit(int b, int h, int qb, const bf16_t* Q, const bf16_t* __restrict__ K, const bf16_t* __restrict__ V, bf16_t* O, char* shm) {
    const int tid = threadIdx.x, lane = tid & 63, r32 = lane & 31, hi = lane >> 5; const int wid = __builtin_amdgcn_readfirstlane(tid >> 6);
    const int q0 = qb * QB;
    const bf16_t* Qw = Q + ((long)b * SEQ + q0 + wid * QBLK) * QP + h * D;
    const bf16_t* Kh = K + (long)b * LK * KP + (h >> 2) * D, *Vh = V + (long)b * LK * KP + (h >> 2) * D;
    const unsigned lds0 = (unsigned)(uintptr_t)shm;
    float* wsf = (float*)(shm + LDS_WS) + wid * 64;
    const bf16_t* ksrc = Kh + (long)lane * KP + wid * 8;
    const bf16_t* vsrc = Vh + (long)(16 * (wid & 3) + (lane >> 2)) * KP + (wid >> 2) * 32 + (lane & 3) * 8;
    const unsigned kdst = lds0 + LDS_K + wid * 1024, vdst = lds0 + LDS_V + wid * 1024;
#define DMA_K(t, slot) glds16(ksrc + (long)(t) * KVBLK * KP, (unsigned)__builtin_amdgcn_readfirstlane(kdst + (slot)))
#define DMA_V(t, slot) glds16(vsrc + (long)(t) * KVBLK * KP, (unsigned)__builtin_amdgcn_readfirstlane(vdst + (slot)))
    const int vb0 = (int)(lds0 + LDS_V) + ((lane >> 4) & 1) * 32 + (lane & 3) * 8 + (4 * hi + ((lane & 15) >> 2)) * 64;
    const char* Kbase = shm + LDS_K; bf16x8 kf[8];
    const lds_cptr shm3 = (lds_cptr)shm; const lds_cptr kp0 = shm3 + LDS_K + hi * 1024 + r32 * 16; const lds_cptr vp0 = shm3 + LDS_V + ((lane >> 4) & 1) * 32 + (lane & 3) * 8 + (4 * hi + ((lane & 15) >> 2)) * 64;
    constexpr int NT = LK / KVBLK;
    DMA_K(0, 0); DMA_V(0, 0); DMA_K(1, SLOTB);
    bf16x8 qr[4];
#pragma unroll
    for (int d0 = 0; d0 < 4; ++d0) qr[d0] = *reinterpret_cast<const bf16x8*>(&Qw[(long)r32 * QP + d0 * 16 + hi * 8]);
    float mhat = 0.f, l_reg = 0.f; f32x16 o[2]; o[0] = f32x16{}; o[1] = f32x16{}; f32x16 negm = f32x16{}; asm volatile("" : "+v"(negm));
    bool resc = false;
#define START(P0, P1) do { const float rm = rowmax(P0, P1); resc = false; \
    { const float dl = rm; mhat = fadd_s(mhat, dl); \
      _Pragma("unroll") for (int r = 0; r < 16; ++r) { P0[r] = fsub_s(P0[r], dl); P1[r] = fsub_s(P1[r], dl); } \
      _Pragma("unroll") for (int r = 0; r < 16; ++r) negm[r] = -mhat; asm volatile("" : "+v"(negm)); } \
    _Pragma("unroll") for (int r = 0; r < 16; ++r) P0[r] = __builtin_amdgcn_exp2f(P0[r]); } while (0)
#define RESC() do { if (resc) { asm volatile("s_waitcnt lgkmcnt(0)" ::: "memory"); \
      _Pragma("unroll") for (int d_ = 0; d_ < 2; ++d_) _Pragma("unroll") for (int r = 0; r < 16; ++r) o[d_][r] *= wsf[crow(r, hi)]; } } while (0)
    f32x16 pA0, pA1, pB0, pB1;
    int sl_prev = 0, sl_cur = 0, sl_next = SLOTB;
#define ROT() do { sl_prev = sl_cur; sl_cur = sl_next; sl_next = (sl_next == (NSLOT - 1) * SLOTB) ? 0 : sl_next + SLOTB; } while (0)
    DMA_K(2, 2 * SLOTB);
    WAIT_BAR(3);
    qkt(pA0, pA1, Kbase, qr, negm, r32, hi); asm volatile("s_nop 15\n\ts_nop 7" : "+v"(pA0), "+v"(pA1));
    START(pA0, pA1);
    _Pragma("unroll") for (int r = 0; r < 16; ++r) pA1[r] = __builtin_amdgcn_exp2f(pA1[r]);
    WAIT_BAR(0);
    DMA_K(3, 0); DMA_V(1, SLOTB);
    ROT();
    kload8(kf, kp0 + sl_cur);
    WAIT_BAR(2);
    s16x4 vlo[8], vhi[8]; u32x4 pw0, pw1, pw2, pw3;
#define PKW(P, B) cvtpk_s(P[B], P[B + 1])
#define PAF(k) __builtin_bit_cast(bf16x8, pw##k)
#define VFR(i) (bf16x8){vlo[i][0], vlo[i][1], vlo[i][2], vlo[i][3], vhi[i][0], vhi[i][1], vhi[i][2], vhi[i][3]}
#define PIN(x) asm volatile("" : "+v"(x))
#define MX3(a, b, c) __builtin_fmaxf(__builtin_fmaxf((a), (b)), (c))
#define GAPA(MF, A0, A1, A2, A3, W0, W1, PW) do { MF; sacc += A0; sacc += A1; sacc += A2; sacc += A3; PIN(sacc); W0; W1; PIN(PW); SBAR(); } while (0)
#define EX(v) __builtin_amdgcn_exp2f(v)
#define GAPB(MF, X, B) do { MF; X[B] = EX(X[B]); X[B + 1] = EX(X[B + 1]); X[B + 2] = EX(X[B + 2]); X[B + 3] = EX(X[B + 3]); PIN(X); SBAR(); } while (0)
#define VRD(i) do { vlo[i] = vtr(vp_ + (((i) >> 2) * 4096 + ((i) & 3) * 1024)); vhi[i] = vtr(vp_ + (((i) >> 2) * 4096 + ((i) & 3) * 1024 + 512)); } while (0)
#define KRD(G, j) do { if (G) { kload2(kf, kp0 + sl_next, j); SBAR(); } } while (0)
#define STEP(C0, C1, P0, P1, t, GK, GV, GL) do { SBAR(); \
    const lds_cptr vp_ = vp0 + sl_prev; \
    VRD(0); SBAR(); float sacc = (P0[0] + P0[1]); \
    GAPA(C0 = __builtin_amdgcn_mfma_f32_32x32x16_bf16(kf[0], qr[0], negm, 0, 0, 0), P0[2], P0[3], P0[4], P0[5],     pw0[0] = PKW(P0, 0), pw0[1] = PKW(P0, 2), pw0); \
    VRD(4); SBAR(); GAPA(C1 = __builtin_amdgcn_mfma_f32_32x32x16_bf16(kf[1], qr[0], negm, 0, 0, 0), P0[6], P0[7], P0[8], P0[9],     pw0[2] = PKW(P0, 4), pw0[3] = PKW(P0, 6), pw0); \
    VRD(1); SBAR(); GAPA(C0 = __builtin_amdgcn_mfma_f32_32x32x16_bf16(kf[2], qr[1], C0, 0, 0, 0),   P0[10], P0[11], P0[12], P0[13], pw1[0] = PKW(P0, 8), pw1[1] = PKW(P0, 10), pw1); \
    VRD(5); SBAR(); GAPA(C1 = __builtin_amdgcn_mfma_f32_32x32x16_bf16(kf[3], qr[1], C1, 0, 0, 0),   P0[14], P0[15], P1[0], P1[1],   pw1[2] = PKW(P0, 12), pw1[3] = PKW(P0, 14), pw1); \
    VRD(2); SBAR(); GAPA(C0 = __builtin_amdgcn_mfma_f32_32x32x16_bf16(kf[4], qr[2], C0, 0, 0, 0),   P1[2], P1[3], P1[4], P1[5],     pw2[0] = PKW(P1, 0), pw2[1] = PKW(P1, 2), pw2); \
    VRD(6); SBAR(); GAPA(C1 = __builtin_amdgcn_mfma_f32_32x32x16_bf16(kf[5], qr[2], C1, 0, 0, 0),   P1[6], P1[7], P1[8], P1[9],     pw2[2] = PKW(P1, 4), pw2[3] = PKW(P1, 6), pw2); \
    VRD(3); SBAR(); GAPA(C0 = __builtin_amdgcn_mfma_f32_32x32x16_bf16(kf[6], qr[3], C0, 0, 0, 0),   P1[10], P1[11], P1[12], P1[13], pw3[0] = PKW(P1, 8), pw3[1] = PKW(P1, 10), pw3); \
    VRD(7); SBAR(); GAPA(C1 = __builtin_amdgcn_mfma_f32_32x32x16_bf16(kf[7], qr[3], C1, 0, 0, 0),   P1[14], P1[15], 0.f, 0.f,       pw3[2] = PKW(P1, 12), pw3[3] = PKW(P1, 14), pw3); \
    l_reg += sacc; \
    if (GK) { DMA_K((t) + 3, sl_cur); } if (GV) { DMA_V((t) + 1, sl_next); } \
    { float a = MX3(C0[0], C0[1], C1[0]), b = MX3(C0[2], C0[3], C1[1]); a = MX3(a, C1[2], C1[3]); \
      _Pragma("unroll") for (int r = 4; r < 16; r += 4) { a = MX3(a, C0[r], C0[r + 1]); b = MX3(b, C0[r + 2], C0[r + 3]); a = MX3(a, C1[r], C1[r + 1]); b = MX3(b, C1[r + 2], C1[r + 3]); } \
      float rm = __builtin_fmaxf(a, b); { auto rr = __builtin_amdgcn_permlane32_swap(__float_as_uint(rm), __float_as_uint(rm), false, false); rm = __builtin_fmaxf(__uint_as_float(rr[0]), __uint_as_float(rr[1])); } \
      resc = false; \
      if (__builtin_expect(__any(rm > (float)THRL), 0)) { const float dl = __builtin_fmaxf(rm, 0.f); mhat += dl; \
        _Pragma("unroll") for (int r = 0; r < 16; ++r) { C0[r] -= dl; C1[r] -= dl; } \
        _Pragma("unroll") for (int r = 0; r < 16; ++r) negm[r] = -mhat; asm volatile("" : "+v"(negm)); \
        const float f = __builtin_amdgcn_exp2f(-dl); l_reg *= f; if (hi == 0) wsf[r32] = f; resc = true; } } \
    SBAR(); \
    GAPB(o[0] = __builtin_amdgcn_mfma_f32_32x32x16_bf16(PAF(0), VFR(0), o[0], 0, 0, 0), C0, 0); \
    GAPB(o[1] = __builtin_amdgcn_mfma_f32_32x32x16_bf16(PAF(0), VFR(4), o[1], 0, 0, 0), C0, 4); \
    KRD(GL, 0); GAPB(o[0] = __builtin_amdgcn_mfma_f32_32x32x16_bf16(PAF(1), VFR(1), o[0], 0, 0, 0), C0, 8); \
    KRD(GL, 1); GAPB(o[1] = __builtin_amdgcn_mfma_f32_32x32x16_bf16(PAF(1), VFR(5), o[1], 0, 0, 0), C0, 12); \
    KRD(GL, 2); GAPB(o[0] = __builtin_amdgcn_mfma_f32_32x32x16_bf16(PAF(2), VFR(2), o[0], 0, 0, 0), C1, 0); \
    KRD(GL, 3); GAPB(o[1] = __builtin_amdgcn_mfma_f32_32x32x16_bf16(PAF(2), VFR(6), o[1], 0, 0, 0), C1, 4); \
    GAPB(o[0] = __builtin_amdgcn_mfma_f32_32x32x16_bf16(PAF(3), VFR(3), o[0], 0, 0, 0), C1, 8); \
    GAPB(o[1] = __builtin_amdgcn_mfma_f32_32x32x16_bf16(PAF(3), VFR(7), o[1], 0, 0, 0), C1, 12); \
    } while (0)
    int t = 1;
    for (; t + 5 < NT; t += 2) {
        STEP(pB0, pB1, pA0, pA1, t, true, true, true);     WAIT_BAR(2); RESC(); ROT();
        STEP(pA0, pA1, pB0, pB1, t + 1, true, true, true); WAIT_BAR(2); RESC(); ROT();
    }
#define ENDW(tt) do { if ((tt) + 3 < NT) { WAIT_BAR(2); } else if ((tt) + 2 < NT) { WAIT_BAR(1); } else { WAIT_BAR(0); } } while (0)
    for (; t + 1 < NT; t += 2) {
        STEP(pB0, pB1, pA0, pA1, t, (t + 3 < NT), (t + 1 < NT), (t + 1 < NT));         ENDW(t);     RESC(); ROT();
        STEP(pA0, pA1, pB0, pB1, t + 1, (t + 4 < NT), (t + 2 < NT), (t + 2 < NT));     ENDW(t + 1); RESC(); ROT();
    }
    STEP(pB0, pB1, pA0, pA1, NT - 1, false, false, false); RESC();
    { float sacc = pB0[0] + pB0[1]; _Pragma("unroll") for (int r = 2; r < 16; ++r) sacc += pB0[r]; _Pragma("unroll") for (int r = 0; r < 16; ++r) sacc += pB1[r]; l_reg += sacc;
      pw0 = (u32x4){PKW(pB0, 0), PKW(pB0, 2), PKW(pB0, 4), PKW(pB0, 6)}; pw1 = (u32x4){PKW(pB0, 8), PKW(pB0, 10), PKW(pB0, 12), PKW(pB0, 14)}; pw2 = (u32x4){PKW(pB1, 0), PKW(pB1, 2), PKW(pB1, 4), PKW(pB1, 6)}; pw3 = (u32x4){PKW(pB1, 8), PKW(pB1, 10), PKW(pB1, 12), PKW(pB1, 14)};
      SBAR(); pv(o, vb0 + sl_cur, PAF(0), PAF(1), PAF(2), PAF(3)); }
#undef PKW
#undef PAF
#undef VFR
#undef PIN
#undef MX3
#undef GAPA
#undef GAPB
#undef EX
#undef VRD
#undef KRD
#undef STEP
#undef ENDW
    { auto rr = __builtin_amdgcn_permlane32_swap(__float_as_uint(l_reg), __float_as_uint(l_reg), false, false); l_reg = __uint_as_float(rr[0]) + __uint_as_float(rr[1]); }
    if (hi == 0) wsf[32 + r32] = l_reg; asm volatile("s_waitcnt lgkmcnt(0)" ::: "memory");
    float rli[16];
#pragma unroll
    for (int r = 0; r < 16; ++r) rli[r] = __builtin_amdgcn_rcpf(wsf[32 + crow(r, hi)]);
    bf16_t* Ow = O + ((long)b * SEQ + q0 + wid * QBLK) * OP + h * D;
    { bf16_t* stg = (bf16_t*)(shm + LDS_OST) + wid * 2048;
#pragma unroll
      for (int r = 0; r < 16; ++r) { const int orow = crow(r, hi);
#pragma unroll
          for (int d0 = 0; d0 < 2; ++d0) stg[orow * 64 + d0 * 32 + r32] = (bf16_t)f2bf(o[d0][r] * rli[r]); }
      asm volatile("s_waitcnt lgkmcnt(0)" ::: "memory");
#pragma unroll
      for (int i = 0; i < 4; ++i) { const int row = i * 8 + (lane >> 3), ch = lane & 7; const u32x4 v = *(const u32x4*)(stg + row * 64 + ch * 8); *(u32x4*)(Ow + (long)row * OP + ch * 8) = v; } }
    asm volatile("s_waitcnt lgkmcnt(0)\n\ts_barrier" ::: "memory");
#undef DMA_K
#undef DMA_V
#undef START
#undef RESC
#undef ROT
}
#undef SBAR
#undef WAIT_BAR
}
__device__ __forceinline__ void ph_attn(const P& p, unsigned char* lds) {
    const int G = gridDim.x, bx = blockIdx.x;
    for (int i = 0;; ++i) {
        int b, h, qb;
        if (G == 256) { if (i >= 2) break; const int vcu = (bx & 7) * 32 + (bx >> 3), X = vcu >> 5, pi = X >> 1, u = (X & 1) * 64 + (vcu & 31) * 2 + i; b = pi >> 1; h = (pi & 1) * 4 + (u >> 5); qb = u & 31; }
        else { const int L = i * G + bx; if (L >= 512) break; b = L >> 8; h = (L >> 5) & 7; qb = L & 31; }
        attn_body::attn_unit<8>(b, h, qb, WSP(bf16_t, OFF_Q), WSP(bf16_t, OFF_K), WSP(bf16_t, OFF_V), WSP(bf16_t, OFF_AO), (char*)lds);
    }
}


#define LAS __attribute__((address_space(3)))
#define XB_TMO      128
#define XB_XCNT(j)  (256  + 64 * (j))
#define XB_XSUB(j)  (1280 + 64 * (j))
#define XB_XGEN(j)  (2304 + 64 * (j))
#define XB_TOP      3328
#define XB_TOPGEN   3392
#define XCD_BAR_WORDS 3456
#define XB_SPIN_CAP (1u << 18)
__device__ __forceinline__ unsigned xb_ld(unsigned* p)              { return __hip_atomic_load(p, __ATOMIC_RELAXED, __HIP_MEMORY_SCOPE_AGENT); }
__device__ __forceinline__ unsigned xb_add(unsigned* p, unsigned v) { return __hip_atomic_fetch_add(p, v, __ATOMIC_RELAXED, __HIP_MEMORY_SCOPE_AGENT); }
__device__ __forceinline__ unsigned xb_xcc_id() { return (unsigned)__builtin_amdgcn_s_getreg((3 << 11) | 20) & 0xFu; }
#define XB_SPIN(cond, bar) do { unsigned _sp = 0; while (cond) { __builtin_amdgcn_s_sleep(1); \
    if ((++_sp & 255u) == 0u) { if (xb_ld(&(bar)[XB_TMO])) break; if (_sp > XB_SPIN_CAP) { atomicAdd(&(bar)[XB_TMO], 1u); break; } } } } while (0)
struct XcdBarrier { unsigned* bar; unsigned x; volatile LAS unsigned* st; };
__device__ __forceinline__ XcdBarrier xcd_barrier_post(unsigned* bar, volatile LAS unsigned* st) {
    XcdBarrier b; b.bar = bar; b.x = xb_xcc_id(); b.st = st;
    if (threadIdx.x == 0) (void)xb_add(&bar[XB_XCNT(b.x)], 1u);
    return b;
}
__device__ __forceinline__ void xcd_barrier_complete(unsigned* bar, unsigned x, unsigned& nloc, unsigned& nx) {
    const unsigned G = gridDim.x * gridDim.y * gridDim.z;
    unsigned sum, cnt, mine, sp = 0u;
    for (;;) {
        sum = 0u; cnt = 0u; mine = 0u;
#pragma unroll
        for (unsigned j = 0; j < 16; ++j) { const unsigned c = xb_ld(&bar[XB_XCNT(j)]); sum += c; cnt += (c > 0u) ? 1u : 0u; mine = (j == x) ? c : mine; }
        if (sum == G) break;
        __builtin_amdgcn_s_sleep(1);
        if ((++sp & 255u) == 0u) { if (xb_ld(&bar[XB_TMO])) break; if (sp > XB_SPIN_CAP) { atomicAdd(&bar[XB_TMO], 1u); break; } }
    }
    nloc = mine > 0u ? mine : 1u; nx = cnt > 0u ? cnt : 1u;
}
__device__ __forceinline__ void xcd_barrier(const XcdBarrier& b) {
    asm volatile("s_waitcnt vmcnt(0)" ::: "memory");
    __syncthreads();
    if (threadIdx.x == 0) {
        unsigned* bar = b.bar;
        __builtin_amdgcn_s_waitcnt(0);
        unsigned nloc = b.st[0], nx = b.st[1];
        if (nloc == 0u) { xcd_barrier_complete(bar, b.x, nloc, nx); b.st[0] = nloc; b.st[1] = nx; }
        const unsigned old = xb_add(&bar[XB_XSUB(b.x)], 1u);
        const unsigned gen = old / nloc;
        if (old + 1u == (gen + 1u) * nloc) {
            __builtin_amdgcn_fence(__ATOMIC_RELEASE, "agent");
            asm volatile("s_waitcnt vmcnt(0)" ::: "memory");
            const unsigned og = xb_add(&bar[XB_TOP], 1u);
            const unsigned tg = og / nx;
            if (og + 1u == (tg + 1u) * nx) xb_add(&bar[XB_TOPGEN], 1u);
            else XB_SPIN(xb_ld(&bar[XB_TOPGEN]) == tg, bar);
            __builtin_amdgcn_fence(__ATOMIC_ACQUIRE, "agent");
            xb_add(&bar[XB_XGEN(b.x)], 1u);
            asm volatile("s_waitcnt vmcnt(0)" ::: "memory");
        } else {
            XB_SPIN(xb_ld(&bar[XB_XGEN(b.x)]) == gen, bar);
            __builtin_amdgcn_fence(__ATOMIC_ACQUIRE, "agent");
            asm volatile("s_waitcnt vmcnt(0)" ::: "memory");
        }
    }
    __syncthreads();
}
constexpr int CW_BAR = 4096;
constexpr int MISC_OFF = LDS_BYTES - 64;

enum { PH_P0 = 0, PH_P1, PH_INPROJ, PH_MIX, PH_HYT, PH_OUTPROJ, PH_ROUTER, PH_TOPK, PH_GATEUP, PH_DOWN, PH_COMBINE, PH_N };
__global__ void __launch_bounds__(NTHR, 2) k_phases(P p, int lo, int hi) {
    extern __shared__ __attribute__((aligned(16))) unsigned char lds[];
    volatile LAS unsigned* misc = (volatile LAS unsigned*)((LAS unsigned char*)lds + MISC_OFF);
    if (threadIdx.x < 16) misc[threadIdx.x] = 0u;
    __syncthreads();
    XcdBarrier bar; bar.bar = WSP(unsigned, OFF_CTL) + CW_BAR; bar.x = 0; bar.st = misc;
    if (hi - lo > 1) bar = xcd_barrier_post(WSP(unsigned, OFF_CTL) + CW_BAR, misc);
#define IN(k) (lo <= (k) && (k) < hi)
#define SEAM(k) do { if (IN(k) && IN((k) + 1)) xcd_barrier(bar); } while (0)
    if (IN(PH_P0)) { ph_mod(p, (float*)lds); __syncthreads(); ph_rope(p); ph_h2(p, (float*)lds); __syncthreads(); ph_convert(p, lds); }
    SEAM(PH_P0);
    if (IN(PH_P1)) { ph_xn(p); ph_ht(p); }
    SEAM(PH_P1);
    if (IN(PH_INPROJ)) { ph_inproj(p, lds); }
    SEAM(PH_INPROJ);
    if (IN(PH_MIX)) { ph_attn(p, lds); __syncthreads(); ph_fft(p, lds); }
    SEAM(PH_MIX);
    if (IN(PH_HYT)) { ph_hyt(p, lds); }
    SEAM(PH_HYT);
    if (IN(PH_OUTPROJ)) { ph_outproj(p, lds); }
    SEAM(PH_OUTPROJ);
    if (IN(PH_ROUTER)) { ph_router(p, lds); }
    SEAM(PH_ROUTER);
    if (IN(PH_TOPK)) { ph_topk(p, lds); }
    SEAM(PH_TOPK);
    if (IN(PH_GATEUP)) { ph_gateup(p, lds); }
    SEAM(PH_GATEUP);
    if (IN(PH_DOWN)) { ph_down(p, lds); }
    SEAM(PH_DOWN);
    if (IN(PH_COMBINE)) { ph_combine(p); }
#undef IN
#undef SEAM
}

extern "C" void kernel_launch(void* const* d_in, const int* in_sizes, int n_in, void* d_out, int out_size, void* d_ws, size_t ws_size, hipStream_t stream) {
    static int init = 0;
    if (!init) {
        if (n_in != 25 || ws_size < WS_END) { fprintf(stderr, "kernel_launch: unexpected n_in %d / ws_size %zu\n", n_in, ws_size); init = -1; return; }
        if (hipFuncSetAttribute((const void*)k_phases, hipFuncAttributeMaxDynamicSharedMemorySize, LDS_BYTES) != hipSuccess) { fprintf(stderr, "hipFuncSetAttribute failed\n"); init = -1; return; }
        init = 1;
    }
    if (init < 0) return;
    P p{};
    const float** f = (const float**)&p.x;
    for (int i = 0; i < 25; ++i) f[i] = (const float*)d_in[i];
    p.out = (float*)d_out; p.ws = (unsigned char*)d_ws;
    for (int i = 0; i < 16; ++i) p.invf[i] = pow(10000.0, -(double)i / 16.0);
    (void)hipMemsetAsync((char*)d_ws + OFF_CTL, 0, CTL_BYTES, stream);
    const int G = 256;
#define PHASES(lo, hi) hipLaunchKernelGGL(k_phases, dim3(G), dim3(NTHR), LDS_BYTES, stream, p, (lo), (hi))
#if ONE_LAUNCH
    PHASES(0, PH_N);
#else
    for (int ph = 0; ph < PH_N; ++ph) PHASES(ph, ph + 1);
#endif
}
```

```cpp
#include <hip/hip_runtime.h>
#include <cstdio>
#include <cstdint>
#include <cmath>

#define ONE_LAUNCH 1
#ifndef EXTRA_PH
#define EXTRA_PH -1
#endif
#ifndef DUP_MASK
#define DUP_MASK 0
#endif
#define DUP(k) for (int rep_ = 0; rep_ < 1 + ((DUP_MASK >> (k)) & 1); ++rep_)
constexpr int DM = 1024, NB = 2, SEQ = 8192, CTXL = 256, LK = SEQ + CTXL;
constexpr int MTOK = NB * SEQ, MCTX = NB * CTXL, MALL = MTOK + MCTX;
constexpr int INW = 2304, NEXP = 16, CAP = 1024, DEXP = 2752, DEXP_P = 2816;
constexpr int NFFT = 16384;
constexpr float EPS = 1e-6f;
constexpr float C2 = 0.125f * 1.4426950408889634f;

typedef unsigned short bf16_t;

constexpr size_t MiB = 1u << 20;
constexpr size_t OFF_CTL = 0, CTL_BYTES = 1 * MiB;
constexpr size_t OFF_MODV = 1 * MiB;
constexpr size_t OFF_ROPE = 1 * MiB + 128 * 1024;
constexpr size_t OFF_H2 = 2 * MiB;
constexpr size_t OFF_AFF = 4 * MiB;
constexpr size_t OFF_INV = 5 * MiB;
constexpr size_t OFF_IDX = 6 * MiB;
constexpr size_t OFF_GATE = 6 * MiB + 128 * 1024;
constexpr size_t OFF_WIN = 8 * MiB, OFF_WOUT = 13 * MiB, OFF_WGU = 16 * MiB, OFF_WD = 192 * MiB;
constexpr size_t OFF_XN2 = 280 * MiB;
constexpr size_t OFF_XN = 312 * MiB;
constexpr size_t OFF_Q = 345 * MiB;
constexpr size_t OFF_K = 361 * MiB;
constexpr size_t OFF_V = 366 * MiB;
constexpr size_t OFF_PT = 371 * MiB;
constexpr size_t OFF_HT = 467 * MiB;
constexpr size_t OFF_H = 312 * MiB;
constexpr size_t OFF_AO = 499 * MiB;
constexpr size_t OFF_HYT = 531 * MiB;
constexpr size_t OFF_Y = 499 * MiB;
constexpr size_t OFF_PROJ = 563 * MiB;
constexpr size_t OFF_KF = 613 * MiB;
constexpr size_t WS_END = 677 * MiB;

struct P {
    const float *x, *c, *ctx, *c_ctx, *w_mod, *b_mod, *n1g, *n2g, *w_in, *w_out, *qng, *kng, *conv_w, *conv_b;
    const float *fw1, *fb1, *fw2, *fb2, *fw3, *ffreq, *hbias, *w_router, *w_gate, *w_up, *w_down;
    float* out; unsigned char* ws;
    double invf[16];
};

#define WSP(T, off) ((T*)(p.ws + (off)))

__device__ __forceinline__ unsigned f2bf(float f) { unsigned u = __float_as_uint(f); return (u + 0x7fffu + ((u >> 16) & 1u)) >> 16; }
__device__ __forceinline__ float bf2f(unsigned h) { return __uint_as_float(h << 16); }
__device__ __forceinline__ unsigned pk2(float lo, float hi) { return f2bf(lo) | (f2bf(hi) << 16); }
__device__ __forceinline__ float hw_sin_rev(float r) { return __builtin_amdgcn_sinf(r); }
__device__ __forceinline__ float hw_cos_rev(float r) { return __builtin_amdgcn_cosf(r); }
__device__ __forceinline__ float wave_sum(float v) {
#pragma unroll
    for (int o = 1; o < 64; o <<= 1) v += __shfl_xor(v, o);
    return v;
}

constexpr int NTHR = 512, NWAVE = 8;
constexpr int LDS_BYTES = 147456;

__device__ __forceinline__ void ph_mod(const P& p, float* lf) {
    const int tid = threadIdx.x, lane = tid & 63, wave = tid >> 6;
    float* sil = lf; float* red = lf + 3072;
    if ((int)blockIdx.x < 96) {
        for (int i = tid; i < 3072; i += NTHR) { const int r = i >> 10, k = i & 1023; const float v = r < 2 ? p.c[r * 1024 + k] : p.c_ctx[k]; sil[i] = v / (1.0f + expf(-v)); }
        __syncthreads();
        float* modv = WSP(float, OFF_MODV);
        for (int item = blockIdx.x; item < 96; item += gridDim.x) {
            const int col = item * 64 + lane, kb = wave * 128;
            float a0 = 0.f, a1 = 0.f, a2 = 0.f;
#pragma unroll 8
            for (int kk = 0; kk < 128; ++kk) { const float w = p.w_mod[(size_t)(kb + kk) * 6144 + col]; a0 += sil[kb + kk] * w; a1 += sil[1024 + kb + kk] * w; a2 += sil[2048 + kb + kk] * w; }
            red[(wave * 3 + 0) * 64 + lane] = a0; red[(wave * 3 + 1) * 64 + lane] = a1; red[(wave * 3 + 2) * 64 + lane] = a2;
            __syncthreads();
            if (wave < 3) { float s = p.b_mod[col];
#pragma unroll
                for (int w2 = 0; w2 < 8; ++w2) s += red[(w2 * 3 + wave) * 64 + lane];
                modv[wave * 6144 + col] = s; }
            __syncthreads();
        }
    }
}
__device__ __forceinline__ void ph_rope(const P& p) {
    float* rope = WSP(float, OFF_ROPE);
    for (int i = blockIdx.x * NTHR + threadIdx.x; i < 2048; i += gridDim.x * NTHR) {
        const int pos = i >> 4, f = i & 15;
        double r = (double)pos * p.invf[f] * 0.15915494309189535; r -= floor(r);
        rope[2 * i] = hw_cos_rev((float)r); rope[2 * i + 1] = hw_sin_rev((float)r);
    }
}
__device__ __forceinline__ void ph_h2(const P& p, float* lf) {
    const int tid = threadIdx.x, lane = tid & 63, wave = tid >> 6;
    float* zf = lf + wave * 40; float* h1 = lf + 8 * 40 + wave * 64;
    float* h2 = WSP(float, OFF_H2);
    const float fr = p.ffreq[lane];
    for (int item = blockIdx.x; item < 1024; item += gridDim.x) {
        const int t = item * 8 + wave;
        if (lane < 33) {
            float z;
            if (lane == 0) z = (float)t / 8191.0f;
            else { const int k = (lane - 1) & 15; const double fk = 1e-4 + (double)k * ((15.0 - 1e-4) / 15.0); double r = (double)t * fk / 8192.0; r -= floor(r);
                   z = lane <= 16 ? hw_cos_rev((float)r) : -hw_sin_rev((float)r); }
            zf[lane] = z;
        }
        __syncthreads();
        float a = p.fb1[lane];
#pragma unroll
        for (int i = 0; i < 33; ++i) a += zf[i] * p.fw1[i * 64 + lane];
        h1[lane] = hw_sin_rev(fr * a * 0.15915494309189535f);
        __syncthreads();
        float b = p.fb2[lane];
#pragma unroll 16
        for (int i = 0; i < 64; ++i) b += h1[i] * p.fw2[i * 64 + lane];
        h2[(size_t)t * 64 + lane] = hw_sin_rev(fr * b * 0.15915494309189535f);
        __syncthreads();
    }
}

__device__ __forceinline__ void ph_xn(const P& p) {
    const int tid = threadIdx.x, lane = tid & 63, wave = tid >> 6;
    const float* modv = WSP(float, OFF_MODV); bf16_t* xn = WSP(bf16_t, OFF_XN);
    for (int row = blockIdx.x * NWAVE + wave; row < MALL; row += gridDim.x * NWAVE) {
        const float* src = row < MTOK ? p.x + (size_t)row * DM : p.ctx + (size_t)(row - MTOK) * DM;
        const float* mv = modv + (row < MTOK ? (row >> 13) : 2) * 6144;
        float4 v[4]; float ss = 0.f;
#pragma unroll
        for (int j = 0; j < 4; ++j) { v[j] = *(const float4*)(src + 4 * lane + 256 * j); ss += v[j].x * v[j].x + v[j].y * v[j].y + v[j].z * v[j].z + v[j].w * v[j].w; }
        const float rstd = rsqrtf(wave_sum(ss) * (1.0f / DM) + EPS);
#pragma unroll
        for (int j = 0; j < 4; ++j) {
            const int c0 = 4 * lane + 256 * j;
            const float4 g = *(const float4*)(p.n1g + c0), sh = *(const float4*)(mv + c0), sc = *(const float4*)(mv + 1024 + c0);
            const float y0 = v[j].x * rstd * g.x * (1.f + sc.x) + sh.x, y1 = v[j].y * rstd * g.y * (1.f + sc.y) + sh.y;
            const float y2 = v[j].z * rstd * g.z * (1.f + sc.z) + sh.z, y3 = v[j].w * rstd * g.w * (1.f + sc.w) + sh.w;
            uint2 o; o.x = pk2(y0, y1); o.y = pk2(y2, y3);
            *(uint2*)(xn + (size_t)row * DM + c0) = o;
        }
    }
}
__device__ __forceinline__ void ph_ht(const P& p, unsigned char* lds) {
    typedef float f32x16_t __attribute__((ext_vector_type(16)));
    const int tid = threadIdx.x, lane = tid & 63, wave = tid >> 6, l31 = lane & 31, kh = lane >> 5;
    const float* h2 = WSP(float, OFF_H2); float* ht = WSP(float, OFF_HT);
    float* hs = (float*)lds + wave * (32 * 65);
    const float MIN_D = -3.0701134573253945f, MAX_D = -15.350567286626973f;
    for (int item = blockIdx.x * NWAVE + wave; item < 2048; item += gridDim.x * NWAVE) {
        const int tb = item >> 3, cg = item & 7, t0 = tb * 32;
        {
            float4 v[8];
#pragma unroll
            for (int i = 0; i < 8; ++i) v[i] = *(const float4*)(h2 + (size_t)t0 * 64 + (i * 64 + lane) * 4);
#pragma unroll
            for (int i = 0; i < 8; ++i) { const int id = i * 64 + lane, row = id >> 4, c4 = (id & 15) * 4; float* d = hs + row * 65 + c4; d[0] = v[i].x; d[1] = v[i].y; d[2] = v[i].z; d[3] = v[i].w; }
        }
        asm volatile("s_waitcnt lgkmcnt(0)" ::: "memory");
        float bv[32];
#pragma unroll
        for (int s2 = 0; s2 < 32; ++s2) bv[s2] = hs[l31 * 65 + 2 * s2 + kh];
        const float tn = (float)(t0 + l31) / 8191.0f;
#pragma unroll 1
        for (int ct = 0; ct < 4; ++ct) {
            const int col0 = cg * 128 + ct * 32;
            float av[32];
#pragma unroll
            for (int s2 = 0; s2 < 32; ++s2) av[s2] = p.fw3[(2 * s2 + kh) * 1024 + col0 + l31];
            f32x16_t acc = {0.f, 0.f, 0.f, 0.f, 0.f, 0.f, 0.f, 0.f, 0.f, 0.f, 0.f, 0.f, 0.f, 0.f, 0.f, 0.f};
#pragma unroll
            for (int s2 = 0; s2 < 32; ++s2) acc = __builtin_amdgcn_mfma_f32_32x32x2f32(av[s2], bv[s2], acc, 0, 0, 0);
#pragma unroll
            for (int r = 0; r < 16; ++r) {
                const int col = col0 + (r & 3) + 8 * (r >> 2) + 4 * kh;
                const float dl = MIN_D + (MAX_D - MIN_D) * (float)(col & 511) / 511.0f;
                ht[(size_t)col * 8192 + t0 + l31] = acc[r] * expf(-tn * fabsf(dl));
            }
        }
        asm volatile("s_waitcnt lgkmcnt(0)" ::: "memory");
    }
}

struct c2 { float x, y; };
__device__ __forceinline__ c2 cmul(c2 a, c2 b) { return c2{a.x * b.x - a.y * b.y, a.x * b.y + a.y * b.x}; }
__device__ __forceinline__ int fsw(int i) { return i ^ (((i >> 4) & 3) << 2); }
template <int LOGS, bool ZHI> __device__ __forceinline__ void r4_compute(const c2* X, c2 (&y)[8][4], int tid) {
#pragma unroll
    for (int i = 0; i < 8; ++i) {
        const int j = tid + 512 * i, pj = fsw(j);
        const c2 a = X[pj], b = X[pj + 4096];
        c2 c{0.f, 0.f}, d{0.f, 0.f};
        if (!ZHI) { c = X[pj + 8192]; d = X[pj + 12288]; }
        const c2 apc{a.x + c.x, a.y + c.y}, amc{a.x - c.x, a.y - c.y}, bpd{b.x + d.x, b.y + d.y}, bmd{b.x - d.x, b.y - d.y};
        const c2 jb{-bmd.y, bmd.x};
        c2 t0{apc.x + bpd.x, apc.y + bpd.y}, t1{amc.x - jb.x, amc.y - jb.y}, t2{apc.x - bpd.x, apc.y - bpd.y}, t3{amc.x + jb.x, amc.y + jb.y};
        if (LOGS < 12) {
            const int ps = (j >> LOGS) << LOGS;
            float r = (float)ps * (1.0f / 16384.0f);
            asm volatile("" : "+v"(r));
            const c2 w1{hw_cos_rev(r), -hw_sin_rev(r)};
            const c2 w2 = cmul(w1, w1), w3 = cmul(w1, w2);
            t1 = cmul(t1, w1); t2 = cmul(t2, w2); t3 = cmul(t3, w3);
        }
        y[i][0] = t0; y[i][1] = t1; y[i][2] = t2; y[i][3] = t3;
    }
}
template <int LOGS> __device__ __forceinline__ void r4_write(c2* X, const c2 (&y)[8][4], int tid) {
    constexpr int S = 1 << LOGS;
#pragma unroll
    for (int i = 0; i < 8; ++i) {
        const int j = tid + 512 * i;
        if (LOGS == 0) {
            float4* dst = (float4*)(X + fsw(4 * j));
            dst[0] = float4{y[i][0].x, y[i][0].y, y[i][1].x, y[i][1].y}; dst[1] = float4{y[i][2].x, y[i][2].y, y[i][3].x, y[i][3].y};
        } else {
            const int q = j & (S - 1), base = 4 * j - 3 * q;
#pragma unroll
            for (int k = 0; k < 4; ++k) X[fsw(base + k * S)] = y[i][k];
        }
    }
}
#define FFT_PASS(L, Z) do { asm volatile("" : "+v"(tid)); r4_compute<L, Z>(X, y, tid); __syncthreads(); asm volatile("" : "+v"(tid)); r4_write<L>(X, y, tid); __syncthreads(); } while (0)
template <bool ZHI> __device__ __forceinline__ void fft16k(c2* X, c2 (&y)[8][4], int tid) {
    FFT_PASS(0, ZHI); FFT_PASS(2, false); FFT_PASS(4, false); FFT_PASS(6, false); FFT_PASS(8, false); FFT_PASS(10, false);
    asm volatile("" : "+v"(tid));
    r4_compute<12, false>(X, y, tid);
}
__device__ __forceinline__ float4 conv3x4(const float* base, int t0, float w0, float w1, float w2, float cb) {
    const float4 c = *(const float4*)(base + t0);
    const float pm = t0 > 0 ? base[t0 - 1] : 0.f, pp = t0 + 4 < SEQ ? base[t0 + 4] : 0.f;
    float4 o; o.x = w0 * pm + w1 * c.x + w2 * c.y + cb; o.y = w0 * c.x + w1 * c.y + w2 * c.z + cb; o.z = w0 * c.y + w1 * c.z + w2 * c.w + cb; o.w = w0 * c.z + w1 * c.w + w2 * pp + cb;
    return o;
}
#define LAUNDER(v) asm volatile("" : "+v"(v))
__device__ __forceinline__ void ph_fft(const P& p, unsigned char* lds) {
    int tid = threadIdx.x; const int lane = tid & 63, wave = tid >> 6;
    c2* X = (c2*)lds; float* red = (float*)(lds + 131072);
    const float* ht = WSP(float, OFF_HT); const float* pt = WSP(float, OFF_PT); bf16_t* hyt = WSP(bf16_t, OFF_HYT);
    c2* kfg = WSP(c2, OFF_KF) + (size_t)blockIdx.x * (2 * NFFT);
    float4* stash = (float4*)(kfg + NFFT);
    for (int ch = blockIdx.x; ch < 512; ch += gridDim.x) {
        LAUNDER(tid);
        const float* hf = ht + (size_t)ch * 8192; const float* hb = ht + (size_t)(512 + ch) * 8192;
        float asum = 0.f;
        { float kv[32];
#pragma unroll
          for (int m = 0; m < 16; ++m) kv[m] = hf[tid + 512 * m];
#pragma unroll
          for (int m = 16; m < 32; ++m) { const int n = tid + 512 * m; kv[m] = (n == 8192) ? 0.f : hb[16384 - (n == 8192 ? 8193 : n)]; }
#pragma unroll
          for (int m = 0; m < 32; ++m) { asum += fabsf(kv[m]); X[fsw(tid + 512 * m)] = c2{kv[m], 0.f}; } }
        asum = wave_sum(asum); if (lane == 0) red[wave] = asum;
        __syncthreads();
        float tot = 0.f;
#pragma unroll
        for (int w = 0; w < 8; ++w) tot += red[w];
        const float scale = 1.0f / (tot * 16384.0f);
        c2 y[8][4];
        LAUNDER(tid);
        fft16k<false>(X, y, tid);
        LAUNDER(tid);
#pragma unroll
        for (int i = 0; i < 8; ++i) { int o = tid + i * 2048; LAUNDER(o);
#pragma unroll
            for (int k = 0; k < 4; ++k) kfg[o + k * 512] = y[i][k]; }
        __syncthreads();
        const float wa0 = p.conv_w[ch], wa1 = p.conv_w[1536 + ch], wa2 = p.conv_w[3072 + ch], ba = p.conv_b[ch];
        const float wx0 = p.conv_w[512 + ch], wx1 = p.conv_w[1536 + 512 + ch], wx2 = p.conv_w[3072 + 512 + ch], bx = p.conv_b[512 + ch];
        const float wv0 = p.conv_w[1024 + ch], wv1 = p.conv_w[1536 + 1024 + ch], wv2 = p.conv_w[3072 + 1024 + ch], bv = p.conv_b[1024 + ch];
        LAUNDER(tid);
        const float* p1 = pt + (size_t)ch * MTOK; const float* px = pt + (size_t)(512 + ch) * MTOK; const float* pv = pt + (size_t)(1024 + ch) * MTOK;
#pragma unroll 2
        for (int m = 0; m < 4; ++m) {
            const int t0 = 4 * (tid + 512 * m);
            const float4 a0 = conv3x4(p1, t0, wa0, wa1, wa2, ba), a1 = conv3x4(p1 + SEQ, t0, wa0, wa1, wa2, ba);
            const float4 v0 = conv3x4(pv, t0, wv0, wv1, wv2, bv), v1 = conv3x4(pv + SEQ, t0, wv0, wv1, wv2, bv);
            const float4 x0 = conv3x4(px, t0, wx0, wx1, wx2, bx), x1 = conv3x4(px + SEQ, t0, wx0, wx1, wx2, bx);
            const float4 u0 = {v0.x * a0.x, v0.y * a0.y, v0.z * a0.z, v0.w * a0.w}, u1 = {v1.x * a1.x, v1.y * a1.y, v1.z * a1.z, v1.w * a1.w};
            float4* dst = (float4*)(X + fsw(t0));
            dst[0] = float4{u0.x, u1.x, u0.y, u1.y}; dst[1] = float4{u0.z, u1.z, u0.w, u1.w};
            stash[t0] = float4{u0.x, u1.x, x0.x, x1.x}; stash[t0 + 1] = float4{u0.y, u1.y, x0.y, x1.y}; stash[t0 + 2] = float4{u0.z, u1.z, x0.z, x1.z}; stash[t0 + 3] = float4{u0.w, u1.w, x0.w, x1.w};
        }
        __syncthreads();
        LAUNDER(tid);
        fft16k<true>(X, y, tid);
        __syncthreads();
        LAUNDER(tid);
        { c2 kq[8][4];
#pragma unroll
          for (int i = 0; i < 8; ++i)
#pragma unroll
              for (int k = 0; k < 4; ++k) kq[i][k] = kfg[tid + i * 2048 + k * 512];
#pragma unroll
          for (int i = 0; i < 8; ++i)
#pragma unroll
              for (int k = 0; k < 4; ++k) { const c2 w = cmul(y[i][k], kq[i][k]); X[fsw(tid + 512 * i + 4096 * k)] = c2{w.x, -w.y}; } }
        __syncthreads();
        LAUNDER(tid);
        fft16k<false>(X, y, tid);
        LAUNDER(tid);
        const float bias = p.hbias[ch];
        { float4 st[8][2];
#pragma unroll
          for (int i = 0; i < 8; ++i)
#pragma unroll
              for (int k = 0; k < 2; ++k) st[i][k] = stash[tid + 512 * i + 4096 * k];
#pragma unroll
          for (int i = 0; i < 8; ++i)
#pragma unroll
              for (int k = 0; k < 2; ++k) {
                  const int t = tid + 512 * i + 4096 * k;
                  const float y0 = y[i][k].x * scale, y1 = -y[i][k].y * scale;
                  hyt[(size_t)ch * MTOK + t] = (bf16_t)f2bf((y0 + st[i][k].x * bias) * st[i][k].z);
                  hyt[(size_t)ch * MTOK + SEQ + t] = (bf16_t)f2bf((y1 + st[i][k].y * bias) * st[i][k].w);
              } }
        __syncthreads();
    }
}

__device__ __forceinline__ void ph_hyt(const P& p, unsigned char* lds) {
    const int tid = threadIdx.x;
    bf16_t* tile = (bf16_t*)lds;
    const bf16_t* hyt = WSP(bf16_t, OFF_HYT); bf16_t* ao = WSP(bf16_t, OFF_AO);
    for (int item = blockIdx.x; item < 2048; item += gridDim.x) {
        const int cg = item & 7, mg = item >> 3, c0 = cg * 64, m0 = mg * 64;
        { const int c = tid >> 3, ch = tid & 7; const uint4 v = *(const uint4*)(hyt + (size_t)(c0 + c) * MTOK + m0 + ch * 8); *(uint4*)(tile + c * 72 + ch * 8) = v; }
        __syncthreads();
        { const int m = tid >> 3, ch = tid & 7; unsigned w[4];
#pragma unroll
          for (int k = 0; k < 4; ++k) { const unsigned lo = tile[(ch * 8 + 2 * k) * 72 + m], hi = tile[(ch * 8 + 2 * k + 1) * 72 + m]; w[k] = lo | (hi << 16); }
          uint4 o; o.x = w[0]; o.y = w[1]; o.z = w[2]; o.w = w[3];
          *(uint4*)(ao + (size_t)(m0 + m) * DM + 512 + c0 + ch * 8) = o; }
        __syncthreads();
    }
}

__device__ __forceinline__ void ph_router(const P& p, unsigned char* lds) {
    const int tid = threadIdx.x, lane = tid & 63, wave = tid >> 6;
    float* wt = (float*)lds;
    float* rowb = (float*)(lds + 16 * 1028 * 4);
    const float* modv = WSP(float, OFF_MODV); bf16_t* xn2 = WSP(bf16_t, OFF_XN2); float* aff = WSP(float, OFF_AFF);
    for (int i = tid; i < 16384; i += NTHR) { const int k = i >> 4, e = i & 15; wt[e * 1028 + k] = p.w_router[i]; }
    __syncthreads();
    for (int item = blockIdx.x; item < MTOK / 8; item += gridDim.x) {
        const int row = item * 8 + wave, b = row >> 13, t = row & 8191;
        const float* src = p.out + (size_t)row * DM; const float* mv = modv + b * 6144;
        float4 v[4]; float ss = 0.f;
#pragma unroll
        for (int j = 0; j < 4; ++j) { v[j] = *(const float4*)(src + 4 * lane + 256 * j); ss += v[j].x * v[j].x + v[j].y * v[j].y + v[j].z * v[j].z + v[j].w * v[j].w; }
        const float rstd = rsqrtf(wave_sum(ss) * (1.0f / DM) + EPS);
        float* rb = rowb + wave * 1024;
#pragma unroll
        for (int j = 0; j < 4; ++j) {
            const int c0 = 4 * lane + 256 * j;
            const float4 g = *(const float4*)(p.n2g + c0), sh = *(const float4*)(mv + 3072 + c0), sc = *(const float4*)(mv + 4096 + c0);
            float4 y; y.x = v[j].x * rstd * g.x * (1.f + sc.x) + sh.x; y.y = v[j].y * rstd * g.y * (1.f + sc.y) + sh.y;
            y.z = v[j].z * rstd * g.z * (1.f + sc.z) + sh.z; y.w = v[j].w * rstd * g.w * (1.f + sc.w) + sh.w;
            uint2 o; o.x = pk2(y.x, y.y); o.y = pk2(y.z, y.w);
            *(uint2*)(xn2 + (size_t)row * DM + c0) = o;
            *(float4*)(rb + c0) = y;
        }
        __syncthreads();
        const int e = lane & 15, kq = lane >> 4;
        float acc = 0.f;
#pragma unroll 8
        for (int j = 0; j < 64; ++j) {
            const int k = 16 * j + 4 * kq;
            const float4 xv = *(const float4*)(rb + k), wv = *(const float4*)(wt + e * 1028 + k);
            acc += xv.x * wv.x + xv.y * wv.y + xv.z * wv.z + xv.w * wv.w;
        }
        acc += __shfl_xor(acc, 16); acc += __shfl_xor(acc, 32);
        float mx = acc;
#pragma unroll
        for (int o = 1; o < 16; o <<= 1) mx = fmaxf(mx, __shfl_xor(mx, o));
        const float ex = expf(acc - mx);
        float sm = ex;
#pragma unroll
        for (int o = 1; o < 16; o <<= 1) sm += __shfl_xor(sm, o);
        if (kq == 0) aff[(size_t)(b * 16 + e) * 8192 + t] = ex / sm;
        __syncthreads();
    }
}

__device__ __forceinline__ void ph_topk(const P& p, unsigned char* lds) {
    const int tid = threadIdx.x, lane = tid & 63, wave = tid >> 6;
    unsigned* hist = (unsigned*)lds; unsigned* wtot = hist + 256; unsigned* sel = hist + 272;
    const float* aff = WSP(float, OFF_AFF); int* idx = WSP(int, OFF_IDX); float* gate = WSP(float, OFF_GATE); int* inv = WSP(int, OFF_INV);
    for (int prob = blockIdx.x; prob < 32; prob += gridDim.x) {
        const float* a = aff + (size_t)prob * 8192 + tid * 16;
        float v[16]; unsigned key[16];
#pragma unroll
        for (int j = 0; j < 4; ++j) { const float4 q = *(const float4*)(a + 4 * j); v[4 * j] = q.x; v[4 * j + 1] = q.y; v[4 * j + 2] = q.z; v[4 * j + 3] = q.w; }
#pragma unroll
        for (int i = 0; i < 16; ++i) key[i] = __float_as_uint(v[i]);
        unsigned prefix = 0u, kk = CAP;
#pragma unroll
        for (int pass = 0; pass < 4; ++pass) {
            const int shift = 24 - 8 * pass;
            const unsigned mhi = pass == 0 ? 0u : (0xFFFFFFFFu << (shift + 8));
            if (tid < 256) hist[tid] = 0u;
            __syncthreads();
#pragma unroll
            for (int i = 0; i < 16; ++i) if ((key[i] & mhi) == prefix) atomicAdd(&hist[(key[i] >> shift) & 255u], 1u);
            __syncthreads();
            unsigned h = 0u, s = 0u;
            if (tid < 256) {
                h = hist[tid]; s = h;
#pragma unroll
                for (int o = 1; o < 64; o <<= 1) { const unsigned n = __shfl_down(s, o); if (lane + o < 64) s += n; }
                if (lane == 0) wtot[wave] = s;
            }
            __syncthreads();
            if (tid < 256) {
                for (int w2 = wave + 1; w2 < 4; ++w2) s += wtot[w2];
                const unsigned sex = s - h;
                if (s >= kk && sex < kk) { sel[0] = (unsigned)tid; sel[1] = kk - sex; }
            }
            __syncthreads();
            prefix |= sel[0] << shift; kk = sel[1];
            __syncthreads();
        }
        const unsigned thr = prefix, krem = kk;
        unsigned cnt = 0u;
#pragma unroll
        for (int i = 0; i < 16; ++i) cnt += (key[i] > thr ? 1u : 0u) + (key[i] == thr ? 0x10000u : 0u);
        unsigned inc = cnt;
#pragma unroll
        for (int o = 1; o < 64; o <<= 1) { const unsigned n = __shfl_up(inc, o); if (lane >= o) inc += n; }
        if (lane == 63) wtot[wave] = inc;
        __syncthreads();
        unsigned before = inc - cnt;
        for (int w2 = 0; w2 < wave; ++w2) before += wtot[w2];
        unsigned gtr = before & 0xFFFFu, eqr = before >> 16;
#pragma unroll
        for (int i = 0; i < 16; ++i) {
            const int t = tid * 16 + i;
            const bool g = key[i] > thr, q = key[i] == thr;
            const bool s = g || (q && eqr < krem);
            const unsigned pos = gtr + (eqr < krem ? eqr : krem);
            if (s) { idx[prob * CAP + pos] = t; gate[prob * CAP + pos] = v[i]; }
            inv[(size_t)prob * 8192 + t] = s ? (int)pos : -1;
            gtr += g ? 1u : 0u; eqr += q ? 1u : 0u;
        }
        __syncthreads();
    }
}

__device__ __forceinline__ void ph_combine(const P& p) {
    const int tid = threadIdx.x, lane = tid & 63, wave = tid >> 6;
    const float* modv = WSP(float, OFF_MODV); const int* inv = WSP(int, OFF_INV); const bf16_t* Y = WSP(bf16_t, OFF_Y);
    for (int row = blockIdx.x * NWAVE + wave; row < MTOK; row += gridDim.x * NWAVE) {
        const int b = row >> 13, t = row & 8191;
        const int myinv = lane < 16 ? inv[(size_t)(b * 16 + lane) * 8192 + t] : -1;
        unsigned long long mask = __ballot(myinv >= 0);
        float acc[16];
#pragma unroll
        for (int i = 0; i < 16; ++i) acc[i] = 0.f;
        while (mask) {
            const int e = __ffsll((long long)mask) - 1; mask &= mask - 1;
            const int pos = __shfl(myinv, e);
            const bf16_t* yr = Y + ((size_t)(e * 2048 + b * 1024 + pos)) * DM;
            const uint4 u0 = *(const uint4*)(yr + 8 * lane), u1 = *(const uint4*)(yr + 512 + 8 * lane);
            acc[0] += bf2f(u0.x & 0xFFFFu); acc[1] += bf2f(u0.x >> 16); acc[2] += bf2f(u0.y & 0xFFFFu); acc[3] += bf2f(u0.y >> 16);
            acc[4] += bf2f(u0.z & 0xFFFFu); acc[5] += bf2f(u0.z >> 16); acc[6] += bf2f(u0.w & 0xFFFFu); acc[7] += bf2f(u0.w >> 16);
            acc[8] += bf2f(u1.x & 0xFFFFu); acc[9] += bf2f(u1.x >> 16); acc[10] += bf2f(u1.y & 0xFFFFu); acc[11] += bf2f(u1.y >> 16);
            acc[12] += bf2f(u1.z & 0xFFFFu); acc[13] += bf2f(u1.z >> 16); acc[14] += bf2f(u1.w & 0xFFFFu); acc[15] += bf2f(u1.w >> 16);
        }
        const float* g2 = modv + b * 6144 + 5120;
        float* orow = p.out + (size_t)row * DM;
#pragma unroll
        for (int j = 0; j < 2; ++j)
#pragma unroll
            for (int h = 0; h < 2; ++h) {
                const int c0 = 512 * j + 8 * lane + 4 * h;
                const float4 xv = *(const float4*)(orow + c0), gv = *(const float4*)(g2 + c0);
                float4 o; o.x = xv.x + gv.x * acc[8 * j + 4 * h]; o.y = xv.y + gv.y * acc[8 * j + 4 * h + 1]; o.z = xv.z + gv.z * acc[8 * j + 4 * h + 2]; o.w = xv.w + gv.w * acc[8 * j + 4 * h + 3];
                *(float4*)(orow + c0) = o;
            }
    }
}


namespace pg8 {
#define PG8_LAS __attribute__((address_space(3)))
typedef short bf16x8 __attribute__((ext_vector_type(8)));
typedef float f32x4 __attribute__((ext_vector_type(4)));
typedef unsigned u32x4 __attribute__((ext_vector_type(4)));
constexpr int BM = 256, BK = 64, HALF = 128, HTB = HALF * BK * 2, STAGE_BYTES = 8 * HTB;
__host__ __device__ __forceinline__ int lds_byte(int r, int c) { const int st = (r >> 4) * 2 + (c >> 5), rr = r & 15, cc = c & 31, ob = rr * 64 + cc * 2; return st * 1024 + (ob ^ (((ob >> 9) & 1) << 5)); }
__host__ __device__ __forceinline__ void stage_rc(int b, int& R, int& C) { const int st = b / 1024, sb = b % 1024, swz = sb ^ (((sb >> 9) & 1) << 5); R = (st >> 1) * 16 + swz / 64; C = (st & 1) * 32 + (swz % 64) / 2; }
__host__ __device__ __forceinline__ int perm32(int rho) { const int n = rho >> 4, i = rho & 15; return 8 * (i >> 2) + 4 * n + (i & 3); }
struct Unit { int pm, pn, am, bn, e; };
struct Gemm { const bf16_t* A; const bf16_t* Bt; int K; const int* idx; };
__device__ __forceinline__ unsigned cvt_pk_bf16(float lo, float hi) { unsigned r; asm volatile("v_cvt_pk_bf16_f32 %0, %1, %2" : "=v"(r) : "v"(lo), "v"(hi)); return r; }

template <class Epi, class Sched, bool GATHER, bool ALIGN_EPI, bool SP2>
__device__ __forceinline__ void gemm_phase(PG8_LAS unsigned char* lds, const Gemm g, const Sched& S, const Epi& E) {
    const int tid = threadIdx.x, wid = __builtin_amdgcn_readfirstlane(tid >> 6), lane = tid & 63, wr = wid >> 2, wc = wid & 3, fr = lane & 15, fq = lane >> 4;
    const int K = g.K, nt = K / BK;
    unsigned voffA[2], voffB[2]; int Rr[2], Cc[2];
#pragma unroll
    for (int i = 0; i < 2; ++i) { int R, C; stage_rc(tid * 16 + i * 8192, R, C); const int Rb = Epi::PERM ? ((R & ~31) + perm32(R & 31)) : R;
        voffA[i] = (unsigned)(R * K + C) * 2u; voffB[i] = (unsigned)(Rb * K + C) * 2u; Rr[i] = R; Cc[i] = C; }
    const size_t kstep = (size_t)(BK * 2);
    const size_t hstep = (size_t)HALF * K * 2;
    const size_t tstep = 2 * hstep;
    const unsigned ldsw = (unsigned)wid * 1024u;
    const int aoff = lds_byte(wr * 64 + fr, fq * 8), boff = lds_byte(wc * 32 + fr, fq * 8);
    unsigned vg[2][2], nvg[2][2];
#define PG8_GV(dst, u) do { _Pragma("unroll") for (int h_ = 0; h_ < 2; ++h_) _Pragma("unroll") for (int i_ = 0; i_ < 2; ++i_) { const int m_ = (u).pm * 256 + h_ * 128 + Rr[i_]; const int b_ = m_ >> 10; \
        const int tok_ = g.idx[(b_ * 16 + (u).e) * 1024 + (m_ & 1023)]; dst[h_][i_] = (unsigned)((b_ * 8192 + tok_) * K + Cc[i_]) * 2u; } } while (0)
#define PG8_SA(b, h) (((b) * 2 + (h)) * HTB)
#define PG8_SB(b, h) ((4 + (b) * 2 + (h)) * HTB)
#define PG8_STAGE(bufoff, gbase, voff) do { _Pragma("unroll") for (int _i = 0; _i < 2; ++_i) \
        __builtin_amdgcn_global_load_lds((const unsigned*)((const char*)(gbase) + (voff)[_i]), (PG8_LAS unsigned*)(lds + (bufoff) + ldsw + _i * 8192), 16, 0, 0); } while (0)
#define PG8_STAGE_A(bufoff, kb, h, GV) do { if constexpr (GATHER) { PG8_STAGE(bufoff, kb, GV[h]); } else { PG8_STAGE(bufoff, (kb) + (h) * hstep, voffA); } } while (0)
#define PG8_LDA(dst, b, h) do { _Pragma("unroll") for (int m = 0; m < 4; ++m) _Pragma("unroll") for (int k = 0; k < 2; ++k) dst[m][k] = *(const PG8_LAS bf16x8*)(lds + PG8_SA(b, h) + aoff + m * 2048 + k * 1024); } while (0)
#define PG8_LDB(dst, b, h) do { _Pragma("unroll") for (int n = 0; n < 2; ++n) _Pragma("unroll") for (int k = 0; k < 2; ++k) dst[n][k] = *(const PG8_LAS bf16x8*)(lds + PG8_SB(b, h) + boff + n * 2048 + k * 1024); } while (0)
#define PG8_MMA(ai, bj, At, Bt) do { __builtin_amdgcn_s_setprio(1); _Pragma("unroll") for (int m = 0; m < 4; ++m) _Pragma("unroll") for (int n = 0; n < 2; ++n) _Pragma("unroll") for (int k = 0; k < 2; ++k) \
        acc[ai][bj][m][n] = __builtin_amdgcn_mfma_f32_16x16x32_bf16(Bt[n][k], At[m][k], acc[ai][bj][m][n], 0, 0, 0); __builtin_amdgcn_s_setprio(0); } while (0)
#define PG8_WAIT_V(n) asm volatile("s_waitcnt vmcnt(" #n ")" ::: "memory")
#define PG8_WAIT_L(n) asm volatile("s_waitcnt lgkmcnt(" #n ")" ::: "memory")
#define PG8_BAR __builtin_amdgcn_s_barrier()
#define PG8_SCHED __builtin_amdgcn_sched_barrier(0)
    Unit cur, nxt; int ui = 0;
    if (!S.next(0, cur)) return;
    f32x4 acc[2][2][4][2];
#pragma unroll
    for (int a = 0; a < 2; ++a)
#pragma unroll
        for (int b = 0; b < 2; ++b)
#pragma unroll
            for (int m = 0; m < 4; ++m)
#pragma unroll
                for (int n = 0; n < 2; ++n) acc[a][b][m][n] = (f32x4){0.f, 0.f, 0.f, 0.f};
    bf16x8 At[4][2], B0[2][2], B1[2][2];
    const char* cA = GATHER ? (const char*)g.A : (const char*)g.A + (size_t)cur.am * tstep; const char* cB = (const char*)g.Bt + (size_t)cur.bn * tstep;
    if constexpr (GATHER) { PG8_GV(vg, cur); }
    if constexpr (SP2) {
        PG8_STAGE(PG8_SB(0, 0), cB, voffB); PG8_STAGE(PG8_SB(0, 1), cB + hstep, voffB); PG8_STAGE_A(PG8_SA(0, 0), cA, 0, vg); PG8_STAGE_A(PG8_SA(0, 1), cA, 1, vg);
        if (wr == 1) PG8_BAR;
        PG8_WAIT_V(2); PG8_BAR;
        PG8_STAGE(PG8_SB(1, 0), cB + kstep, voffB); PG8_STAGE_A(PG8_SA(1, 0), cA + kstep, 0, vg); PG8_STAGE(PG8_SB(1, 1), cB + hstep + kstep, voffB);
        PG8_WAIT_V(6); PG8_BAR;
    } else {
        PG8_STAGE(PG8_SB(0, 0), cB, voffB); PG8_STAGE_A(PG8_SA(0, 0), cA, 0, vg); PG8_STAGE(PG8_SB(0, 1), cB + hstep, voffB); PG8_STAGE_A(PG8_SA(0, 1), cA, 1, vg);
        if (wr == 1) PG8_BAR;
        PG8_WAIT_V(4); PG8_BAR;
        PG8_STAGE(PG8_SB(1, 0), cB + kstep, voffB); PG8_STAGE_A(PG8_SA(1, 0), cA + kstep, 0, vg); PG8_STAGE(PG8_SB(1, 1), cB + hstep + kstep, voffB);
        PG8_WAIT_V(6); PG8_BAR;
    }
    for (;;) {
        const bool has_next = S.next(ui + 1, nxt);
        const char* nA = GATHER ? cA : (has_next ? (const char*)g.A + (size_t)nxt.am * tstep : cA); const char* nB = has_next ? (const char*)g.Bt + (size_t)nxt.bn * tstep : cB;
        if constexpr (GATHER) { if (has_next) { PG8_GV(nvg, nxt); } else { _Pragma("unroll") for (int h_ = 0; h_ < 2; ++h_) _Pragma("unroll") for (int i_ = 0; i_ < 2; ++i_) nvg[h_][i_] = vg[h_][i_]; } }
        for (int t = 0; t < nt; t += 2) {
            const bool last = (t == nt - 2);
            const char* a1 = cA + (size_t)(t + 1) * kstep;
            const char* a2 = last ? nA : cA + (size_t)(t + 2) * kstep; const char* b2 = last ? nB : cB + (size_t)(t + 2) * kstep;
            const char* a3 = a2 + kstep; const char* b3 = b2 + kstep;
            unsigned sv[2][2];
            if constexpr (GATHER) { _Pragma("unroll") for (int h_ = 0; h_ < 2; ++h_) _Pragma("unroll") for (int i_ = 0; i_ < 2; ++i_) sv[h_][i_] = last ? nvg[h_][i_] : vg[h_][i_]; }
            if constexpr (SP2) {
            PG8_LDB(B0, 0, 0); PG8_LDB(B1, 0, 1); PG8_SCHED; PG8_LDA(At, 0, 0); PG8_STAGE_A(PG8_SA(1, 1), a1, 1, vg);
            PG8_WAIT_V(8); PG8_WAIT_L(0); PG8_BAR; PG8_MMA(0, 0, At, B0); PG8_MMA(0, 1, At, B1); PG8_BAR; PG8_SCHED;
            PG8_LDA(At, 0, 1); PG8_STAGE(PG8_SB(0, 0), b2, voffB); PG8_STAGE(PG8_SB(0, 1), b2 + hstep, voffB); PG8_STAGE_A(PG8_SA(0, 0), a2, 0, sv);
            PG8_WAIT_V(8); PG8_WAIT_L(0); PG8_BAR; PG8_MMA(1, 0, At, B0); PG8_MMA(1, 1, At, B1); PG8_BAR; PG8_SCHED;
            PG8_LDB(B0, 1, 0); PG8_LDB(B1, 1, 1); PG8_SCHED; PG8_LDA(At, 1, 0); PG8_STAGE_A(PG8_SA(0, 1), a2, 1, sv);
            PG8_WAIT_V(8); PG8_WAIT_L(0); PG8_BAR; PG8_MMA(0, 0, At, B0); PG8_MMA(0, 1, At, B1); PG8_BAR; PG8_SCHED;
            PG8_LDA(At, 1, 1); PG8_STAGE(PG8_SB(1, 0), b3, voffB); PG8_STAGE(PG8_SB(1, 1), b3 + hstep, voffB); PG8_STAGE_A(PG8_SA(1, 0), a3, 0, sv);
            PG8_WAIT_V(8); PG8_WAIT_L(0); PG8_BAR; PG8_MMA(1, 0, At, B0); PG8_MMA(1, 1, At, B1); PG8_BAR; PG8_SCHED;
            } else {
            PG8_LDB(B0, 0, 0); PG8_SCHED; PG8_LDA(At, 0, 0); PG8_STAGE_A(PG8_SA(1, 1), a1, 1, vg);
            PG8_WAIT_L(8); PG8_BAR; PG8_WAIT_L(0); PG8_MMA(0, 0, At, B0); PG8_BAR; PG8_SCHED;
            PG8_LDB(B1, 0, 1); PG8_STAGE(PG8_SB(0, 0), b2, voffB);
            PG8_BAR; PG8_WAIT_L(0); PG8_MMA(0, 1, At, B1); PG8_BAR;
            PG8_LDA(At, 0, 1); PG8_STAGE_A(PG8_SA(0, 0), a2, 0, sv);
            PG8_BAR; PG8_WAIT_L(0); PG8_MMA(1, 0, At, B0); PG8_BAR; PG8_SCHED;
            PG8_STAGE(PG8_SB(0, 1), b2 + hstep, voffB);
            PG8_WAIT_V(6); PG8_BAR; PG8_MMA(1, 1, At, B1); PG8_BAR;
            PG8_LDB(B0, 1, 0); PG8_SCHED; PG8_LDA(At, 1, 0); PG8_STAGE_A(PG8_SA(0, 1), a2, 1, sv);
            PG8_WAIT_L(8); PG8_BAR; PG8_WAIT_L(0); PG8_MMA(0, 0, At, B0); PG8_BAR; PG8_SCHED;
            PG8_LDB(B1, 1, 1); PG8_STAGE(PG8_SB(1, 0), b3, voffB);
            PG8_BAR; PG8_WAIT_L(0); PG8_MMA(0, 1, At, B1); PG8_BAR;
            PG8_LDA(At, 1, 1); PG8_STAGE_A(PG8_SA(1, 0), a3, 0, sv);
            PG8_BAR; PG8_WAIT_L(0); PG8_MMA(1, 0, At, B0); PG8_BAR; PG8_SCHED;
            PG8_STAGE(PG8_SB(1, 1), b3 + hstep, voffB);
            PG8_WAIT_V(6); PG8_BAR; PG8_MMA(1, 1, At, B1); PG8_BAR;
            }
        }
        if constexpr (ALIGN_EPI) { if (wr == 0) PG8_BAR; }
        E(acc, cur, wr, wc, fr, fq);
        if (!has_next) break;
#pragma unroll
        for (int a = 0; a < 2; ++a)
#pragma unroll
            for (int b = 0; b < 2; ++b)
#pragma unroll
                for (int m = 0; m < 4; ++m)
#pragma unroll
                    for (int n = 0; n < 2; ++n) acc[a][b][m][n] = (f32x4){0.f, 0.f, 0.f, 0.f};
        cur = nxt; cA = nA; cB = nB; ++ui;
        if constexpr (GATHER) { _Pragma("unroll") for (int h_ = 0; h_ < 2; ++h_) _Pragma("unroll") for (int i_ = 0; i_ < 2; ++i_) vg[h_][i_] = nvg[h_][i_]; }
        if constexpr (ALIGN_EPI) { if (wr == 1) PG8_BAR; }
    }
    PG8_WAIT_V(0);
    if constexpr (!ALIGN_EPI) { if (wr == 0) PG8_BAR; }
    PG8_BAR;
#undef PG8_GV
#undef PG8_SA
#undef PG8_SB
#undef PG8_STAGE
#undef PG8_STAGE_A
#undef PG8_LDA
#undef PG8_LDB
#undef PG8_MMA
#undef PG8_WAIT_V
#undef PG8_WAIT_L
#undef PG8_BAR
#undef PG8_SCHED
}
}


struct SchedGrid {
    int nM, nN, nwg, G, c, extra;
    __device__ void init(int nM_, int nN_, int G_, int c_, int extra_) { nM = nM_; nN = nN_; nwg = nM * nN; G = G_; c = c_; extra = extra_; }
    __device__ bool next(int i, pg8::Unit& u) const {
        const int L = i * G + c; if (L >= nwg + extra) return false;
        if (L >= nwg) { u.pm = nM + (L - nwg); u.pn = 2; }
        else { int wgid = L; { const int q = nwg / 8, r = nwg % 8, xcd = wgid % 8, off = wgid / 8; wgid = (xcd < r ? xcd * (q + 1) : r * (q + 1) + (xcd - r) * q) + off; }
               const int nig = 8 * nN, gid = wgid / nig, fm = gid * 8, gsz = (nM - fm) < 8 ? (nM - fm) : 8;
               u.pm = fm + ((wgid % nig) % gsz); u.pn = (wgid % nig) / gsz; }
        u.am = u.pm; u.bn = u.pn; u.e = 0; return true;
    }
};
struct SchedGateUp {
    int G, c;
    __device__ bool next(int i, pg8::Unit& u) const {
        int bt, pm;
        if (G == 256) { if (i >= 11) return false; const int x = c & 7, s = c >> 3; bt = i * 32 + x * 4 + (s >> 3); pm = s & 7; }
        else { const int L = i * G + c; if (L >= 2816) return false; bt = L >> 3; pm = L & 7; }
        u.e = bt / 22; u.pn = bt % 22; u.pm = pm; u.am = 0; u.bn = bt; return true;
    }
};
struct SchedDown {
    int G, c;
    __device__ bool next(int i, pg8::Unit& u) const {
        if (G == 256) { if (i >= 2) return false; const int x = c & 7, s = c >> 3; u.e = i * 8 + x; u.pm = s & 7; u.pn = s >> 3; }
        else { const int L = i * G + c; if (L >= 512) return false; u.e = L >> 5; u.pm = L & 7; u.pn = (L >> 3) & 3; }
        u.am = u.e * 8 + u.pm; u.bn = u.e * 4 + u.pn; return true;
    }
};

using pg8::f32x4; using pg8::u32x4;
__device__ __forceinline__ u32x4 pack8(const f32x4& a, const f32x4& b) { u32x4 w; w.x = pg8::cvt_pk_bf16(a[0], a[1]); w.y = pg8::cvt_pk_bf16(a[2], a[3]); w.z = pg8::cvt_pk_bf16(b[0], b[1]); w.w = pg8::cvt_pk_bf16(b[2], b[3]); return w; }
struct EpiInproj {
    static constexpr bool PERM = true;
    bf16_t *Q, *Kb, *Vb; float* PT; const float *rope, *qng, *kng;
    __device__ __forceinline__ void operator()(const f32x4 (&acc)[2][2][4][2], const pg8::Unit& u, int wr, int wc, int fr, int fq) const {
        const int row0 = u.pm * 256 + wr * 64 + fr;
        if (u.pn >= 3) {
            const int colb = u.pn * 256 + wc * 32 + fq * 8 - 768;
#pragma unroll
            for (int ai = 0; ai < 2; ++ai)
#pragma unroll
                for (int m = 0; m < 4; ++m) { const int row = row0 + ai * 128 + m * 16;
#pragma unroll
                    for (int bj = 0; bj < 2; ++bj)
#pragma unroll
                        for (int n = 0; n < 2; ++n)
#pragma unroll
                            for (int e = 0; e < 4; ++e) PT[(size_t)(colb + bj * 128 + n * 4 + e) * MTOK + row] = acc[ai][bj][m][n][e]; }
        } else if (u.pn == 2 && wc >= 2) {
#pragma unroll
            for (int ai = 0; ai < 2; ++ai)
#pragma unroll
                for (int m = 0; m < 4; ++m) { const int row = row0 + ai * 128 + m * 16;
                    size_t kvrow; if (row < MTOK) kvrow = (size_t)(row >> 13) * LK + (row & 8191); else { const int j = row - MTOK; kvrow = (size_t)(j >> 8) * LK + SEQ + (j & 255); }
#pragma unroll
                    for (int bj = 0; bj < 2; ++bj) *(u32x4*)(Vb + kvrow * 128 + (wc - 2) * 64 + bj * 32 + fq * 8) = pack8(acc[ai][bj][m][0], acc[ai][bj][m][1]); }
        } else {
            const bool isq = u.pn < 2; const float* gn = isq ? qng : kng;
            f32x4 g[2][2];
#pragma unroll
            for (int bj = 0; bj < 2; ++bj)
#pragma unroll
                for (int n = 0; n < 2; ++n) g[bj][n] = *(const f32x4*)(gn + bj * 32 + n * 16 + fq * 4);
#pragma unroll
            for (int ai = 0; ai < 2; ++ai)
#pragma unroll
                for (int m = 0; m < 4; ++m) { const int row = row0 + ai * 128 + m * 16; const bool tok = row < MTOK; const int t = row & 8191;
                    float ss = 0.f;
#pragma unroll
                    for (int bj = 0; bj < 2; ++bj)
#pragma unroll
                        for (int n = 0; n < 2; ++n) { const f32x4 v = acc[ai][bj][m][n]; ss += v[0] * v[0] + v[1] * v[1] + v[2] * v[2] + v[3] * v[3]; }
                    ss += __shfl_xor(ss, 16); ss += __shfl_xor(ss, 32);
                    const float rstd = rsqrtf(ss * (1.0f / 64.0f) + EPS);
                    bf16_t* dst; if (isq) dst = Q + (size_t)row * 512 + (4 * u.pn + wc) * 64;
                    else { size_t kvrow; if (tok) kvrow = (size_t)(row >> 13) * LK + t; else { const int j = row - MTOK; kvrow = (size_t)(j >> 8) * LK + SEQ + (j & 255); } dst = Kb + kvrow * 128 + wc * 64; }
#pragma unroll
                    for (int bj = 0; bj < 2; ++bj) {
                        f32x4 x1 = acc[ai][bj][m][0] * rstd * g[bj][0], x2 = acc[ai][bj][m][1] * rstd * g[bj][1];
                        if (tok) { const int pos = bj == 0 ? (t >> 6) : (t & 63);
                            const f32x4 ra = *(const f32x4*)(rope + (pos * 16 + fq * 4) * 2), rb = *(const f32x4*)(rope + (pos * 16 + fq * 4) * 2 + 4);
                            const f32x4 cs = {ra[0], ra[2], rb[0], rb[2]}, sn = {ra[1], ra[3], rb[1], rb[3]};
                            const f32x4 o1 = x1 * cs - x2 * sn, o2 = x1 * sn + x2 * cs; x1 = o1; x2 = o2; }
                        if (isq) { x1 = x1 * C2; x2 = x2 * C2; }
                        *(u32x4*)(dst + bj * 32 + fq * 8) = pack8(x1, x2);
                    } }
        }
    }
};
struct EpiOutproj {
    static constexpr bool PERM = false;
    const float* x; const float* modv; float* out;
    __device__ __forceinline__ void operator()(const f32x4 (&acc)[2][2][4][2], const pg8::Unit& u, int wr, int wc, int fr, int fq) const {
#pragma unroll
        for (int ai = 0; ai < 2; ++ai)
#pragma unroll
            for (int m = 0; m < 4; ++m) { const int row = u.pm * 256 + ai * 128 + wr * 64 + m * 16 + fr; const float* g1 = modv + (row >> 13) * 6144 + 2048;
#pragma unroll
                for (int bj = 0; bj < 2; ++bj)
#pragma unroll
                    for (int n = 0; n < 2; ++n) { const int col = u.pn * 256 + bj * 128 + wc * 32 + n * 16 + fq * 4;
                        const f32x4 xv = *(const f32x4*)(x + (size_t)row * DM + col), gv = *(const f32x4*)(g1 + col);
                        *(f32x4*)(out + (size_t)row * DM + col) = xv + gv * acc[ai][bj][m][n]; } }
    }
};
struct EpiGateUp {
    static constexpr bool PERM = true;
    bf16_t* H;
    __device__ __forceinline__ void operator()(const f32x4 (&acc)[2][2][4][2], const pg8::Unit& u, int wr, int wc, int fr, int fq) const {
#pragma unroll
        for (int ai = 0; ai < 2; ++ai)
#pragma unroll
            for (int m = 0; m < 4; ++m) { const int row = u.pm * 256 + ai * 128 + wr * 64 + m * 16 + fr;
                f32x4 o[2];
#pragma unroll
                for (int n = 0; n < 2; ++n)
#pragma unroll
                    for (int e = 0; e < 4; ++e) { const float gv = acc[ai][0][m][n][e]; o[n][e] = gv * __builtin_amdgcn_rcpf(1.0f + __builtin_amdgcn_exp2f(-1.4426950408889634f * gv)) * acc[ai][1][m][n][e]; }
                *(u32x4*)(H + ((size_t)(u.e * 2048 + row)) * DEXP_P + u.pn * 128 + wc * 32 + fq * 8) = pack8(o[0], o[1]); }
    }
};
struct EpiDown {
    static constexpr bool PERM = true;
    bf16_t* Y; const float* gate;
    __device__ __forceinline__ void operator()(const f32x4 (&acc)[2][2][4][2], const pg8::Unit& u, int wr, int wc, int fr, int fq) const {
#pragma unroll
        for (int ai = 0; ai < 2; ++ai)
#pragma unroll
            for (int m = 0; m < 4; ++m) { const int row = u.pm * 256 + ai * 128 + wr * 64 + m * 16 + fr;
                const float gt = gate[((row >> 10) * 16 + u.e) * CAP + (row & 1023)];
#pragma unroll
                for (int bj = 0; bj < 2; ++bj)
                    *(u32x4*)(Y + ((size_t)(u.e * 2048 + row)) * DM + u.pn * 256 + bj * 128 + wc * 32 + fq * 8) = pack8(acc[ai][bj][m][0] * gt, acc[ai][bj][m][1] * gt); }
    }
};

__device__ __forceinline__ int win_src_col(int g) {
    const int pn = g >> 8;
    if (pn >= 3) return g;
    const int bj = (g >> 7) & 1, wc = (g >> 5) & 3, ci = g & 31, fq = ci >> 3, n = (ci >> 2) & 1, j = ci & 3;
    const int dim = bj * 32 + n * 16 + fq * 4 + j;
    if (pn < 2) return (4 * pn + wc) * 64 + dim;
    if (wc < 2) return 512 + wc * 64 + dim;
    return 640 + (wc - 2) * 64 + bj * 32 + ci;
}
struct CvtItem { const float* src; bf16_t* dst; size_t ldn, ldk; };
__device__ __forceinline__ void cvt_load(const CvtItem& c, float4 (&v)[16], int lane) {
    const int kq = lane >> 4, n4 = 4 * (lane & 15);
#pragma unroll
    for (int i = 0; i < 16; ++i) v[i] = *(const float4*)(c.src + (size_t)(4 * i + kq) * c.ldn + n4);
}
__device__ __forceinline__ void cvt_store_rows(bf16_t* dst, size_t ldk, const float* scr, int lane) {
    const int c = lane >> 3, np = lane & 7;
#pragma unroll
    for (int j = 0; j < 8; ++j) { const int n = np + 8 * j; const float* sp = scr + (8 * c) * 65 + n;
        uint4 o; o.x = pk2(sp[0], sp[65]); o.y = pk2(sp[2 * 65], sp[3 * 65]); o.z = pk2(sp[4 * 65], sp[5 * 65]); o.w = pk2(sp[6 * 65], sp[7 * 65]);
        *(uint4*)(dst + (size_t)n * ldk + 8 * c) = o; }
    asm volatile("s_waitcnt lgkmcnt(0)" ::: "memory");
}
__device__ __forceinline__ void cvt_finish(const CvtItem& c, const float4 (&v)[16], float* scr, int lane) {
    const int kq = lane >> 4, n4 = 4 * (lane & 15);
#pragma unroll
    for (int i = 0; i < 16; ++i) { float* d = scr + (4 * i + kq) * 65 + n4; d[0] = v[i].x; d[1] = v[i].y; d[2] = v[i].z; d[3] = v[i].w; }
    asm volatile("s_waitcnt lgkmcnt(0)" ::: "memory");
    cvt_store_rows(c.dst, c.ldk, scr, lane);
}
constexpr int CV_IG = 16 * 16 * 43, CV_ID = 16 * 43 * 16, CV_IO = 16 * 16, CV_II = 16 * 36, CV_NF = 2 * CV_IG + CV_ID + CV_IO;
__device__ __forceinline__ CvtItem cvt_decode(const P& p, int r) {
    CvtItem c;
    if (r < 2 * CV_IG) { const int up = r >= CV_IG; if (up) r -= CV_IG; const int e = r / (16 * 43), q = r % (16 * 43), kb = q / 43, nb = q % 43;
        c.src = (up ? p.w_up : p.w_gate) + (size_t)e * DM * DEXP + (size_t)(kb * 64) * DEXP + nb * 64; c.ldn = DEXP;
        c.dst = WSP(bf16_t, OFF_WGU) + ((size_t)e * 5632 + (nb >> 1) * 256 + up * 128 + (nb & 1) * 64) * DM + kb * 64; c.ldk = DM; return c; }
    r -= 2 * CV_IG;
    if (r < CV_ID) { const int e = r / (43 * 16), q = r % (43 * 16), kb = q / 16, nb = q % 16;
        c.src = p.w_down + (size_t)e * DEXP * DM + (size_t)(kb * 64) * DM + nb * 64; c.ldn = DM;
        c.dst = WSP(bf16_t, OFF_WD) + ((size_t)e * 1024 + nb * 64) * DEXP_P + kb * 64; c.ldk = DEXP_P; return c; }
    r -= CV_ID;
    { const int kb = r / 16, nb = r % 16; c.src = p.w_out + (size_t)(kb * 64) * DM + nb * 64; c.ldn = DM; c.dst = WSP(bf16_t, OFF_WOUT) + (size_t)(nb * 64) * DM + kb * 64; c.ldk = DM; }
    return c;
}
template <int PART> __device__ __forceinline__ void ph_convert(const P& p, unsigned char* lds, int grp = 0, int ngrp = 1) {
    const int tid = threadIdx.x, lane = tid & 63, wave = tid >> 6;
    float* scr = (float*)lds + wave * (64 * 65);
    const int gw = (PART == 0 ? blockIdx.x : (int)blockIdx.x / ngrp) * NWAVE + wave, NGW = (PART == 0 ? gridDim.x : (int)gridDim.x / ngrp) * NWAVE;
    bf16_t* wgu = WSP(bf16_t, OFF_WGU); bf16_t* wd = WSP(bf16_t, OFF_WD); bf16_t* win = WSP(bf16_t, OFF_WIN);
    if (PART == 0) for (int r = gw; r < CV_II; r += NGW) {
        const int kb = r / 36, nb = r % 36, sc = win_src_col(nb * 64 + lane);
#pragma unroll 16
        for (int k = 0; k < 64; ++k) scr[k * 65 + lane] = p.w_in[(size_t)(kb * 64 + k) * INW + sc];
        asm volatile("s_waitcnt lgkmcnt(0)" ::: "memory");
        cvt_store_rows(win + (size_t)(nb * 64) * DM + kb * 64, DM, scr, lane);
    }
    {
        const int NMOE = 2 * CV_IG + CV_ID, PER = NMOE / ngrp;
        const int IT0 = PART == 0 ? NMOE : grp * PER, IT1 = PART == 0 ? CV_NF : (grp + 1) * PER;
#pragma unroll 1
        for (int it = IT0 + gw; it < IT1; it += NGW) { float4 va[16]; const CvtItem ca = cvt_decode(p, it); cvt_load(ca, va, lane); cvt_finish(ca, va, scr, lane); }
    }
    if (PART == 0 || grp != 0) return;
    const uint4 z = {0u, 0u, 0u, 0u};
    for (int i = ((int)blockIdx.x / ngrp) * NTHR + tid; i < 16 * 128 * 128; i += ((int)gridDim.x / ngrp) * NTHR) {
        const int e = i >> 14, rr = (i >> 7) & 127, ch = i & 127, row = 21 * 256 + (rr < 64 ? 64 + rr : 192 + (rr - 64));
        *(uint4*)(wgu + ((size_t)e * 5632 + row) * DM + ch * 8) = z; }
    for (int i = ((int)blockIdx.x / ngrp) * NTHR + tid; i < 16 * 1024 * 8; i += ((int)gridDim.x / ngrp) * NTHR) {
        *(uint4*)(wd + (size_t)(i >> 3) * DEXP_P + DEXP + (i & 7) * 8) = z; }
}

#define PG8_SP2 true
__device__ __forceinline__ void ph_inproj(const P& p, unsigned char* lds) {
    pg8::Gemm g{WSP(bf16_t, OFF_XN), WSP(bf16_t, OFF_WIN), DM, nullptr};
    SchedGrid S; S.init(64, 9, gridDim.x, blockIdx.x, 2);
    EpiInproj E{WSP(bf16_t, OFF_Q), WSP(bf16_t, OFF_K), WSP(bf16_t, OFF_V), WSP(float, OFF_PT), WSP(float, OFF_ROPE), p.qng, p.kng};
    pg8::gemm_phase<EpiInproj, SchedGrid, false, true, PG8_SP2>((PG8_LAS unsigned char*)lds, g, S, E);
}
__device__ __forceinline__ void ph_outproj(const P& p, unsigned char* lds) {
    pg8::Gemm g{WSP(bf16_t, OFF_AO), WSP(bf16_t, OFF_WOUT), DM, nullptr};
    SchedGrid S; S.init(64, 4, gridDim.x, blockIdx.x, 0);
    EpiOutproj E{p.x, WSP(float, OFF_MODV), p.out};
    pg8::gemm_phase<EpiOutproj, SchedGrid, false, true, PG8_SP2>((PG8_LAS unsigned char*)lds, g, S, E);
}
__device__ __forceinline__ void ph_gateup(const P& p, unsigned char* lds) {
    pg8::Gemm g{WSP(bf16_t, OFF_XN2), WSP(bf16_t, OFF_WGU), DM, WSP(int, OFF_IDX)};
    SchedGateUp S{(int)gridDim.x, (int)blockIdx.x};
    EpiGateUp E{WSP(bf16_t, OFF_H)};
    pg8::gemm_phase<EpiGateUp, SchedGateUp, true, true, PG8_SP2>((PG8_LAS unsigned char*)lds, g, S, E);
}
__device__ __forceinline__ void ph_down(const P& p, unsigned char* lds) {
    pg8::Gemm g{WSP(bf16_t, OFF_H), WSP(bf16_t, OFF_WD), DEXP_P, nullptr};
    SchedDown S{(int)gridDim.x, (int)blockIdx.x};
    EpiDown E{WSP(bf16_t, OFF_Y), WSP(float, OFF_GATE)};
    pg8::gemm_phase<EpiDown, SchedDown, false, true, PG8_SP2>((PG8_LAS unsigned char*)lds, g, S, E);
}


namespace attn_body {
using bf16x8 = __attribute__((ext_vector_type(8))) short;
using s16x4 = __attribute__((ext_vector_type(4))) short;
using f32x16 = __attribute__((ext_vector_type(16))) float;
using u32x4 = __attribute__((ext_vector_type(4))) unsigned;
constexpr int D = 64, QP = 512, KP = 128, OP = 1024;
constexpr int NW = 8, QBLK = 32, QB = QBLK * NW, KVBLK = 64;
__device__ __forceinline__ int crow(int r, int hi) { return (r & 3) + 8 * (r >> 2) + 4 * hi; }
#define SBAR() __builtin_amdgcn_sched_barrier(0)
constexpr int NSLOT = 3, SLOTB = 8192;
constexpr int LDS_K = 0, LDS_V = NSLOT * SLOTB, LDS_WS = 2 * NSLOT * SLOTB, LDS_OST = LDS_WS + NW * 64 * 4, ATTN_LDS_BYTES = LDS_OST + NW * 4096;
__device__ __forceinline__ void glds16(const void* gsrc, unsigned lds_dst) { unsigned keep;
    asm volatile("s_mov_b32 %0, m0\n\ts_mov_b32 m0, %2\n\ts_nop 0\n\tglobal_load_lds_dwordx4 %1, off\n\ts_mov_b32 m0, %0" : "=&s"(keep) : "v"(gsrc), "s"(lds_dst) : "memory"); }
__device__ __forceinline__ float max3f(float a, float b, float c) { float r; asm("v_max3_f32 %0, %1, %2, %3" : "=v"(r) : "v"(a), "v"(b), "v"(c)); return r; }
__device__ __forceinline__ float max2f(float a, float b) { float r; asm("v_max_f32_e32 %0, %1, %2" : "=v"(r) : "v"(a), "v"(b)); return r; }
__device__ __forceinline__ float fadd_s(float a, float b) { float r; asm("v_add_f32_e32 %0, %1, %2" : "=v"(r) : "v"(a), "v"(b)); return r; }
__device__ __forceinline__ float fsub_s(float a, float b) { float r; asm("v_sub_f32_e32 %0, %1, %2" : "=v"(r) : "v"(a), "v"(b)); return r; }
typedef float f32x2_t __attribute__((ext_vector_type(2))); typedef __bf16 bf16x2_t __attribute__((ext_vector_type(2)));
__device__ __forceinline__ unsigned cvtpk_s(float lo, float hi) { f32x2_t v = {lo, hi}; bf16x2_t b = __builtin_convertvector(v, bf16x2_t); return __builtin_bit_cast(unsigned, b); }
#define WAIT_BAR(N) asm volatile("s_waitcnt vmcnt(" #N ") lgkmcnt(0)\n\ts_barrier" ::: "memory")
__device__ __forceinline__ void qkt(f32x16& p0, f32x16& p1, const char* Kslot, const bf16x8* qr, const f32x16& negm, int r32, int hi) {
    const char* kb = Kslot + hi * 1024 + r32 * 16;
#pragma unroll
    for (int d0 = 0; d0 < 4; ++d0) {
        const bf16x8 b0 = *reinterpret_cast<const bf16x8*>(kb + d0 * 2048);
        const bf16x8 b1 = *reinterpret_cast<const bf16x8*>(kb + d0 * 2048 + 512);
        if (d0 == 0) { p0 = __builtin_amdgcn_mfma_f32_32x32x16_bf16(b0, qr[0], negm, 0, 0, 0); p1 = __builtin_amdgcn_mfma_f32_32x32x16_bf16(b1, qr[0], negm, 0, 0, 0); }
        else { p0 = __builtin_amdgcn_mfma_f32_32x32x16_bf16(b0, qr[d0], p0, 0, 0, 0); p1 = __builtin_amdgcn_mfma_f32_32x32x16_bf16(b1, qr[d0], p1, 0, 0, 0); } }
}
typedef __attribute__((address_space(3))) const char* lds_cptr;
typedef short v4i16_t __attribute__((ext_vector_type(4)));
__device__ __forceinline__ void kload8(bf16x8* kf, lds_cptr kp) {
    kf[0] = *(const __attribute__((address_space(3))) bf16x8*)(kp);        kf[1] = *(const __attribute__((address_space(3))) bf16x8*)(kp + 512);
    kf[2] = *(const __attribute__((address_space(3))) bf16x8*)(kp + 2048); kf[3] = *(const __attribute__((address_space(3))) bf16x8*)(kp + 2560);
    kf[4] = *(const __attribute__((address_space(3))) bf16x8*)(kp + 4096); kf[5] = *(const __attribute__((address_space(3))) bf16x8*)(kp + 4608);
    kf[6] = *(const __attribute__((address_space(3))) bf16x8*)(kp + 6144); kf[7] = *(const __attribute__((address_space(3))) bf16x8*)(kp + 6656);
}
__device__ __forceinline__ void kload2(bf16x8* kf, lds_cptr kp, int j) { kf[2 * j] = *(const __attribute__((address_space(3))) bf16x8*)(kp + j * 2048); kf[2 * j + 1] = *(const __attribute__((address_space(3))) bf16x8*)(kp + j * 2048 + 512); }
__device__ __forceinline__ s16x4 vtr(lds_cptr p) { return __builtin_bit_cast(s16x4, __builtin_amdgcn_ds_read_tr16_b64_v4i16((__attribute__((address_space(3))) v4i16_t*)p)); }
__device__ __forceinline__ float rowmax(const f32x16& p0, const f32x16& p1) {
    float a = max3f(p0[0], p0[1], p1[0]), b = max3f(p0[2], p0[3], p1[1]); a = max3f(a, p1[2], p1[3]);
#pragma unroll
    for (int r = 4; r < 16; r += 4) { a = max3f(a, p0[r], p0[r + 1]); b = max3f(b, p0[r + 2], p0[r + 3]); a = max3f(a, p1[r], p1[r + 1]); b = max3f(b, p1[r + 2], p1[r + 3]); }
    const float m = max2f(a, b);
    auto rr = __builtin_amdgcn_permlane32_swap(__float_as_uint(m), __float_as_uint(m), false, false);
    return max2f(__uint_as_float(rr[0]), __uint_as_float(rr[1]));
}
__device__ __forceinline__ void pv(f32x16* o, int vb, bf16x8 pa0, bf16x8 pa1, bf16x8 pa2, bf16x8 pa3) {
#pragma unroll
    for (int d0 = 0; d0 < 2; ++d0) { s16x4 lo[4], hi[4];
#pragma unroll
        for (int ks = 0; ks < 4; ++ks) {
            asm volatile("ds_read_b64_tr_b16 %0,%1 offset:%c2" : "=&v"(lo[ks]) : "v"(vb), "i"(d0 * 4096 + ks * 1024) : "memory");
            asm volatile("ds_read_b64_tr_b16 %0,%1 offset:%c2" : "=&v"(hi[ks]) : "v"(vb), "i"(d0 * 4096 + ks * 1024 + 512) : "memory"); }
        asm volatile("s_waitcnt lgkmcnt(0)" ::: "memory"); SBAR();
#define PK(k) (bf16x8){lo[k][0], lo[k][1], lo[k][2], lo[k][3], hi[k][0], hi[k][1], hi[k][2], hi[k][3]}
        o[d0] = __builtin_amdgcn_mfma_f32_32x32x16_bf16(pa0, PK(0), o[d0], 0, 0, 0);
        o[d0] = __builtin_amdgcn_mfma_f32_32x32x16_bf16(pa1, PK(1), o[d0], 0, 0, 0);
        o[d0] = __builtin_amdgcn_mfma_f32_32x32x16_bf16(pa2, PK(2), o[d0], 0, 0, 0);
        o[d0] = __builtin_amdgcn_mfma_f32_32x32x16_bf16(pa3, PK(3), o[d0], 0, 0, 0);
#undef PK
    }
}
template <int THRL> __device__ __forceinline__ void attn_unit(int b, int h, int qb, const bf16_t* Q, const bf16_t* __restrict__ K, const bf16_t* __restrict__ V, bf16_t* O, char* shm) {
    const int tid = threadIdx.x, lane = tid & 63, r32 = lane & 31, hi = lane >> 5; const int wid = __builtin_amdgcn_readfirstlane(tid >> 6);
    const int q0 = qb * QB;
    const bf16_t* Qw = Q + ((long)b * SEQ + q0 + wid * QBLK) * QP + h * D;
    const bf16_t* Kh = K + (long)b * LK * KP + (h >> 2) * D, *Vh = V + (long)b * LK * KP + (h >> 2) * D;
    const unsigned lds0 = (unsigned)(uintptr_t)shm;
    float* wsf = (float*)(shm + LDS_WS) + wid * 64;
    const bf16_t* ksrc = Kh + (long)lane * KP + wid * 8;
    const bf16_t* vsrc = Vh + (long)(16 * (wid & 3) + (lane >> 2)) * KP + (wid >> 2) * 32 + (lane & 3) * 8;
    const unsigned kdst = lds0 + LDS_K + wid * 1024, vdst = lds0 + LDS_V + wid * 1024;
#define DMA_K(t, slot) glds16(ksrc + (long)(t) * KVBLK * KP, (unsigned)__builtin_amdgcn_readfirstlane(kdst + (slot)))
#define DMA_V(t, slot) glds16(vsrc + (long)(t) * KVBLK * KP, (unsigned)__builtin_amdgcn_readfirstlane(vdst + (slot)))
    const int vb0 = (int)(lds0 + LDS_V) + ((lane >> 4) & 1) * 32 + (lane & 3) * 8 + (4 * hi + ((lane & 15) >> 2)) * 64;
    const char* Kbase = shm + LDS_K; bf16x8 kf[8];
    const lds_cptr shm3 = (lds_cptr)shm; const lds_cptr kp0 = shm3 + LDS_K + hi * 1024 + r32 * 16; const lds_cptr vp0 = shm3 + LDS_V + ((lane >> 4) & 1) * 32 + (lane & 3) * 8 + (4 * hi + ((lane & 15) >> 2)) * 64;
    constexpr int NT = LK / KVBLK;
    DMA_K(0, 0); DMA_V(0, 0); DMA_K(1, SLOTB);
    bf16x8 qr[4];
#pragma unroll
    for (int d0 = 0; d0 < 4; ++d0) qr[d0] = *reinterpret_cast<const bf16x8*>(&Qw[(long)r32 * QP + d0 * 16 + hi * 8]);
    float mhat = 0.f, l_reg = 0.f; f32x16 o[2]; o[0] = f32x16{}; o[1] = f32x16{}; f32x16 negm = f32x16{}; asm volatile("" : "+v"(negm));
    bool resc = false;
#define START(P0, P1) do { const float rm = rowmax(P0, P1); resc = false; \
    { const float dl = rm; mhat = fadd_s(mhat, dl); \
      _Pragma("unroll") for (int r = 0; r < 16; ++r) { P0[r] = fsub_s(P0[r], dl); P1[r] = fsub_s(P1[r], dl); } \
      _Pragma("unroll") for (int r = 0; r < 16; ++r) negm[r] = -mhat; asm volatile("" : "+v"(negm)); } \
    _Pragma("unroll") for (int r = 0; r < 16; ++r) P0[r] = __builtin_amdgcn_exp2f(P0[r]); } while (0)
#define RESC() do { if (resc) { asm volatile("s_waitcnt lgkmcnt(0)" ::: "memory"); \
      _Pragma("unroll") for (int d_ = 0; d_ < 2; ++d_) _Pragma("unroll") for (int r = 0; r < 16; ++r) o[d_][r] *= wsf[crow(r, hi)]; } } while (0)
    f32x16 pA0, pA1, pB0, pB1;
    int sl_prev = 0, sl_cur = 0, sl_next = SLOTB;
#define ROT() do { sl_prev = sl_cur; sl_cur = sl_next; sl_next = (sl_next == (NSLOT - 1) * SLOTB) ? 0 : sl_next + SLOTB; } while (0)
    DMA_K(2, 2 * SLOTB);
    WAIT_BAR(3);
    qkt(pA0, pA1, Kbase, qr, negm, r32, hi); asm volatile("s_nop 15\n\ts_nop 7" : "+v"(pA0), "+v"(pA1));
    START(pA0, pA1);
    _Pragma("unroll") for (int r = 0; r < 16; ++r) pA1[r] = __builtin_amdgcn_exp2f(pA1[r]);
    WAIT_BAR(0);
    DMA_K(3, 0); DMA_V(1, SLOTB);
    ROT();
    kload8(kf, kp0 + sl_cur);
    WAIT_BAR(2);
    s16x4 vlo[8], vhi[8]; u32x4 pw0, pw1, pw2, pw3;
#define PKW(P, B) cvtpk_s(P[B], P[B + 1])
#define PAF(k) __builtin_bit_cast(bf16x8, pw##k)
#define VFR(i) (bf16x8){vlo[i][0], vlo[i][1], vlo[i][2], vlo[i][3], vhi[i][0], vhi[i][1], vhi[i][2], vhi[i][3]}
#define PIN(x) asm volatile("" : "+v"(x))
#define MX3(a, b, c) __builtin_fmaxf(__builtin_fmaxf((a), (b)), (c))
#define GAPA(MF, A0, A1, A2, A3, W0, W1, PW) do { MF; sacc += A0; sacc += A1; sacc += A2; sacc += A3; PIN(sacc); W0; W1; PIN(PW); SBAR(); } while (0)
#define EX(v) __builtin_amdgcn_exp2f(v)
#define GAPB(MF, X, B) do { MF; X[B] = EX(X[B]); X[B + 1] = EX(X[B + 1]); X[B + 2] = EX(X[B + 2]); X[B + 3] = EX(X[B + 3]); PIN(X); SBAR(); } while (0)
#define VRD(i) do { vlo[i] = vtr(vp_ + (((i) >> 2) * 4096 + ((i) & 3) * 1024)); vhi[i] = vtr(vp_ + (((i) >> 2) * 4096 + ((i) & 3) * 1024 + 512)); } while (0)
#define KRD(G, j) do { if (G) { kload2(kf, kp0 + sl_next, j); SBAR(); } } while (0)
#define STEP(C0, C1, P0, P1, t, GK, GV, GL) do { SBAR(); \
    const lds_cptr vp_ = vp0 + sl_prev; \
    VRD(0); SBAR(); float sacc = (P0[0] + P0[1]); \
    GAPA(C0 = __builtin_amdgcn_mfma_f32_32x32x16_bf16(kf[0], qr[0], negm, 0, 0, 0), P0[2], P0[3], P0[4], P0[5],     pw0[0] = PKW(P0, 0), pw0[1] = PKW(P0, 2), pw0); \
    VRD(4); SBAR(); GAPA(C1 = __builtin_amdgcn_mfma_f32_32x32x16_bf16(kf[1], qr[0], negm, 0, 0, 0), P0[6], P0[7], P0[8], P0[9],     pw0[2] = PKW(P0, 4), pw0[3] = PKW(P0, 6), pw0); \
    VRD(1); SBAR(); GAPA(C0 = __builtin_amdgcn_mfma_f32_32x32x16_bf16(kf[2], qr[1], C0, 0, 0, 0),   P0[10], P0[11], P0[12], P0[13], pw1[0] = PKW(P0, 8), pw1[1] = PKW(P0, 10), pw1); \
    VRD(5); SBAR(); GAPA(C1 = __builtin_amdgcn_mfma_f32_32x32x16_bf16(kf[3], qr[1], C1, 0, 0, 0),   P0[14], P0[15], P1[0], P1[1],   pw1[2] = PKW(P0, 12), pw1[3] = PKW(P0, 14), pw1); \
    VRD(2); SBAR(); GAPA(C0 = __builtin_amdgcn_mfma_f32_32x32x16_bf16(kf[4], qr[2], C0, 0, 0, 0),   P1[2], P1[3], P1[4], P1[5],     pw2[0] = PKW(P1, 0), pw2[1] = PKW(P1, 2), pw2); \
    VRD(6); SBAR(); GAPA(C1 = __builtin_amdgcn_mfma_f32_32x32x16_bf16(kf[5], qr[2], C1, 0, 0, 0),   P1[6], P1[7], P1[8], P1[9],     pw2[2] = PKW(P1, 4), pw2[3] = PKW(P1, 6), pw2); \
    VRD(3); SBAR(); GAPA(C0 = __builtin_amdgcn_mfma_f32_32x32x16_bf16(kf[6], qr[3], C0, 0, 0, 0),   P1[10], P1[11], P1[12], P1[13], pw3[0] = PKW(P1, 8), pw3[1] = PKW(P1, 10), pw3); \
    VRD(7); SBAR(); GAPA(C1 = __builtin_amdgcn_mfma_f32_32x32x16_bf16(kf[7], qr[3], C1, 0, 0, 0),   P1[14], P1[15], 0.f, 0.f,       pw3[2] = PKW(P1, 12), pw3[3] = PKW(P1, 14), pw3); \
    l_reg += sacc; \
    if (GK) { DMA_K((t) + 3, sl_cur); } if (GV) { DMA_V((t) + 1, sl_next); } \
    { float a = MX3(C0[0], C0[1], C1[0]), b = MX3(C0[2], C0[3], C1[1]); a = MX3(a, C1[2], C1[3]); \
      _Pragma("unroll") for (int r = 4; r < 16; r += 4) { a = MX3(a, C0[r], C0[r + 1]); b = MX3(b, C0[r + 2], C0[r + 3]); a = MX3(a, C1[r], C1[r + 1]); b = MX3(b, C1[r + 2], C1[r + 3]); } \
      float rm = __builtin_fmaxf(a, b); { auto rr = __builtin_amdgcn_permlane32_swap(__float_as_uint(rm), __float_as_uint(rm), false, false); rm = __builtin_fmaxf(__uint_as_float(rr[0]), __uint_as_float(rr[1])); } \
      resc = false; \
      if (__builtin_expect(__any(rm > (float)THRL), 0)) { const float dl = __builtin_fmaxf(rm, 0.f); mhat += dl; \
        _Pragma("unroll") for (int r = 0; r < 16; ++r) { C0[r] -= dl; C1[r] -= dl; } \
        _Pragma("unroll") for (int r = 0; r < 16; ++r) negm[r] = -mhat; asm volatile("" : "+v"(negm)); \
        const float f = __builtin_amdgcn_exp2f(-dl); l_reg *= f; if (hi == 0) wsf[r32] = f; resc = true; } } \
    SBAR(); \
    GAPB(o[0] = __builtin_amdgcn_mfma_f32_32x32x16_bf16(PAF(0), VFR(0), o[0], 0, 0, 0), C0, 0); \
    GAPB(o[1] = __builtin_amdgcn_mfma_f32_32x32x16_bf16(PAF(0), VFR(4), o[1], 0, 0, 0), C0, 4); \
    KRD(GL, 0); GAPB(o[0] = __builtin_amdgcn_mfma_f32_32x32x16_bf16(PAF(1), VFR(1), o[0], 0, 0, 0), C0, 8); \
    KRD(GL, 1); GAPB(o[1] = __builtin_amdgcn_mfma_f32_32x32x16_bf16(PAF(1), VFR(5), o[1], 0, 0, 0), C0, 12); \
    KRD(GL, 2); GAPB(o[0] = __builtin_amdgcn_mfma_f32_32x32x16_bf16(PAF(2), VFR(2), o[0], 0, 0, 0), C1, 0); \
    KRD(GL, 3); GAPB(o[1] = __builtin_amdgcn_mfma_f32_32x32x16_bf16(PAF(2), VFR(6), o[1], 0, 0, 0), C1, 4); \
    GAPB(o[0] = __builtin_amdgcn_mfma_f32_32x32x16_bf16(PAF(3), VFR(3), o[0], 0, 0, 0), C1, 8); \
    GAPB(o[1] = __builtin_amdgcn_mfma_f32_32x32x16_bf16(PAF(3), VFR(7), o[1], 0, 0, 0), C1, 12); \
    } while (0)
    int t = 1;
    for (; t + 5 < NT; t += 2) {
        STEP(pB0, pB1, pA0, pA1, t, true, true, true);     WAIT_BAR(2); RESC(); ROT();
        STEP(pA0, pA1, pB0, pB1, t + 1, true, true, true); WAIT_BAR(2); RESC(); ROT();
    }
#define ENDW(tt) do { if ((tt) + 3 < NT) { WAIT_BAR(2); } else if ((tt) + 2 < NT) { WAIT_BAR(1); } else { WAIT_BAR(0); } } while (0)
    for (; t + 1 < NT; t += 2) {
        STEP(pB0, pB1, pA0, pA1, t, (t + 3 < NT), (t + 1 < NT), (t + 1 < NT));         ENDW(t);     RESC(); ROT();
        STEP(pA0, pA1, pB0, pB1, t + 1, (t + 4 < NT), (t + 2 < NT), (t + 2 < NT));     ENDW(t + 1); RESC(); ROT();
    }
    STEP(pB0, pB1, pA0, pA1, NT - 1, false, false, false); RESC();
    { float sacc = pB0[0] + pB0[1]; _Pragma("unroll") for (int r = 2; r < 16; ++r) sacc += pB0[r]; _Pragma("unroll") for (int r = 0; r < 16; ++r) sacc += pB1[r]; l_reg += sacc;
      pw0 = (u32x4){PKW(pB0, 0), PKW(pB0, 2), PKW(pB0, 4), PKW(pB0, 6)}; pw1 = (u32x4){PKW(pB0, 8), PKW(pB0, 10), PKW(pB0, 12), PKW(pB0, 14)}; pw2 = (u32x4){PKW(pB1, 0), PKW(pB1, 2), PKW(pB1, 4), PKW(pB1, 6)}; pw3 = (u32x4){PKW(pB1, 8), PKW(pB1, 10), PKW(pB1, 12), PKW(pB1, 14)};
      SBAR(); pv(o, vb0 + sl_cur, PAF(0), PAF(1), PAF(2), PAF(3)); }
#undef PKW
#undef PAF
#undef VFR
#undef PIN
#undef MX3
#undef GAPA
#undef GAPB
#undef EX
#undef VRD
#undef KRD
#undef STEP
#undef ENDW
    { auto rr = __builtin_amdgcn_permlane32_swap(__float_as_uint(l_reg), __float_as_uint(l_reg), false, false); l_reg = __uint_as_float(rr[0]) + __uint_as_float(rr[1]); }
    if (hi == 0) wsf[32 + r32] = l_reg; asm volatile("s_waitcnt lgkmcnt(0)" ::: "memory");
    float rli[16];
#pragma unroll
    for (int r = 0; r < 16; ++r) rli[r] = __builtin_amdgcn_rcpf(wsf[32 + crow(r, hi)]);
    bf16_t* Ow = O + ((long)b * SEQ + q0 + wid * QBLK) * OP + h * D;
    { bf16_t* stg = (bf16_t*)(shm + LDS_OST) + wid * 2048;
#pragma unroll
      for (int r = 0; r < 16; ++r) { const int orow = crow(r, hi);
#pragma unroll
          for (int d0 = 0; d0 < 2; ++d0) stg[orow * 64 + d0 * 32 + r32] = (bf16_t)f2bf(o[d0][r] * rli[r]); }
      asm volatile("s_waitcnt lgkmcnt(0)" ::: "memory");
#pragma unroll
      for (int i = 0; i < 4; ++i) { const int row = i * 8 + (lane >> 3), ch = lane & 7; const u32x4 v = *(const u32x4*)(stg + row * 64 + ch * 8); *(u32x4*)(Ow + (long)row * OP + ch * 8) = v; } }
    asm volatile("s_waitcnt lgkmcnt(0)\n\ts_barrier" ::: "memory");
#undef DMA_K
#undef DMA_V
#undef START
#undef RESC
#undef ROT
}
#undef SBAR
#undef WAIT_BAR
}
__device__ __forceinline__ void ph_attn(const P& p, unsigned char* lds) {
    const int G = gridDim.x, bx = blockIdx.x;
    for (int i = 0;; ++i) {
        int b, h, qb;
        if (G == 256) { if (i >= 2) break; const int vcu = (bx & 7) * 32 + (bx >> 3), X = vcu >> 5, pi = X >> 1, u = (X & 1) * 64 + (vcu & 31) * 2 + i; b = pi >> 1; h = (pi & 1) * 4 + (u >> 5); qb = u & 31; }
        else { const int L = i * G + bx; if (L >= 512) break; b = L >> 8; h = (L >> 5) & 7; qb = L & 31; }
        attn_body::attn_unit<8>(b, h, qb, WSP(bf16_t, OFF_Q), WSP(bf16_t, OFF_K), WSP(bf16_t, OFF_V), WSP(bf16_t, OFF_AO), (char*)lds);
    }
}


#define LAS __attribute__((address_space(3)))
#define XB_TMO      128
#define XB_XCNT(j)  (256  + 64 * (j))
#define XB_XSUB(j)  (1280 + 64 * (j))
#define XB_XGEN(j)  (2304 + 64 * (j))
#define XB_TOP      3328
#define XB_TOPGEN   3392
#define XCD_BAR_WORDS 3456
#define XB_SPIN_CAP (1u << 18)
__device__ __forceinline__ unsigned xb_ld(unsigned* p)              { return __hip_atomic_load(p, __ATOMIC_RELAXED, __HIP_MEMORY_SCOPE_AGENT); }
__device__ __forceinline__ unsigned xb_add(unsigned* p, unsigned v) { return __hip_atomic_fetch_add(p, v, __ATOMIC_RELAXED, __HIP_MEMORY_SCOPE_AGENT); }
__device__ __forceinline__ unsigned xb_xcc_id() { return (unsigned)__builtin_amdgcn_s_getreg((3 << 11) | 20) & 0xFu; }
#define XB_SPIN(cond, bar) do { unsigned _sp = 0; while (cond) { __builtin_amdgcn_s_sleep(1); \
    if ((++_sp & 255u) == 0u) { if (xb_ld(&(bar)[XB_TMO])) break; if (_sp > XB_SPIN_CAP) { atomicAdd(&(bar)[XB_TMO], 1u); break; } } } } while (0)
struct XcdBarrier { unsigned* bar; unsigned x; volatile LAS unsigned* st; };
__device__ __forceinline__ XcdBarrier xcd_barrier_post(unsigned* bar, volatile LAS unsigned* st) {
    XcdBarrier b; b.bar = bar; b.x = xb_xcc_id(); b.st = st;
    if (threadIdx.x == 0) (void)xb_add(&bar[XB_XCNT(b.x)], 1u);
    return b;
}
__device__ __forceinline__ void xcd_barrier_complete(unsigned* bar, unsigned x, unsigned& nloc, unsigned& nx) {
    const unsigned G = gridDim.x * gridDim.y * gridDim.z;
    unsigned sum, cnt, mine, sp = 0u;
    for (;;) {
        sum = 0u; cnt = 0u; mine = 0u;
#pragma unroll
        for (unsigned j = 0; j < 16; ++j) { const unsigned c = xb_ld(&bar[XB_XCNT(j)]); sum += c; cnt += (c > 0u) ? 1u : 0u; mine = (j == x) ? c : mine; }
        if (sum == G) break;
        __builtin_amdgcn_s_sleep(1);
        if ((++sp & 255u) == 0u) { if (xb_ld(&bar[XB_TMO])) break; if (sp > XB_SPIN_CAP) { atomicAdd(&bar[XB_TMO], 1u); break; } }
    }
    nloc = mine > 0u ? mine : 1u; nx = cnt > 0u ? cnt : 1u;
}
__device__ __forceinline__ void xcd_barrier(const XcdBarrier& b) {
    asm volatile("s_waitcnt vmcnt(0)" ::: "memory");
    __syncthreads();
    if (threadIdx.x == 0) {
        unsigned* bar = b.bar;
        __builtin_amdgcn_s_waitcnt(0);
        unsigned nloc = b.st[0], nx = b.st[1];
        if (nloc == 0u) { xcd_barrier_complete(bar, b.x, nloc, nx); b.st[0] = nloc; b.st[1] = nx; }
        const unsigned old = xb_add(&bar[XB_XSUB(b.x)], 1u);
        const unsigned gen = old / nloc;
        if (old + 1u == (gen + 1u) * nloc) {
            __builtin_amdgcn_fence(__ATOMIC_RELEASE, "agent");
            asm volatile("s_waitcnt vmcnt(0)" ::: "memory");
            const unsigned og = xb_add(&bar[XB_TOP], 1u);
            const unsigned tg = og / nx;
            if (og + 1u == (tg + 1u) * nx) xb_add(&bar[XB_TOPGEN], 1u);
            else XB_SPIN(xb_ld(&bar[XB_TOPGEN]) == tg, bar);
            __builtin_amdgcn_fence(__ATOMIC_ACQUIRE, "agent");
            xb_add(&bar[XB_XGEN(b.x)], 1u);
            asm volatile("s_waitcnt vmcnt(0)" ::: "memory");
        } else {
            XB_SPIN(xb_ld(&bar[XB_XGEN(b.x)]) == gen, bar);
            __builtin_amdgcn_fence(__ATOMIC_ACQUIRE, "agent");
            asm volatile("s_waitcnt vmcnt(0)" ::: "memory");
        }
    }
    __syncthreads();
}
constexpr int CW_BAR = 4096;
constexpr int MISC_OFF = LDS_BYTES - 64;

enum { PH_P0 = 0, PH_P1, PH_INPROJ, PH_MIX, PH_HYT, PH_OUTPROJ, PH_ROUTER, PH_TOPK, PH_GATEUP, PH_DOWN, PH_COMBINE, PH_N };
__global__ void __launch_bounds__(NTHR, 2) k_phases(P p, int lo, int hi) {
    extern __shared__ __attribute__((aligned(16))) unsigned char lds[];
    volatile LAS unsigned* misc = (volatile LAS unsigned*)((LAS unsigned char*)lds + MISC_OFF);
    if (threadIdx.x < 16) misc[threadIdx.x] = 0u;
    __syncthreads();
    XcdBarrier bar; bar.bar = WSP(unsigned, OFF_CTL) + CW_BAR; bar.x = 0; bar.st = misc;
    if (hi - lo > 1) bar = xcd_barrier_post(WSP(unsigned, OFF_CTL) + CW_BAR, misc);
#define IN(k) (lo <= (k) && (k) < hi)
#define SEAM(k) do { if (IN(k) && IN((k) + 1)) xcd_barrier(bar); } while (0)
    if (IN(PH_P0)) DUP(PH_P0) { __syncthreads(); ph_mod(p, (float*)lds); __syncthreads(); ph_rope(p); ph_h2(p, (float*)lds); __syncthreads(); ph_convert<0>(p, lds); }
    SEAM(PH_P0);
    if (IN(PH_P1)) DUP(PH_P1) { __syncthreads(); ph_xn(p); ph_ht(p, lds); }
    SEAM(PH_P1);
    if (IN(PH_INPROJ)) DUP(PH_INPROJ) { __syncthreads(); ph_inproj(p, lds); }
    SEAM(PH_INPROJ);
    if (IN(PH_MIX)) DUP(PH_MIX) { __syncthreads(); const int grp_ = blockIdx.x & 1;
        if (grp_ == 0) { ph_convert<1>(p, lds, 0, 2); __syncthreads(); }
        ph_attn(p, lds); __syncthreads(); ph_fft(p, lds);
        if (grp_ == 1) { __syncthreads(); ph_convert<1>(p, lds, 1, 2); } }
    SEAM(PH_MIX);
    if (IN(PH_HYT)) DUP(PH_HYT) { __syncthreads(); ph_hyt(p, lds); }
    SEAM(PH_HYT);
    if (IN(PH_OUTPROJ)) DUP(PH_OUTPROJ) { __syncthreads(); ph_outproj(p, lds); }
    SEAM(PH_OUTPROJ);
    if (IN(PH_ROUTER)) DUP(PH_ROUTER) { __syncthreads(); ph_router(p, lds); }
    SEAM(PH_ROUTER);
    if (IN(PH_TOPK)) DUP(PH_TOPK) { __syncthreads(); ph_topk(p, lds); }
    SEAM(PH_TOPK);
    if (IN(PH_GATEUP)) DUP(PH_GATEUP) { __syncthreads(); ph_gateup(p, lds); }
    SEAM(PH_GATEUP);
    if (IN(PH_DOWN)) DUP(PH_DOWN) { __syncthreads(); ph_down(p, lds); }
    SEAM(PH_DOWN);
    if (IN(PH_COMBINE)) { ph_combine(p); }
    if (lo == PH_N) { ph_fft(p, lds); }
    if (lo == PH_N + 1) { ph_mod(p, (float*)lds); }
    if (lo == PH_N + 2) { ph_h2(p, (float*)lds); }
    if (lo == PH_N + 3) { ph_convert<1>(p, lds); }
#undef IN
#undef SEAM
}

extern "C" void kernel_launch(void* const* d_in, const int* in_sizes, int n_in, void* d_out, int out_size, void* d_ws, size_t ws_size, hipStream_t stream) {
    static int init = 0;
    if (!init) {
        if (n_in != 25 || ws_size < WS_END) { fprintf(stderr, "kernel_launch: unexpected n_in %d / ws_size %zu\n", n_in, ws_size); init = -1; return; }
        if (hipFuncSetAttribute((const void*)k_phases, hipFuncAttributeMaxDynamicSharedMemorySize, LDS_BYTES) != hipSuccess) { fprintf(stderr, "hipFuncSetAttribute failed\n"); init = -1; return; }
        init = 1;
    }
    if (init < 0) return;
    P p{};
    const float** f = (const float**)&p.x;
    for (int i = 0; i < 25; ++i) f[i] = (const float*)d_in[i];
    p.out = (float*)d_out; p.ws = (unsigned char*)d_ws;
    for (int i = 0; i < 16; ++i) p.invf[i] = pow(10000.0, -(double)i / 16.0);
    (void)hipMemsetAsync((char*)d_ws + OFF_CTL, 0, CTL_BYTES, stream);
    const int G = 256;
#define PHASES(lo, hi) hipLaunchKernelGGL(k_phases, dim3(G), dim3(NTHR), LDS_BYTES, stream, p, (lo), (hi))
#if ONE_LAUNCH
    PHASES(0, PH_N);
    if (EXTRA_PH >= 0) PHASES(EXTRA_PH, EXTRA_PH + 1);
#else
    for (int ph = 0; ph < PH_N; ++ph) PHASES(ph, ph + 1);
#endif
}
```

```cpp
#include <hip/hip_runtime.h>
#include <cstdio>
#include <cstdint>
#include <cmath>

#define ONE_LAUNCH 1
#ifndef PROBE_A
#define PROBE_A -1
#define PROBE_B -1
#define PROBE_BLK 0
#define PROBE_DIV 40.0f
#endif
#ifndef EXTRA_PH
#define EXTRA_PH -1
#endif
#ifndef DUP_MASK
#define DUP_MASK 0
#endif
#define DUP(k) for (int rep_ = 0; rep_ < 1 + ((DUP_MASK >> (k)) & 1); ++rep_)
constexpr int DM = 1024, NB = 2, SEQ = 8192, CTXL = 256, LK = SEQ + CTXL;
constexpr int MTOK = NB * SEQ, MCTX = NB * CTXL, MALL = MTOK + MCTX;
constexpr int INW = 2304, NEXP = 16, CAP = 1024, DEXP = 2752, DEXP_P = 2816;
constexpr int NFFT = 16384;
constexpr float EPS = 1e-6f;
constexpr float C2 = 0.125f * 1.4426950408889634f;

typedef unsigned short bf16_t;

constexpr size_t MiB = 1u << 20;
constexpr size_t OFF_CTL = 0, CTL_BYTES = 1 * MiB;
constexpr size_t OFF_MODV = 1 * MiB;
constexpr size_t OFF_ROPE = 1 * MiB + 128 * 1024;
constexpr size_t OFF_H2 = 2 * MiB;
constexpr size_t OFF_AFF = 4 * MiB;
constexpr size_t OFF_INV = 5 * MiB;
constexpr size_t OFF_IDX = 6 * MiB;
constexpr size_t OFF_GATE = 6 * MiB + 128 * 1024;
constexpr size_t OFF_WIN = 8 * MiB, OFF_WOUT = 13 * MiB, OFF_WGU = 16 * MiB, OFF_WD = 192 * MiB;
constexpr size_t OFF_XN2 = 280 * MiB;
constexpr size_t OFF_XN = 312 * MiB;
constexpr size_t OFF_Q = 345 * MiB;
constexpr size_t OFF_K = 361 * MiB;
constexpr size_t OFF_V = 366 * MiB;
constexpr size_t OFF_PT = 371 * MiB;
constexpr size_t OFF_HT = 467 * MiB;
constexpr size_t OFF_H = 312 * MiB;
constexpr size_t OFF_AO = 499 * MiB;
constexpr size_t OFF_HYT = 531 * MiB;
constexpr size_t OFF_Y = 499 * MiB;
constexpr size_t OFF_PROJ = 563 * MiB;
constexpr size_t OFF_KF = 613 * MiB;
constexpr size_t WS_END = 677 * MiB;

struct P {
    const float *x, *c, *ctx, *c_ctx, *w_mod, *b_mod, *n1g, *n2g, *w_in, *w_out, *qng, *kng, *conv_w, *conv_b;
    const float *fw1, *fb1, *fw2, *fb2, *fw3, *ffreq, *hbias, *w_router, *w_gate, *w_up, *w_down;
    float* out; unsigned char* ws;
    double invf[16];
};

#define WSP(T, off) ((T*)(p.ws + (off)))

__device__ __forceinline__ unsigned f2bf(float f) { unsigned u = __float_as_uint(f); return (u + 0x7fffu + ((u >> 16) & 1u)) >> 16; }
__device__ __forceinline__ float bf2f(unsigned h) { return __uint_as_float(h << 16); }
__device__ __forceinline__ unsigned pk2(float lo, float hi) { return f2bf(lo) | (f2bf(hi) << 16); }
__device__ __forceinline__ unsigned hw_pk2(float lo, float hi) { typedef float f2_t __attribute__((ext_vector_type(2))); typedef __bf16 b2_t __attribute__((ext_vector_type(2))); f2_t v = {lo, hi}; b2_t b = __builtin_convertvector(v, b2_t); return __builtin_bit_cast(unsigned, b); }
__device__ __forceinline__ float hw_sin_rev(float r) { return __builtin_amdgcn_sinf(r); }
__device__ __forceinline__ float hw_cos_rev(float r) { return __builtin_amdgcn_cosf(r); }
__device__ __forceinline__ float wave_sum(float v) {
#pragma unroll
    for (int o = 1; o < 64; o <<= 1) v += __shfl_xor(v, o);
    return v;
}

constexpr int NTHR = 512, NWAVE = 8;
constexpr int LDS_BYTES = 147456;

__device__ __forceinline__ void ph_mod(const P& p, float* lf) {
    const int tid = threadIdx.x, lane = tid & 63, wave = tid >> 6;
    float* sil = lf; float* red = lf + 3072;
    if ((int)blockIdx.x < 96) {
        for (int i = tid; i < 3072; i += NTHR) { const int r = i >> 10, k = i & 1023; const float v = r < 2 ? p.c[r * 1024 + k] : p.c_ctx[k]; sil[i] = v / (1.0f + expf(-v)); }
        __syncthreads();
        float* modv = WSP(float, OFF_MODV);
        for (int item = blockIdx.x; item < 96; item += gridDim.x) {
            const int col = item * 64 + lane, kb = wave * 128;
            float a0 = 0.f, a1 = 0.f, a2 = 0.f;
#pragma unroll 8
            for (int kk = 0; kk < 128; ++kk) { const float w = p.w_mod[(size_t)(kb + kk) * 6144 + col]; a0 += sil[kb + kk] * w; a1 += sil[1024 + kb + kk] * w; a2 += sil[2048 + kb + kk] * w; }
            red[(wave * 3 + 0) * 64 + lane] = a0; red[(wave * 3 + 1) * 64 + lane] = a1; red[(wave * 3 + 2) * 64 + lane] = a2;
            __syncthreads();
            if (wave < 3) { float s = p.b_mod[col];
#pragma unroll
                for (int w2 = 0; w2 < 8; ++w2) s += red[(w2 * 3 + wave) * 64 + lane];
                modv[wave * 6144 + col] = s; }
            __syncthreads();
        }
    }
}
__device__ __forceinline__ void ph_rope(const P& p) {
    float* rope = WSP(float, OFF_ROPE);
    for (int i = blockIdx.x * NTHR + threadIdx.x; i < 2048; i += gridDim.x * NTHR) {
        const int pos = i >> 4, f = i & 15;
        double r = (double)pos * p.invf[f] * 0.15915494309189535; r -= floor(r);
        rope[2 * i] = hw_cos_rev((float)r); rope[2 * i + 1] = hw_sin_rev((float)r);
    }
}
__device__ __forceinline__ void ph_h2(const P& p, float* lf) {
    const int tid = threadIdx.x, lane = tid & 63, wave = tid >> 6;
    float* zf = lf + wave * 40; float* h1 = lf + 8 * 40 + wave * 64;
    float* h2 = WSP(float, OFF_H2);
    const float fr = p.ffreq[lane];
    for (int item = blockIdx.x; item < 1024; item += gridDim.x) {
        const int t = item * 8 + wave;
        if (lane < 33) {
            float z;
            if (lane == 0) z = (float)t / 8191.0f;
            else { const int k = (lane - 1) & 15; const double fk = 1e-4 + (double)k * ((15.0 - 1e-4) / 15.0); double r = (double)t * fk / 8192.0; r -= floor(r);
                   z = lane <= 16 ? hw_cos_rev((float)r) : -hw_sin_rev((float)r); }
            zf[lane] = z;
        }
        __syncthreads();
        float a = p.fb1[lane];
#pragma unroll
        for (int i = 0; i < 33; ++i) a += zf[i] * p.fw1[i * 64 + lane];
        h1[lane] = hw_sin_rev(fr * a * 0.15915494309189535f);
        __syncthreads();
        float b = p.fb2[lane];
#pragma unroll 16
        for (int i = 0; i < 64; ++i) b += h1[i] * p.fw2[i * 64 + lane];
        h2[(size_t)t * 64 + lane] = hw_sin_rev(fr * b * 0.15915494309189535f);
        __syncthreads();
    }
}

__device__ __forceinline__ void ph_xn(const P& p) {
    const int tid = threadIdx.x, lane = tid & 63, wave = tid >> 6;
    const float* modv = WSP(float, OFF_MODV); bf16_t* xn = WSP(bf16_t, OFF_XN);
    for (int row0 = (blockIdx.x * NWAVE + wave) * 4; row0 < MALL; row0 += gridDim.x * NWAVE * 4) {
        const float* src = row0 < MTOK ? p.x + (size_t)row0 * DM : p.ctx + (size_t)(row0 - MTOK) * DM;
        const float* mv = modv + (row0 < MTOK ? (row0 >> 13) : 2) * 6144;
        float4 v[4][4];
#pragma unroll
        for (int r = 0; r < 4; ++r)
#pragma unroll
            for (int j = 0; j < 4; ++j) v[r][j] = *(const float4*)(src + (size_t)r * DM + 4 * lane + 256 * j);
        float4 g[4], sh[4], sc[4];
#pragma unroll
        for (int j = 0; j < 4; ++j) { const int c0 = 4 * lane + 256 * j; g[j] = *(const float4*)(p.n1g + c0); sh[j] = *(const float4*)(mv + c0); sc[j] = *(const float4*)(mv + 1024 + c0);
            g[j].x *= 1.f + sc[j].x; g[j].y *= 1.f + sc[j].y; g[j].z *= 1.f + sc[j].z; g[j].w *= 1.f + sc[j].w; }
#pragma unroll
        for (int r = 0; r < 4; ++r) {
            float ss = 0.f;
#pragma unroll
            for (int j = 0; j < 4; ++j) ss += v[r][j].x * v[r][j].x + v[r][j].y * v[r][j].y + v[r][j].z * v[r][j].z + v[r][j].w * v[r][j].w;
            const float rstd = rsqrtf(wave_sum(ss) * (1.0f / DM) + EPS);
#pragma unroll
            for (int j = 0; j < 4; ++j) {
                const int c0 = 4 * lane + 256 * j;
                uint2 o; o.x = hw_pk2(v[r][j].x * rstd * g[j].x + sh[j].x, v[r][j].y * rstd * g[j].y + sh[j].y); o.y = hw_pk2(v[r][j].z * rstd * g[j].z + sh[j].z, v[r][j].w * rstd * g[j].w + sh[j].w);
                *(uint2*)(xn + (size_t)(row0 + r) * DM + c0) = o;
            }
        }
    }
}
__device__ __forceinline__ void ph_ht(const P& p, unsigned char* lds) {
    typedef float f32x16_t __attribute__((ext_vector_type(16)));
    const int tid = threadIdx.x, lane = tid & 63, wave = tid >> 6, l31 = lane & 31, kh = lane >> 5;
    const float* h2 = WSP(float, OFF_H2); float* ht = WSP(float, OFF_HT);
    float* hs = (float*)lds + wave * (32 * 65);
    const float MIN_D = -3.0701134573253945f, MAX_D = -15.350567286626973f;
    for (int item = blockIdx.x * NWAVE + wave; item < 2048; item += gridDim.x * NWAVE) {
        const int tb = item >> 3, cg = item & 7, t0 = tb * 32;
        {
            float4 v[8];
#pragma unroll
            for (int i = 0; i < 8; ++i) v[i] = *(const float4*)(h2 + (size_t)t0 * 64 + (i * 64 + lane) * 4);
#pragma unroll
            for (int i = 0; i < 8; ++i) { const int id = i * 64 + lane, row = id >> 4, c4 = (id & 15) * 4; float* d = hs + row * 65 + c4; d[0] = v[i].x; d[1] = v[i].y; d[2] = v[i].z; d[3] = v[i].w; }
        }
        asm volatile("s_waitcnt lgkmcnt(0)" ::: "memory");
        float bv[32];
#pragma unroll
        for (int s2 = 0; s2 < 32; ++s2) bv[s2] = hs[l31 * 65 + 2 * s2 + kh];
        const float tn = (float)(t0 + l31) / 8191.0f;
#pragma unroll 1
        for (int ct = 0; ct < 4; ++ct) {
            const int col0 = cg * 128 + ct * 32;
            float av[32];
#pragma unroll
            for (int s2 = 0; s2 < 32; ++s2) av[s2] = p.fw3[(2 * s2 + kh) * 1024 + col0 + l31];
            f32x16_t acc = {0.f, 0.f, 0.f, 0.f, 0.f, 0.f, 0.f, 0.f, 0.f, 0.f, 0.f, 0.f, 0.f, 0.f, 0.f, 0.f};
#pragma unroll
            for (int s2 = 0; s2 < 32; ++s2) acc = __builtin_amdgcn_mfma_f32_32x32x2f32(av[s2], bv[s2], acc, 0, 0, 0);
#pragma unroll
            for (int r = 0; r < 16; ++r) {
                const int col = col0 + (r & 3) + 8 * (r >> 2) + 4 * kh;
                const float dl = MIN_D + (MAX_D - MIN_D) * (float)(col & 511) / 511.0f;
                ht[(size_t)col * 8192 + t0 + l31] = acc[r] * expf(-tn * fabsf(dl));
            }
        }
        asm volatile("s_waitcnt lgkmcnt(0)" ::: "memory");
    }
}

struct c2 { float x, y; };
__device__ __forceinline__ c2 cmul(c2 a, c2 b) { return c2{a.x * b.x - a.y * b.y, a.x * b.y + a.y * b.x}; }
#define FFT_DEV __device__ __forceinline__
#define FFT_LAUNDER(x) asm volatile("" : "+v"(x))
FFT_DEV int fsw(int i) { return i ^ (((i >> 4) & 7) << 1); }
FFT_DEV c2 cadd(c2 a, c2 b) { return c2{a.x + b.x, a.y + b.y}; }
FFT_DEV c2 csub(c2 a, c2 b) { return c2{a.x - b.x, a.y - b.y}; }
FFT_DEV void dft4(c2& a, c2& b, c2& c, c2& d) {
    const c2 apc = cadd(a, c), amc = csub(a, c), bpd = cadd(b, d), bmd = csub(b, d);
    const c2 jb{-bmd.y, bmd.x};
    a = cadd(apc, bpd); b = csub(amc, jb); c = csub(apc, bpd); d = cadd(amc, jb);
}
FFT_DEV void dft16(c2 (&x)[16]) {
#pragma unroll
    for (int m0 = 0; m0 < 4; ++m0) dft4(x[m0], x[m0 + 4], x[m0 + 8], x[m0 + 12]);
    const float C1 = 0.92387953251128674f, S1 = 0.38268343236508977f, R = 0.70710678118654752f;
    x[5]  = cmul(x[5],  c2{C1, -S1});
    x[6]  = c2{(x[6].x + x[6].y) * R, (x[6].y - x[6].x) * R};
    x[7]  = cmul(x[7],  c2{S1, -C1});
    x[9]  = c2{(x[9].x + x[9].y) * R, (x[9].y - x[9].x) * R};
    x[10] = c2{x[10].y, -x[10].x};
    x[11] = c2{(x[11].y - x[11].x) * R, -(x[11].x + x[11].y) * R};
    x[13] = cmul(x[13], c2{S1, -C1});
    x[14] = c2{(x[14].y - x[14].x) * R, -(x[14].x + x[14].y) * R};
    x[15] = cmul(x[15], c2{-C1, S1});
#pragma unroll
    for (int k1 = 0; k1 < 4; ++k1) dft4(x[4 * k1], x[4 * k1 + 1], x[4 * k1 + 2], x[4 * k1 + 3]);
#pragma unroll
    for (int a = 0; a < 4; ++a)
#pragma unroll
        for (int b = a + 1; b < 4; ++b) { const c2 t = x[a + 4 * b]; x[a + 4 * b] = x[b + 4 * a]; x[b + 4 * a] = t; }
}
template <int LOGS, bool ZHI> FFT_DEV void r16_compute(const c2* X, c2 (&y)[2][16], int tid) {
#pragma unroll
    for (int i = 0; i < 2; ++i) {
        const int j = tid + 512 * i, pj = fsw(j);
        c2 x[16];
#pragma unroll
        for (int m = 0; m < 16; ++m) x[m] = (ZHI && m >= 8) ? c2{0.f, 0.f} : X[pj + 1024 * m];
        dft16(x);
        const int ps = (j >> LOGS) << LOGS;
        float r = (float)ps * (1.0f / 16384.0f);
        FFT_LAUNDER(r);
        const c2 w1{hw_cos_rev(r), -hw_sin_rev(r)}, w2{hw_cos_rev(2.f * r), -hw_sin_rev(2.f * r)}, w4{hw_cos_rev(4.f * r), -hw_sin_rev(4.f * r)}, w8{hw_cos_rev(8.f * r), -hw_sin_rev(8.f * r)};
        const c2 w3 = cmul(w1, w2), w5 = cmul(w1, w4), w6 = cmul(w2, w4), w7 = cmul(w3, w4);
        y[i][0] = x[0]; y[i][1] = cmul(x[1], w1); y[i][2] = cmul(x[2], w2); y[i][3] = cmul(x[3], w3);
        y[i][4] = cmul(x[4], w4); y[i][5] = cmul(x[5], w5); y[i][6] = cmul(x[6], w6); y[i][7] = cmul(x[7], w7);
        y[i][8] = cmul(x[8], w8); y[i][9] = cmul(x[9], cmul(w1, w8)); y[i][10] = cmul(x[10], cmul(w2, w8)); y[i][11] = cmul(x[11], cmul(w3, w8));
        y[i][12] = cmul(x[12], cmul(w4, w8)); y[i][13] = cmul(x[13], cmul(w5, w8)); y[i][14] = cmul(x[14], cmul(w6, w8)); y[i][15] = cmul(x[15], cmul(w7, w8));
    }
}
template <int LOGS> FFT_DEV void r16_write(c2* X, const c2 (&y)[2][16], int tid) {
#pragma unroll
    for (int i = 0; i < 2; ++i) {
        const int j = tid + 512 * i;
        if (LOGS == 0) {
#pragma unroll
            for (int c = 0; c < 8; ++c) { float4* d = (float4*)(X + 16 * j + 2 * (c ^ (j & 7))); *d = float4{y[i][2 * c].x, y[i][2 * c].y, y[i][2 * c + 1].x, y[i][2 * c + 1].y}; }
        } else if (LOGS == 4) {
            const int q = j & 15, b = 256 * (j >> 4);
#pragma unroll
            for (int k = 0; k < 16; ++k) X[b + 16 * k + (q ^ ((k & 7) << 1))] = y[i][k];
        } else {
            const int b = fsw(j & 255) + 4096 * (j >> 8);
#pragma unroll
            for (int k = 0; k < 16; ++k) X[b + 256 * k] = y[i][k];
        }
    }
}
FFT_DEV void r4_last(const c2* X, c2 (&y4)[8][4], int tid) {
#pragma unroll
    for (int i = 0; i < 8; ++i) {
        const int pj = fsw(tid + 512 * i);
        c2 a = X[pj], b = X[pj + 4096], c = X[pj + 8192], d = X[pj + 12288];
        dft4(a, b, c, d);
        y4[i][0] = a; y4[i][1] = b; y4[i][2] = c; y4[i][3] = d;
    }
}

#define FFT_PASS16(L, Z) do { asm volatile("" : "+v"(tid)); r16_compute<L, Z>(X, y, tid); __syncthreads(); asm volatile("" : "+v"(tid)); r16_write<L>(X, y, tid); __syncthreads(); } while (0)
template <bool ZHI> __device__ __forceinline__ void fft16k(c2* X, c2 (&y4)[8][4], int tid) {
    { c2 y[2][16]; FFT_PASS16(0, ZHI); FFT_PASS16(4, false); FFT_PASS16(8, false); }
    asm volatile("" : "+v"(tid));
    r4_last(X, y4, tid);
}
__device__ __forceinline__ void conv3x16(const float* base, int t0, float w0, float w1, float w2, float cb, float (&o)[16]) {
    float in[18];
    in[0] = t0 > 0 ? base[t0 - 1] : 0.f; in[17] = t0 + 16 < SEQ ? base[t0 + 16] : 0.f;
#pragma unroll
    for (int q = 0; q < 4; ++q) { const float4 c = *(const float4*)(base + t0 + 4 * q); in[1 + 4 * q] = c.x; in[2 + 4 * q] = c.y; in[3 + 4 * q] = c.z; in[4 + 4 * q] = c.w; }
#pragma unroll
    for (int e = 0; e < 16; ++e) o[e] = w0 * in[e] + w1 * in[e + 1] + w2 * in[e + 2] + cb;
}
__device__ __forceinline__ unsigned pack_h2(float a, float b) { typedef _Float16 h2_t __attribute__((ext_vector_type(2))); typedef float f2_t __attribute__((ext_vector_type(2))); f2_t v = {a, b}; h2_t h = __builtin_convertvector(v, h2_t); return __builtin_bit_cast(unsigned, h); }
__device__ __forceinline__ c2 unpack_h2(unsigned u) { typedef _Float16 h2_t __attribute__((ext_vector_type(2))); const h2_t h = __builtin_bit_cast(h2_t, u); return c2{(float)h[0], (float)h[1]}; }
#define LAUNDER(v) asm volatile("" : "+v"(v))
__device__ __forceinline__ void ph_fft(const P& p, unsigned char* lds) {
    int tid = threadIdx.x; const int lane = tid & 63, wave = tid >> 6;
    c2* X = (c2*)lds; float* red = (float*)(lds + 131072);
    const float* ht = WSP(float, OFF_HT); const float* pt = WSP(float, OFF_PT); bf16_t* hyt = WSP(bf16_t, OFF_HYT);
    unsigned* kfg = WSP(unsigned, OFF_KF) + (size_t)blockIdx.x * NFFT;
    for (int ch = blockIdx.x; ch < 512; ch += gridDim.x) {
        LAUNDER(tid);
        const float* hf = ht + (size_t)ch * 8192; const float* hb = ht + (size_t)(512 + ch) * 8192;
        float asum = 0.f;
        { float kv[32];
#pragma unroll
          for (int m = 0; m < 16; ++m) kv[m] = hf[tid + 512 * m];
#pragma unroll
          for (int m = 16; m < 32; ++m) { const int n = tid + 512 * m; kv[m] = (n == 8192) ? 0.f : hb[16384 - (n == 8192 ? 8193 : n)]; }
#pragma unroll
          for (int m = 0; m < 32; ++m) { asum += fabsf(kv[m]); X[fsw(tid + 512 * m)] = c2{kv[m], 0.f}; } }
        asum = wave_sum(asum); if (lane == 0) red[wave] = asum;
        __syncthreads();
        float tot = 0.f;
#pragma unroll
        for (int w = 0; w < 8; ++w) tot += red[w];
        const float rtot = 1.0f / tot;
        c2 y[8][4];
        LAUNDER(tid);
        fft16k<false>(X, y, tid);
        LAUNDER(tid);
#pragma unroll
        for (int i = 0; i < 8; ++i)
#pragma unroll
            for (int k = 0; k < 4; ++k) kfg[tid + i * 2048 + k * 512] = pack_h2(y[i][k].x * rtot, y[i][k].y * rtot);
        __syncthreads();
        const float wa0 = p.conv_w[ch], wa1 = p.conv_w[1536 + ch], wa2 = p.conv_w[3072 + ch], ba = p.conv_b[ch];
        const float wx0 = p.conv_w[512 + ch], wx1 = p.conv_w[1536 + 512 + ch], wx2 = p.conv_w[3072 + 512 + ch], bx = p.conv_b[512 + ch];
        const float wv0 = p.conv_w[1024 + ch], wv1 = p.conv_w[1536 + 1024 + ch], wv2 = p.conv_w[3072 + 1024 + ch], bv = p.conv_b[1024 + ch];
        LAUNDER(tid);
        const float* p1 = pt + (size_t)ch * MTOK; const float* px = pt + (size_t)(512 + ch) * MTOK; const float* pv = pt + (size_t)(1024 + ch) * MTOK;
        unsigned us[16], xs[16];
        { const int t0 = 16 * tid; float a[16], u0[16], u1[16];
          conv3x16(pv, t0, wv0, wv1, wv2, bv, u0); conv3x16(p1, t0, wa0, wa1, wa2, ba, a);
#pragma unroll
          for (int e = 0; e < 16; ++e) u0[e] *= a[e];
          conv3x16(pv + SEQ, t0, wv0, wv1, wv2, bv, u1); conv3x16(p1 + SEQ, t0, wa0, wa1, wa2, ba, a);
#pragma unroll
          for (int e = 0; e < 16; ++e) { u1[e] *= a[e]; us[e] = hw_pk2(u0[e], u1[e]); }
#pragma unroll
          for (int c = 0; c < 8; ++c) *(float4*)(X + 16 * tid + 2 * (c ^ (tid & 7))) = float4{u0[2 * c], u1[2 * c], u0[2 * c + 1], u1[2 * c + 1]};
          conv3x16(px, t0, wx0, wx1, wx2, bx, u0); conv3x16(px + SEQ, t0, wx0, wx1, wx2, bx, u1);
#pragma unroll
          for (int e = 0; e < 16; ++e) xs[e] = hw_pk2(u0[e], u1[e]); }
        __syncthreads();
        LAUNDER(tid);
        fft16k<true>(X, y, tid);
        __syncthreads();
        LAUNDER(tid);
        { unsigned kq[8][4];
#pragma unroll
          for (int i = 0; i < 8; ++i)
#pragma unroll
              for (int k = 0; k < 4; ++k) kq[i][k] = kfg[tid + i * 2048 + k * 512];
#pragma unroll
          for (int i = 0; i < 8; ++i)
#pragma unroll
              for (int k = 0; k < 4; ++k) { const c2 w = cmul(y[i][k], unpack_h2(kq[i][k])); X[fsw(tid + 512 * i + 4096 * k)] = c2{w.x, -w.y}; } }
        __syncthreads();
        LAUNDER(tid);
        fft16k<false>(X, y, tid);
        __syncthreads();
        LAUNDER(tid);
#pragma unroll
        for (int i = 0; i < 8; ++i)
#pragma unroll
            for (int k = 0; k < 2; ++k) X[fsw(tid + 512 * i + 4096 * k)] = y[i][k];
        __syncthreads();
        LAUNDER(tid);
        const float bias = p.hbias[ch], scale = 1.0f / 16384.0f;
        { unsigned o0[8], o1[8];
#pragma unroll
          for (int c = 0; c < 8; ++c) { const float4 r = *(const float4*)(X + 16 * tid + 2 * (c ^ (tid & 7)));
              const float ua0 = bf2f(us[2 * c] & 0xFFFFu), ub0 = bf2f(us[2 * c] >> 16), ua1 = bf2f(us[2 * c + 1] & 0xFFFFu), ub1 = bf2f(us[2 * c + 1] >> 16);
              const float xa0 = bf2f(xs[2 * c] & 0xFFFFu), xb0 = bf2f(xs[2 * c] >> 16), xa1 = bf2f(xs[2 * c + 1] & 0xFFFFu), xb1 = bf2f(xs[2 * c + 1] >> 16);
              o0[c] = hw_pk2((r.x * scale + ua0 * bias) * xa0, (r.z * scale + ua1 * bias) * xa1);
              o1[c] = hw_pk2((-r.y * scale + ub0 * bias) * xb0, (-r.w * scale + ub1 * bias) * xb1); }
          uint4* d0 = (uint4*)(hyt + (size_t)ch * MTOK + 16 * tid); uint4* d1 = (uint4*)(hyt + (size_t)ch * MTOK + SEQ + 16 * tid);
          d0[0] = uint4{o0[0], o0[1], o0[2], o0[3]}; d0[1] = uint4{o0[4], o0[5], o0[6], o0[7]};
          d1[0] = uint4{o1[0], o1[1], o1[2], o1[3]}; d1[1] = uint4{o1[4], o1[5], o1[6], o1[7]}; }
        __syncthreads();
    }
}

__device__ __forceinline__ void ph_hyt(const P& p, unsigned char* lds) {
    const int tid = threadIdx.x;
    bf16_t* tile = (bf16_t*)lds;
    const bf16_t* hyt = WSP(bf16_t, OFF_HYT); bf16_t* ao = WSP(bf16_t, OFF_AO);
    for (int item = blockIdx.x; item < 2048; item += gridDim.x) {
        const int cg = item & 7, mg = item >> 3, c0 = cg * 64, m0 = mg * 64;
        { const int c = tid >> 3, ch = tid & 7; const uint4 v = *(const uint4*)(hyt + (size_t)(c0 + c) * MTOK + m0 + ch * 8); *(uint4*)(tile + c * 72 + ch * 8) = v; }
        __syncthreads();
        { const int m = tid >> 3, ch = tid & 7; unsigned w[4];
#pragma unroll
          for (int k = 0; k < 4; ++k) { const unsigned lo = tile[(ch * 8 + 2 * k) * 72 + m], hi = tile[(ch * 8 + 2 * k + 1) * 72 + m]; w[k] = lo | (hi << 16); }
          uint4 o; o.x = w[0]; o.y = w[1]; o.z = w[2]; o.w = w[3];
          *(uint4*)(ao + (size_t)(m0 + m) * DM + 512 + c0 + ch * 8) = o; }
        __syncthreads();
    }
}

__device__ __forceinline__ void ph_router(const P& p, unsigned char* lds) {
    const int tid = threadIdx.x, lane = tid & 63, wave = tid >> 6;
    float* wt = (float*)lds;
    float* rowb = (float*)(lds + 16 * 1028 * 4);
    const float* modv = WSP(float, OFF_MODV); bf16_t* xn2 = WSP(bf16_t, OFF_XN2); float* aff = WSP(float, OFF_AFF);
    for (int i = tid; i < 16384; i += NTHR) { const int k = i >> 4, e = i & 15; wt[e * 1028 + k] = p.w_router[i]; }
    __syncthreads();
    float4 vn[4];
    { const int row = blockIdx.x * 8 + wave;
#pragma unroll
      for (int j = 0; j < 4; ++j) vn[j] = (blockIdx.x < MTOK / 8) ? *(const float4*)(p.out + (size_t)row * DM + 4 * lane + 256 * j) : float4{0.f, 0.f, 0.f, 0.f}; }
    for (int item = blockIdx.x; item < MTOK / 8; item += gridDim.x) {
        const int row = item * 8 + wave, b = row >> 13, t = row & 8191;
        const float* mv = modv + b * 6144;
        float4 v[4]; float ss = 0.f;
#pragma unroll
        for (int j = 0; j < 4; ++j) { v[j] = vn[j]; ss += v[j].x * v[j].x + v[j].y * v[j].y + v[j].z * v[j].z + v[j].w * v[j].w; }
        { const int nitem = item + gridDim.x;
          if (nitem < MTOK / 8) {
#pragma unroll
              for (int j = 0; j < 4; ++j) vn[j] = *(const float4*)(p.out + (size_t)(nitem * 8 + wave) * DM + 4 * lane + 256 * j); } }
        const float rstd = rsqrtf(wave_sum(ss) * (1.0f / DM) + EPS);
        float* rb = rowb + wave * 1024;
#pragma unroll
        for (int j = 0; j < 4; ++j) {
            const int c0 = 4 * lane + 256 * j;
            const float4 g = *(const float4*)(p.n2g + c0), sh = *(const float4*)(mv + 3072 + c0), sc = *(const float4*)(mv + 4096 + c0);
            float4 y; y.x = v[j].x * rstd * g.x * (1.f + sc.x) + sh.x; y.y = v[j].y * rstd * g.y * (1.f + sc.y) + sh.y;
            y.z = v[j].z * rstd * g.z * (1.f + sc.z) + sh.z; y.w = v[j].w * rstd * g.w * (1.f + sc.w) + sh.w;
            uint2 o; o.x = pk2(y.x, y.y); o.y = pk2(y.z, y.w);
            *(uint2*)(xn2 + (size_t)row * DM + c0) = o;
            *(float4*)(rb + c0) = y;
        }
        __syncthreads();
        const int e = lane & 15, kq = lane >> 4;
        float acc = 0.f;
#pragma unroll 8
        for (int j = 0; j < 64; ++j) {
            const int k = 16 * j + 4 * kq;
            const float4 xv = *(const float4*)(rb + k), wv = *(const float4*)(wt + e * 1028 + k);
            acc += xv.x * wv.x + xv.y * wv.y + xv.z * wv.z + xv.w * wv.w;
        }
        acc += __shfl_xor(acc, 16); acc += __shfl_xor(acc, 32);
        float mx = acc;
#pragma unroll
        for (int o = 1; o < 16; o <<= 1) mx = fmaxf(mx, __shfl_xor(mx, o));
        const float ex = expf(acc - mx);
        float sm = ex;
#pragma unroll
        for (int o = 1; o < 16; o <<= 1) sm += __shfl_xor(sm, o);
        if (kq == 0) aff[(size_t)(b * 16 + e) * 8192 + t] = ex / sm;
        __syncthreads();
    }
}

__device__ __forceinline__ void ph_topk(const P& p, unsigned char* lds) {
    const int tid = threadIdx.x, lane = tid & 63, wave = tid >> 6;
    unsigned* hist = (unsigned*)lds; unsigned* wtot = hist + 256; unsigned* sel = hist + 272;
    const float* aff = WSP(float, OFF_AFF); int* idx = WSP(int, OFF_IDX); float* gate = WSP(float, OFF_GATE); int* inv = WSP(int, OFF_INV);
    for (int prob = blockIdx.x; prob < 32; prob += gridDim.x) {
        const float* a = aff + (size_t)prob * 8192 + tid * 16;
        float v[16]; unsigned key[16];
#pragma unroll
        for (int j = 0; j < 4; ++j) { const float4 q = *(const float4*)(a + 4 * j); v[4 * j] = q.x; v[4 * j + 1] = q.y; v[4 * j + 2] = q.z; v[4 * j + 3] = q.w; }
#pragma unroll
        for (int i = 0; i < 16; ++i) key[i] = __float_as_uint(v[i]);
        unsigned prefix = 0u, kk = CAP;
#pragma unroll
        for (int pass = 0; pass < 4; ++pass) {
            const int shift = 24 - 8 * pass;
            const unsigned mhi = pass == 0 ? 0u : (0xFFFFFFFFu << (shift + 8));
            if (tid < 256) hist[tid] = 0u;
            __syncthreads();
#pragma unroll
            for (int i = 0; i < 16; ++i) if ((key[i] & mhi) == prefix) atomicAdd(&hist[(key[i] >> shift) & 255u], 1u);
            __syncthreads();
            unsigned h = 0u, s = 0u;
            if (tid < 256) {
                h = hist[tid]; s = h;
#pragma unroll
                for (int o = 1; o < 64; o <<= 1) { const unsigned n = __shfl_down(s, o); if (lane + o < 64) s += n; }
                if (lane == 0) wtot[wave] = s;
            }
            __syncthreads();
            if (tid < 256) {
                for (int w2 = wave + 1; w2 < 4; ++w2) s += wtot[w2];
                const unsigned sex = s - h;
                if (s >= kk && sex < kk) { sel[0] = (unsigned)tid; sel[1] = kk - sex; }
            }
            __syncthreads();
            prefix |= sel[0] << shift; kk = sel[1];
            __syncthreads();
        }
        const unsigned thr = prefix, krem = kk;
        unsigned cnt = 0u;
#pragma unroll
        for (int i = 0; i < 16; ++i) cnt += (key[i] > thr ? 1u : 0u) + (key[i] == thr ? 0x10000u : 0u);
        unsigned inc = cnt;
#pragma unroll
        for (int o = 1; o < 64; o <<= 1) { const unsigned n = __shfl_up(inc, o); if (lane >= o) inc += n; }
        if (lane == 63) wtot[wave] = inc;
        __syncthreads();
        unsigned before = inc - cnt;
        for (int w2 = 0; w2 < wave; ++w2) before += wtot[w2];
        unsigned gtr = before & 0xFFFFu, eqr = before >> 16;
#pragma unroll
        for (int i = 0; i < 16; ++i) {
            const int t = tid * 16 + i;
            const bool g = key[i] > thr, q = key[i] == thr;
            const bool s = g || (q && eqr < krem);
            const unsigned pos = gtr + (eqr < krem ? eqr : krem);
            if (s) { idx[prob * CAP + pos] = t; gate[prob * CAP + pos] = v[i]; }
            inv[(size_t)prob * 8192 + t] = s ? (int)pos : -1;
            gtr += g ? 1u : 0u; eqr += q ? 1u : 0u;
        }
        __syncthreads();
    }
}

__device__ __forceinline__ void ph_combine(const P& p) {
    const int tid = threadIdx.x, lane = tid & 63, wave = tid >> 6;
    const float* modv = WSP(float, OFF_MODV); const int* inv = WSP(int, OFF_INV); const bf16_t* Y = WSP(bf16_t, OFF_Y);
    const int stride = gridDim.x * NWAVE;
    int row = blockIdx.x * NWAVE + wave;
    int myinv = -1; float4 xv[4];
    if (row < MTOK) { myinv = lane < 16 ? inv[(size_t)((row >> 13) * 16 + lane) * 8192 + (row & 8191)] : -1;
#pragma unroll
        for (int j = 0; j < 4; ++j) xv[j] = *(const float4*)(p.out + (size_t)row * DM + 512 * (j >> 1) + 8 * lane + 4 * (j & 1)); }
    for (; row < MTOK; row += stride) {
        const int b = row >> 13;
        unsigned long long mask = __ballot(myinv >= 0);
        const int curinv = myinv; float4 xc[4];
#pragma unroll
        for (int j = 0; j < 4; ++j) xc[j] = xv[j];
        const int nrow = row + stride;
        if (nrow < MTOK) { myinv = lane < 16 ? inv[(size_t)((nrow >> 13) * 16 + lane) * 8192 + (nrow & 8191)] : -1;
#pragma unroll
            for (int j = 0; j < 4; ++j) xv[j] = *(const float4*)(p.out + (size_t)nrow * DM + 512 * (j >> 1) + 8 * lane + 4 * (j & 1)); }
        float acc[16];
#pragma unroll
        for (int i = 0; i < 16; ++i) acc[i] = 0.f;
        while (mask) {
            const int e = __ffsll((long long)mask) - 1; mask &= mask - 1;
            const int pos = __shfl(curinv, e);
            const bf16_t* yr = Y + ((size_t)(e * 2048 + b * 1024 + pos)) * DM;
            const uint4 u0 = *(const uint4*)(yr + 8 * lane), u1 = *(const uint4*)(yr + 512 + 8 * lane);
            acc[0] += bf2f(u0.x & 0xFFFFu); acc[1] += bf2f(u0.x >> 16); acc[2] += bf2f(u0.y & 0xFFFFu); acc[3] += bf2f(u0.y >> 16);
            acc[4] += bf2f(u0.z & 0xFFFFu); acc[5] += bf2f(u0.z >> 16); acc[6] += bf2f(u0.w & 0xFFFFu); acc[7] += bf2f(u0.w >> 16);
            acc[8] += bf2f(u1.x & 0xFFFFu); acc[9] += bf2f(u1.x >> 16); acc[10] += bf2f(u1.y & 0xFFFFu); acc[11] += bf2f(u1.y >> 16);
            acc[12] += bf2f(u1.z & 0xFFFFu); acc[13] += bf2f(u1.z >> 16); acc[14] += bf2f(u1.w & 0xFFFFu); acc[15] += bf2f(u1.w >> 16);
        }
        const float* g2 = modv + b * 6144 + 5120;
        float* orow = p.out + (size_t)row * DM;
#pragma unroll
        for (int j = 0; j < 4; ++j) {
            const int c0 = 512 * (j >> 1) + 8 * lane + 4 * (j & 1);
            const float4 gv = *(const float4*)(g2 + c0);
            float4 o; o.x = xc[j].x + gv.x * acc[4 * j]; o.y = xc[j].y + gv.y * acc[4 * j + 1]; o.z = xc[j].z + gv.z * acc[4 * j + 2]; o.w = xc[j].w + gv.w * acc[4 * j + 3];
            *(float4*)(orow + c0) = o;
        }
    }
}

namespace pg8 {
#define PG8_LAS __attribute__((address_space(3)))
typedef short bf16x8 __attribute__((ext_vector_type(8)));
typedef float f32x4 __attribute__((ext_vector_type(4)));
typedef unsigned u32x4 __attribute__((ext_vector_type(4)));
constexpr int BM = 256, BK = 64, HALF = 128, HTB = HALF * BK * 2, STAGE_BYTES = 8 * HTB;
__host__ __device__ __forceinline__ int lds_byte(int r, int c) { const int st = (r >> 4) * 2 + (c >> 5), rr = r & 15, cc = c & 31, ob = rr * 64 + cc * 2; return st * 1024 + (ob ^ (((ob >> 9) & 1) << 5)); }
__host__ __device__ __forceinline__ void stage_rc(int b, int& R, int& C) { const int st = b / 1024, sb = b % 1024, swz = sb ^ (((sb >> 9) & 1) << 5); R = (st >> 1) * 16 + swz / 64; C = (st & 1) * 32 + (swz % 64) / 2; }
__host__ __device__ __forceinline__ int perm32(int rho) { const int n = rho >> 4, i = rho & 15; return 8 * (i >> 2) + 4 * n + (i & 3); }
struct Unit { int pm, pn, am, bn, e; };
struct Gemm { const bf16_t* A; const bf16_t* Bt; int K; const int* idx; };
__device__ __forceinline__ unsigned cvt_pk_bf16(float lo, float hi) { unsigned r; asm volatile("v_cvt_pk_bf16_f32 %0, %1, %2" : "=v"(r) : "v"(lo), "v"(hi)); return r; }

template <class Epi, class Sched, bool GATHER, bool ALIGN_EPI, bool SP2>
__device__ __forceinline__ void gemm_phase(PG8_LAS unsigned char* lds, const Gemm g, const Sched& S, const Epi& E) {
    const int tid = threadIdx.x, wid = __builtin_amdgcn_readfirstlane(tid >> 6), lane = tid & 63, wr = wid >> 2, wc = wid & 3, fr = lane & 15, fq = lane >> 4;
    const int K = g.K, nt = K / BK;
    unsigned voffA[2], voffB[2]; int Rr[2], Cc[2];
#pragma unroll
    for (int i = 0; i < 2; ++i) { int R, C; stage_rc(tid * 16 + i * 8192, R, C); const int Rb = Epi::PERM ? ((R & ~31) + perm32(R & 31)) : R;
        voffA[i] = (unsigned)(R * K + C) * 2u; voffB[i] = (unsigned)(Rb * K + C) * 2u; Rr[i] = R; Cc[i] = C; }
    const size_t kstep = (size_t)(BK * 2);
    const size_t hstep = (size_t)HALF * K * 2;
    const size_t tstep = 2 * hstep;
    const unsigned ldsw = (unsigned)wid * 1024u;
    const int aoff = lds_byte(wr * 64 + fr, fq * 8), boff = lds_byte(wc * 32 + fr, fq * 8);
    unsigned vg[2][2], nvg[2][2];
#define PG8_GV(dst, u) do { _Pragma("unroll") for (int h_ = 0; h_ < 2; ++h_) _Pragma("unroll") for (int i_ = 0; i_ < 2; ++i_) { const int m_ = (u).pm * 256 + h_ * 128 + Rr[i_]; const int b_ = m_ >> 10; \
        const int tok_ = g.idx[(b_ * 16 + (u).e) * 1024 + (m_ & 1023)]; dst[h_][i_] = (unsigned)((b_ * 8192 + tok_) * K + Cc[i_]) * 2u; } } while (0)
#define PG8_SA(b, h) (((b) * 2 + (h)) * HTB)
#define PG8_SB(b, h) ((4 + (b) * 2 + (h)) * HTB)
#define PG8_STAGE(bufoff, gbase, voff) do { _Pragma("unroll") for (int _i = 0; _i < 2; ++_i) \
        __builtin_amdgcn_global_load_lds((const unsigned*)((const char*)(gbase) + (voff)[_i]), (PG8_LAS unsigned*)(lds + (bufoff) + ldsw + _i * 8192), 16, 0, 0); } while (0)
#define PG8_STAGE_A(bufoff, kb, h, GV) do { if constexpr (GATHER) { PG8_STAGE(bufoff, kb, GV[h]); } else { PG8_STAGE(bufoff, (kb) + (h) * hstep, voffA); } } while (0)
#define PG8_LDA(dst, b, h) do { _Pragma("unroll") for (int m = 0; m < 4; ++m) _Pragma("unroll") for (int k = 0; k < 2; ++k) dst[m][k] = *(const PG8_LAS bf16x8*)(lds + PG8_SA(b, h) + aoff + m * 2048 + k * 1024); } while (0)
#define PG8_LDB(dst, b, h) do { _Pragma("unroll") for (int n = 0; n < 2; ++n) _Pragma("unroll") for (int k = 0; k < 2; ++k) dst[n][k] = *(const PG8_LAS bf16x8*)(lds + PG8_SB(b, h) + boff + n * 2048 + k * 1024); } while (0)
#define PG8_MMA(ai, bj, At, Bt) do { __builtin_amdgcn_s_setprio(1); _Pragma("unroll") for (int m = 0; m < 4; ++m) _Pragma("unroll") for (int n = 0; n < 2; ++n) _Pragma("unroll") for (int k = 0; k < 2; ++k) \
        acc[ai][bj][m][n] = __builtin_amdgcn_mfma_f32_16x16x32_bf16(Bt[n][k], At[m][k], acc[ai][bj][m][n], 0, 0, 0); __builtin_amdgcn_s_setprio(0); } while (0)
#define PG8_WAIT_V(n) asm volatile("s_waitcnt vmcnt(" #n ")" ::: "memory")
#define PG8_WAIT_L(n) asm volatile("s_waitcnt lgkmcnt(" #n ")" ::: "memory")
#define PG8_BAR __builtin_amdgcn_s_barrier()
#define PG8_SCHED __builtin_amdgcn_sched_barrier(0)
    Unit cur, nxt; int ui = 0;
    if (!S.next(0, cur)) return;
    f32x4 acc[2][2][4][2];
#pragma unroll
    for (int a = 0; a < 2; ++a)
#pragma unroll
        for (int b = 0; b < 2; ++b)
#pragma unroll
            for (int m = 0; m < 4; ++m)
#pragma unroll
                for (int n = 0; n < 2; ++n) acc[a][b][m][n] = (f32x4){0.f, 0.f, 0.f, 0.f};
    bf16x8 At[4][2], B0[2][2], B1[2][2];
    const char* cA = GATHER ? (const char*)g.A : (const char*)g.A + (size_t)cur.am * tstep; const char* cB = (const char*)g.Bt + (size_t)cur.bn * tstep;
    if constexpr (GATHER) { PG8_GV(vg, cur); }
    if constexpr (SP2) {
        PG8_STAGE(PG8_SB(0, 0), cB, voffB); PG8_STAGE(PG8_SB(0, 1), cB + hstep, voffB); PG8_STAGE_A(PG8_SA(0, 0), cA, 0, vg); PG8_STAGE_A(PG8_SA(0, 1), cA, 1, vg);
        if (wr == 1) PG8_BAR;
        PG8_WAIT_V(2); PG8_BAR;
        PG8_STAGE(PG8_SB(1, 0), cB + kstep, voffB); PG8_STAGE_A(PG8_SA(1, 0), cA + kstep, 0, vg); PG8_STAGE(PG8_SB(1, 1), cB + hstep + kstep, voffB);
        PG8_WAIT_V(6); PG8_BAR;
    } else {
        PG8_STAGE(PG8_SB(0, 0), cB, voffB); PG8_STAGE_A(PG8_SA(0, 0), cA, 0, vg); PG8_STAGE(PG8_SB(0, 1), cB + hstep, voffB); PG8_STAGE_A(PG8_SA(0, 1), cA, 1, vg);
        if (wr == 1) PG8_BAR;
        PG8_WAIT_V(4); PG8_BAR;
        PG8_STAGE(PG8_SB(1, 0), cB + kstep, voffB); PG8_STAGE_A(PG8_SA(1, 0), cA + kstep, 0, vg); PG8_STAGE(PG8_SB(1, 1), cB + hstep + kstep, voffB);
        PG8_WAIT_V(6); PG8_BAR;
    }
    for (;;) {
        const bool has_next = S.next(ui + 1, nxt);
        const char* nA = GATHER ? cA : (has_next ? (const char*)g.A + (size_t)nxt.am * tstep : cA); const char* nB = has_next ? (const char*)g.Bt + (size_t)nxt.bn * tstep : cB;
        if constexpr (GATHER) { if (has_next) { PG8_GV(nvg, nxt); } else { _Pragma("unroll") for (int h_ = 0; h_ < 2; ++h_) _Pragma("unroll") for (int i_ = 0; i_ < 2; ++i_) nvg[h_][i_] = vg[h_][i_]; } }
        for (int t = 0; t < nt; t += 2) {
            const bool last = (t == nt - 2);
            const char* a1 = cA + (size_t)(t + 1) * kstep;
            const char* a2 = last ? nA : cA + (size_t)(t + 2) * kstep; const char* b2 = last ? nB : cB + (size_t)(t + 2) * kstep;
            const char* a3 = a2 + kstep; const char* b3 = b2 + kstep;
            unsigned sv[2][2];
            if constexpr (GATHER) { _Pragma("unroll") for (int h_ = 0; h_ < 2; ++h_) _Pragma("unroll") for (int i_ = 0; i_ < 2; ++i_) sv[h_][i_] = last ? nvg[h_][i_] : vg[h_][i_]; }
            if constexpr (SP2) {
            PG8_LDB(B0, 0, 0); PG8_LDB(B1, 0, 1); PG8_SCHED; PG8_LDA(At, 0, 0); PG8_STAGE_A(PG8_SA(1, 1), a1, 1, vg);
            PG8_WAIT_V(8); PG8_WAIT_L(0); PG8_BAR; PG8_MMA(0, 0, At, B0); PG8_MMA(0, 1, At, B1); PG8_BAR; PG8_SCHED;
            PG8_LDA(At, 0, 1); PG8_STAGE(PG8_SB(0, 0), b2, voffB); PG8_STAGE(PG8_SB(0, 1), b2 + hstep, voffB); PG8_STAGE_A(PG8_SA(0, 0), a2, 0, sv);
            PG8_WAIT_V(8); PG8_WAIT_L(0); PG8_BAR; PG8_MMA(1, 0, At, B0); PG8_MMA(1, 1, At, B1); PG8_BAR; PG8_SCHED;
            PG8_LDB(B0, 1, 0); PG8_LDB(B1, 1, 1); PG8_SCHED; PG8_LDA(At, 1, 0); PG8_STAGE_A(PG8_SA(0, 1), a2, 1, sv);
            PG8_WAIT_V(8); PG8_WAIT_L(0); PG8_BAR; PG8_MMA(0, 0, At, B0); PG8_MMA(0, 1, At, B1); PG8_BAR; PG8_SCHED;
            PG8_LDA(At, 1, 1); PG8_STAGE(PG8_SB(1, 0), b3, voffB); PG8_STAGE(PG8_SB(1, 1), b3 + hstep, voffB); PG8_STAGE_A(PG8_SA(1, 0), a3, 0, sv);
            PG8_WAIT_V(8); PG8_WAIT_L(0); PG8_BAR; PG8_MMA(1, 0, At, B0); PG8_MMA(1, 1, At, B1); PG8_BAR; PG8_SCHED;
            } else {
            PG8_LDB(B0, 0, 0); PG8_SCHED; PG8_LDA(At, 0, 0); PG8_STAGE_A(PG8_SA(1, 1), a1, 1, vg);
            PG8_WAIT_L(8); PG8_BAR; PG8_WAIT_L(0); PG8_MMA(0, 0, At, B0); PG8_BAR; PG8_SCHED;
            PG8_LDB(B1, 0, 1); PG8_STAGE(PG8_SB(0, 0), b2, voffB);
            PG8_BAR; PG8_WAIT_L(0); PG8_MMA(0, 1, At, B1); PG8_BAR;
            PG8_LDA(At, 0, 1); PG8_STAGE_A(PG8_SA(0, 0), a2, 0, sv);
            PG8_BAR; PG8_WAIT_L(0); PG8_MMA(1, 0, At, B0); PG8_BAR; PG8_SCHED;
            PG8_STAGE(PG8_SB(0, 1), b2 + hstep, voffB);
            PG8_WAIT_V(6); PG8_BAR; PG8_MMA(1, 1, At, B1); PG8_BAR;
            PG8_LDB(B0, 1, 0); PG8_SCHED; PG8_LDA(At, 1, 0); PG8_STAGE_A(PG8_SA(0, 1), a2, 1, sv);
            PG8_WAIT_L(8); PG8_BAR; PG8_WAIT_L(0); PG8_MMA(0, 0, At, B0); PG8_BAR; PG8_SCHED;
            PG8_LDB(B1, 1, 1); PG8_STAGE(PG8_SB(1, 0), b3, voffB);
            PG8_BAR; PG8_WAIT_L(0); PG8_MMA(0, 1, At, B1); PG8_BAR;
            PG8_LDA(At, 1, 1); PG8_STAGE_A(PG8_SA(1, 0), a3, 0, sv);
            PG8_BAR; PG8_WAIT_L(0); PG8_MMA(1, 0, At, B0); PG8_BAR; PG8_SCHED;
            PG8_STAGE(PG8_SB(1, 1), b3 + hstep, voffB);
            PG8_WAIT_V(6); PG8_BAR; PG8_MMA(1, 1, At, B1); PG8_BAR;
            }
        }
        if constexpr (ALIGN_EPI) { if (wr == 0) PG8_BAR; }
        E(acc, cur, wr, wc, fr, fq);
        if (!has_next) break;
#pragma unroll
        for (int a = 0; a < 2; ++a)
#pragma unroll
            for (int b = 0; b < 2; ++b)
#pragma unroll
                for (int m = 0; m < 4; ++m)
#pragma unroll
                    for (int n = 0; n < 2; ++n) acc[a][b][m][n] = (f32x4){0.f, 0.f, 0.f, 0.f};
        cur = nxt; cA = nA; cB = nB; ++ui;
        if constexpr (GATHER) { _Pragma("unroll") for (int h_ = 0; h_ < 2; ++h_) _Pragma("unroll") for (int i_ = 0; i_ < 2; ++i_) vg[h_][i_] = nvg[h_][i_]; }
        if constexpr (ALIGN_EPI) { if (wr == 1) PG8_BAR; }
    }
    PG8_WAIT_V(0);
    if constexpr (!ALIGN_EPI) { if (wr == 0) PG8_BAR; }
    PG8_BAR;
#undef PG8_GV
#undef PG8_SA
#undef PG8_SB
#undef PG8_STAGE
#undef PG8_STAGE_A
#undef PG8_LDA
#undef PG8_LDB
#undef PG8_MMA
#undef PG8_WAIT_V
#undef PG8_WAIT_L
#undef PG8_BAR
#undef PG8_SCHED
}
}


struct SchedGrid {
    int nM, nN, nwg, G, c, extra;
    __device__ void init(int nM_, int nN_, int G_, int c_, int extra_) { nM = nM_; nN = nN_; nwg = nM * nN; G = G_; c = c_; extra = extra_; }
    __device__ bool next(int i, pg8::Unit& u) const {
        const int L = i * G + c; if (L >= nwg + extra) return false;
        if (L >= nwg) { u.pm = nM + (L - nwg); u.pn = 2; }
        else { int wgid = L; { const int q = nwg / 8, r = nwg % 8, xcd = wgid % 8, off = wgid / 8; wgid = (xcd < r ? xcd * (q + 1) : r * (q + 1) + (xcd - r) * q) + off; }
               const int nig = 8 * nN, gid = wgid / nig, fm = gid * 8, gsz = (nM - fm) < 8 ? (nM - fm) : 8;
               u.pm = fm + ((wgid % nig) % gsz); u.pn = (wgid % nig) / gsz; }
        u.am = u.pm; u.bn = u.pn; u.e = 0; return true;
    }
};
struct SchedGateUp {
    int G, c;
    __device__ bool next(int i, pg8::Unit& u) const {
        int bt, pm;
        if (G == 256) { if (i >= 11) return false; const int x = c & 7, s = c >> 3; bt = i * 32 + x * 4 + (s >> 3); pm = s & 7; }
        else { const int L = i * G + c; if (L >= 2816) return false; bt = L >> 3; pm = L & 7; }
        u.e = bt / 22; u.pn = bt % 22; u.pm = pm; u.am = 0; u.bn = bt; return true;
    }
};
struct SchedDown {
    int G, c;
    __device__ bool next(int i, pg8::Unit& u) const {
        if (G == 256) { if (i >= 2) return false; const int x = c & 7, s = c >> 3; u.e = i * 8 + x; u.pm = s & 7; u.pn = s >> 3; }
        else { const int L = i * G + c; if (L >= 512) return false; u.e = L >> 5; u.pm = L & 7; u.pn = (L >> 3) & 3; }
        u.am = u.e * 8 + u.pm; u.bn = u.e * 4 + u.pn; return true;
    }
};

using pg8::f32x4; using pg8::u32x4;
__device__ __forceinline__ u32x4 pack8(const f32x4& a, const f32x4& b) { u32x4 w; w.x = pg8::cvt_pk_bf16(a[0], a[1]); w.y = pg8::cvt_pk_bf16(a[2], a[3]); w.z = pg8::cvt_pk_bf16(b[0], b[1]); w.w = pg8::cvt_pk_bf16(b[2], b[3]); return w; }
struct EpiInproj {
    static constexpr bool PERM = true;
    bf16_t *Q, *Kb, *Vb; float* PT; const float *rope, *qng, *kng;
    __device__ __forceinline__ void operator()(const f32x4 (&acc)[2][2][4][2], const pg8::Unit& u, int wr, int wc, int fr, int fq) const {
        const int row0 = u.pm * 256 + wr * 64 + fr;
        if (u.pn >= 3) {
            const int colb = u.pn * 256 + wc * 32 + fq * 8 - 768;
#pragma unroll
            for (int ai = 0; ai < 2; ++ai)
#pragma unroll
                for (int m = 0; m < 4; ++m) { const int row = row0 + ai * 128 + m * 16;
#pragma unroll
                    for (int bj = 0; bj < 2; ++bj)
#pragma unroll
                        for (int n = 0; n < 2; ++n)
#pragma unroll
                            for (int e = 0; e < 4; ++e) PT[(size_t)(colb + bj * 128 + n * 4 + e) * MTOK + row] = acc[ai][bj][m][n][e]; }
        } else if (u.pn == 2 && wc >= 2) {
#pragma unroll
            for (int ai = 0; ai < 2; ++ai)
#pragma unroll
                for (int m = 0; m < 4; ++m) { const int row = row0 + ai * 128 + m * 16;
                    size_t kvrow; if (row < MTOK) kvrow = (size_t)(row >> 13) * LK + (row & 8191); else { const int j = row - MTOK; kvrow = (size_t)(j >> 8) * LK + SEQ + (j & 255); }
#pragma unroll
                    for (int bj = 0; bj < 2; ++bj) *(u32x4*)(Vb + kvrow * 128 + (wc - 2) * 64 + bj * 32 + fq * 8) = pack8(acc[ai][bj][m][0], acc[ai][bj][m][1]); }
        } else {
            const bool isq = u.pn < 2; const float* gn = isq ? qng : kng;
            f32x4 g[2][2];
#pragma unroll
            for (int bj = 0; bj < 2; ++bj)
#pragma unroll
                for (int n = 0; n < 2; ++n) g[bj][n] = *(const f32x4*)(gn + bj * 32 + n * 16 + fq * 4);
#pragma unroll
            for (int ai = 0; ai < 2; ++ai)
#pragma unroll
                for (int m = 0; m < 4; ++m) { const int row = row0 + ai * 128 + m * 16; const bool tok = row < MTOK; const int t = row & 8191;
                    float ss = 0.f;
#pragma unroll
                    for (int bj = 0; bj < 2; ++bj)
#pragma unroll
                        for (int n = 0; n < 2; ++n) { const f32x4 v = acc[ai][bj][m][n]; ss += v[0] * v[0] + v[1] * v[1] + v[2] * v[2] + v[3] * v[3]; }
                    ss += __shfl_xor(ss, 16); ss += __shfl_xor(ss, 32);
                    const float rstd = rsqrtf(ss * (1.0f / 64.0f) + EPS);
                    bf16_t* dst; if (isq) dst = Q + (size_t)row * 512 + (4 * u.pn + wc) * 64;
                    else { size_t kvrow; if (tok) kvrow = (size_t)(row >> 13) * LK + t; else { const int j = row - MTOK; kvrow = (size_t)(j >> 8) * LK + SEQ + (j & 255); } dst = Kb + kvrow * 128 + wc * 64; }
#pragma unroll
                    for (int bj = 0; bj < 2; ++bj) {
                        f32x4 x1 = acc[ai][bj][m][0] * rstd * g[bj][0], x2 = acc[ai][bj][m][1] * rstd * g[bj][1];
                        if (tok) { const int pos = bj == 0 ? (t >> 6) : (t & 63);
                            const f32x4 ra = *(const f32x4*)(rope + (pos * 16 + fq * 4) * 2), rb = *(const f32x4*)(rope + (pos * 16 + fq * 4) * 2 + 4);
                            const f32x4 cs = {ra[0], ra[2], rb[0], rb[2]}, sn = {ra[1], ra[3], rb[1], rb[3]};
                            const f32x4 o1 = x1 * cs - x2 * sn, o2 = x1 * sn + x2 * cs; x1 = o1; x2 = o2; }
                        if (isq) { x1 = x1 * C2; x2 = x2 * C2; }
                        *(u32x4*)(dst + bj * 32 + fq * 8) = pack8(x1, x2);
                    } }
        }
    }
};
struct EpiOutproj {
    static constexpr bool PERM = false;
    const float* x; const float* modv; float* out;
    __device__ __forceinline__ void operator()(const f32x4 (&acc)[2][2][4][2], const pg8::Unit& u, int wr, int wc, int fr, int fq) const {
#pragma unroll
        for (int ai = 0; ai < 2; ++ai)
#pragma unroll
            for (int m = 0; m < 4; ++m) { const int row = u.pm * 256 + ai * 128 + wr * 64 + m * 16 + fr; const float* g1 = modv + (row >> 13) * 6144 + 2048;
#pragma unroll
                for (int bj = 0; bj < 2; ++bj)
#pragma unroll
                    for (int n = 0; n < 2; ++n) { const int col = u.pn * 256 + bj * 128 + wc * 32 + n * 16 + fq * 4;
                        const f32x4 xv = *(const f32x4*)(x + (size_t)row * DM + col), gv = *(const f32x4*)(g1 + col);
                        *(f32x4*)(out + (size_t)row * DM + col) = xv + gv * acc[ai][bj][m][n]; } }
    }
};
struct EpiGateUp {
    static constexpr bool PERM = true;
    bf16_t* H;
    __device__ __forceinline__ void operator()(const f32x4 (&acc)[2][2][4][2], const pg8::Unit& u, int wr, int wc, int fr, int fq) const {
#pragma unroll
        for (int ai = 0; ai < 2; ++ai)
#pragma unroll
            for (int m = 0; m < 4; ++m) { const int row = u.pm * 256 + ai * 128 + wr * 64 + m * 16 + fr;
                f32x4 o[2];
#pragma unroll
                for (int n = 0; n < 2; ++n)
#pragma unroll
                    for (int e = 0; e < 4; ++e) { const float gv = acc[ai][0][m][n][e]; o[n][e] = gv * __builtin_amdgcn_rcpf(1.0f + __builtin_amdgcn_exp2f(-1.4426950408889634f * gv)) * acc[ai][1][m][n][e]; }
                *(u32x4*)(H + ((size_t)(u.e * 2048 + row)) * DEXP_P + u.pn * 128 + wc * 32 + fq * 8) = pack8(o[0], o[1]); }
    }
};
struct EpiDown {
    static constexpr bool PERM = true;
    bf16_t* Y; const float* gate;
    __device__ __forceinline__ void operator()(const f32x4 (&acc)[2][2][4][2], const pg8::Unit& u, int wr, int wc, int fr, int fq) const {
#pragma unroll
        for (int ai = 0; ai < 2; ++ai)
#pragma unroll
            for (int m = 0; m < 4; ++m) { const int row = u.pm * 256 + ai * 128 + wr * 64 + m * 16 + fr;
                const float gt = gate[((row >> 10) * 16 + u.e) * CAP + (row & 1023)];
#pragma unroll
                for (int bj = 0; bj < 2; ++bj)
                    *(u32x4*)(Y + ((size_t)(u.e * 2048 + row)) * DM + u.pn * 256 + bj * 128 + wc * 32 + fq * 8) = pack8(acc[ai][bj][m][0] * gt, acc[ai][bj][m][1] * gt); }
    }
};

__device__ __forceinline__ int win_src_col(int g) {
    const int pn = g >> 8;
    if (pn >= 3) return g;
    const int bj = (g >> 7) & 1, wc = (g >> 5) & 3, ci = g & 31, fq = ci >> 3, n = (ci >> 2) & 1, j = ci & 3;
    const int dim = bj * 32 + n * 16 + fq * 4 + j;
    if (pn < 2) return (4 * pn + wc) * 64 + dim;
    if (wc < 2) return 512 + wc * 64 + dim;
    return 640 + (wc - 2) * 64 + bj * 32 + ci;
}
struct CvtItem { const float* src; bf16_t* dst; size_t ldn, ldk; };
__device__ __forceinline__ void cvt_load(const CvtItem& c, float4 (&v)[16], int lane) {
    const int kq = lane >> 4, n4 = 4 * (lane & 15);
#pragma unroll
    for (int i = 0; i < 16; ++i) v[i] = *(const float4*)(c.src + (size_t)(4 * i + kq) * c.ldn + n4);
}
__device__ __forceinline__ void cvt_store_rows(bf16_t* dst, size_t ldk, const float* scr, int lane) {
    const int c = lane >> 3, np = lane & 7;
#pragma unroll
    for (int j = 0; j < 8; ++j) { const int n = np + 8 * j; const float* sp = scr + (8 * c) * 65 + n;
        uint4 o; o.x = hw_pk2(sp[0], sp[65]); o.y = hw_pk2(sp[2 * 65], sp[3 * 65]); o.z = hw_pk2(sp[4 * 65], sp[5 * 65]); o.w = hw_pk2(sp[6 * 65], sp[7 * 65]);
        *(uint4*)(dst + (size_t)n * ldk + 8 * c) = o; }
    asm volatile("s_waitcnt lgkmcnt(0)" ::: "memory");
}
__device__ __forceinline__ void cvt_finish(const CvtItem& c, const float4 (&v)[16], float* scr, int lane) {
    const int kq = lane >> 4, n4 = 4 * (lane & 15);
#pragma unroll
    for (int i = 0; i < 16; ++i) { float* d = scr + (4 * i + kq) * 65 + n4; d[0] = v[i].x; d[1] = v[i].y; d[2] = v[i].z; d[3] = v[i].w; }
    asm volatile("s_waitcnt lgkmcnt(0)" ::: "memory");
    cvt_store_rows(c.dst, c.ldk, scr, lane);
}
constexpr int CV_IG = 16 * 16 * 43, CV_ID = 16 * 43 * 16, CV_IO = 16 * 16, CV_II = 16 * 36, CV_NF = 2 * CV_IG + CV_ID + CV_IO;
__device__ __forceinline__ CvtItem cvt_decode(const P& p, int r) {
    CvtItem c;
    if (r < 2 * CV_IG) { const int up = r >= CV_IG; if (up) r -= CV_IG; const int e = r / (16 * 43), q = r % (16 * 43), kb = q / 43, nb = q % 43;
        c.src = (up ? p.w_up : p.w_gate) + (size_t)e * DM * DEXP + (size_t)(kb * 64) * DEXP + nb * 64; c.ldn = DEXP;
        c.dst = WSP(bf16_t, OFF_WGU) + ((size_t)e * 5632 + (nb >> 1) * 256 + up * 128 + (nb & 1) * 64) * DM + kb * 64; c.ldk = DM; return c; }
    r -= 2 * CV_IG;
    if (r < CV_ID) { const int e = r / (43 * 16), q = r % (43 * 16), kb = q / 16, nb = q % 16;
        c.src = p.w_down + (size_t)e * DEXP * DM + (size_t)(kb * 64) * DM + nb * 64; c.ldn = DM;
        c.dst = WSP(bf16_t, OFF_WD) + ((size_t)e * 1024 + nb * 64) * DEXP_P + kb * 64; c.ldk = DEXP_P; return c; }
    r -= CV_ID;
    { const int kb = r / 16, nb = r % 16; c.src = p.w_out + (size_t)(kb * 64) * DM + nb * 64; c.ldn = DM; c.dst = WSP(bf16_t, OFF_WOUT) + (size_t)(nb * 64) * DM + kb * 64; c.ldk = DM; }
    return c;
}
constexpr int CV_NMOE = 2 * CV_IG + CV_ID;
__device__ __forceinline__ void cvt_range(const P& p, unsigned char* lds, int a0, int na, int b0, int nb, int bl, int nbl) {
    int tidl = threadIdx.x; asm volatile("" : "+v"(tidl));
    const int lane = tidl & 63, wave = tidl >> 6;
    float* scr = (float*)lds + wave * (64 * 65);
    const int st = nbl * NWAVE, n = na + nb;
#define CV_IT(v) ((v) < na ? a0 + (v) : b0 + ((v) - na))
    float4 va[16], vb[16]; CvtItem ca, cb;
    int v = bl * NWAVE + wave;
    if (v < n) { ca = cvt_decode(p, CV_IT(v)); cvt_load(ca, va, lane); }
#pragma unroll 1
    while (v < n) {
        const int v1 = v + st;
        if (v1 < n) { cb = cvt_decode(p, CV_IT(v1)); cvt_load(cb, vb, lane); }
        cvt_finish(ca, va, scr, lane);
        if (v1 >= n) break;
        const int v2 = v1 + st;
        if (v2 < n) { ca = cvt_decode(p, CV_IT(v2)); cvt_load(ca, va, lane); }
        cvt_finish(cb, vb, scr, lane);
        v = v2;
    }
#undef CV_IT
}
__device__ __forceinline__ void cvt_win(const P& p, unsigned char* lds) {
    const int lane = threadIdx.x & 63, wave = threadIdx.x >> 6;
    float* scr = (float*)lds + wave * (64 * 65);
    bf16_t* win = WSP(bf16_t, OFF_WIN);
    for (int r = blockIdx.x * NWAVE + wave; r < CV_II; r += gridDim.x * NWAVE) {
        const int kb = r / 36, nb = r % 36, sc = win_src_col(nb * 64 + lane);
#pragma unroll 16
        for (int k = 0; k < 64; ++k) scr[k * 65 + lane] = p.w_in[(size_t)(kb * 64 + k) * INW + sc];
        asm volatile("s_waitcnt lgkmcnt(0)" ::: "memory");
        cvt_store_rows(win + (size_t)(nb * 64) * DM + kb * 64, DM, scr, lane);
    }
}
__device__ __forceinline__ void zero_wgu_pad(const P& p, int bl, int nbl) {
    bf16_t* wgu = WSP(bf16_t, OFF_WGU); const uint4 z = {0u, 0u, 0u, 0u};
    for (int i = bl * NTHR + threadIdx.x; i < 16 * 128 * 128; i += nbl * NTHR) {
        const int e = i >> 14, rr = (i >> 7) & 127, ch = i & 127, row = 21 * 256 + (rr < 64 ? 64 + rr : 192 + (rr - 64));
        *(uint4*)(wgu + ((size_t)e * 5632 + row) * DM + ch * 8) = z; }
}
__device__ __forceinline__ void zero_wd_pad(const P& p, int bl, int nbl) {
    bf16_t* wd = WSP(bf16_t, OFF_WD); const uint4 z = {0u, 0u, 0u, 0u};
    for (int i = bl * NTHR + threadIdx.x; i < 16 * 1024 * 8; i += nbl * NTHR) *(uint4*)(wd + (size_t)(i >> 3) * DEXP_P + DEXP + (i & 7) * 8) = z;
}

#define PG8_SP2 true
__device__ __forceinline__ void ph_inproj(const P& p, unsigned char* lds) {
    pg8::Gemm g{WSP(bf16_t, OFF_XN), WSP(bf16_t, OFF_WIN), DM, nullptr};
    SchedGrid S; S.init(64, 9, gridDim.x, blockIdx.x, 2);
    EpiInproj E{WSP(bf16_t, OFF_Q), WSP(bf16_t, OFF_K), WSP(bf16_t, OFF_V), WSP(float, OFF_PT), WSP(float, OFF_ROPE), p.qng, p.kng};
    pg8::gemm_phase<EpiInproj, SchedGrid, false, true, PG8_SP2>((PG8_LAS unsigned char*)lds, g, S, E);
}
__device__ __forceinline__ void ph_outproj(const P& p, unsigned char* lds) {
    pg8::Gemm g{WSP(bf16_t, OFF_AO), WSP(bf16_t, OFF_WOUT), DM, nullptr};
    SchedGrid S; S.init(64, 4, gridDim.x, blockIdx.x, 0);
    EpiOutproj E{p.x, WSP(float, OFF_MODV), p.out};
    pg8::gemm_phase<EpiOutproj, SchedGrid, false, true, PG8_SP2>((PG8_LAS unsigned char*)lds, g, S, E);
}
__device__ __forceinline__ void ph_gateup(const P& p, unsigned char* lds) {
    pg8::Gemm g{WSP(bf16_t, OFF_XN2), WSP(bf16_t, OFF_WGU), DM, WSP(int, OFF_IDX)};
    SchedGateUp S{(int)gridDim.x, (int)blockIdx.x};
    EpiGateUp E{WSP(bf16_t, OFF_H)};
    pg8::gemm_phase<EpiGateUp, SchedGateUp, true, true, PG8_SP2>((PG8_LAS unsigned char*)lds, g, S, E);
}
__device__ __forceinline__ void ph_down(const P& p, unsigned char* lds) {
    pg8::Gemm g{WSP(bf16_t, OFF_H), WSP(bf16_t, OFF_WD), DEXP_P, nullptr};
    SchedDown S{(int)gridDim.x, (int)blockIdx.x};
    EpiDown E{WSP(bf16_t, OFF_Y), WSP(float, OFF_GATE)};
    pg8::gemm_phase<EpiDown, SchedDown, false, true, PG8_SP2>((PG8_LAS unsigned char*)lds, g, S, E);
}


namespace attn_body {
using bf16x8 = __attribute__((ext_vector_type(8))) short;
using s16x4 = __attribute__((ext_vector_type(4))) short;
using f32x16 = __attribute__((ext_vector_type(16))) float;
using u32x4 = __attribute__((ext_vector_type(4))) unsigned;
constexpr int D = 64, QP = 512, KP = 128, OP = 1024;
constexpr int NW = 8, QBLK = 32, QB = QBLK * NW, KVBLK = 64;
__device__ __forceinline__ int crow(int r, int hi) { return (r & 3) + 8 * (r >> 2) + 4 * hi; }
#define SBAR() __builtin_amdgcn_sched_barrier(0)
constexpr int NSLOT = 3, SLOTB = 8192;
constexpr int LDS_K = 0, LDS_V = NSLOT * SLOTB, LDS_WS = 2 * NSLOT * SLOTB, LDS_OST = LDS_WS + NW * 64 * 4, ATTN_LDS_BYTES = LDS_OST + NW * 4096;
__device__ __forceinline__ void glds16(const void* gsrc, unsigned lds_dst) { unsigned keep;
    asm volatile("s_mov_b32 %0, m0\n\ts_mov_b32 m0, %2\n\ts_nop 0\n\tglobal_load_lds_dwordx4 %1, off\n\ts_mov_b32 m0, %0" : "=&s"(keep) : "v"(gsrc), "s"(lds_dst) : "memory"); }
__device__ __forceinline__ float max3f(float a, float b, float c) { float r; asm("v_max3_f32 %0, %1, %2, %3" : "=v"(r) : "v"(a), "v"(b), "v"(c)); return r; }
__device__ __forceinline__ float max2f(float a, float b) { float r; asm("v_max_f32_e32 %0, %1, %2" : "=v"(r) : "v"(a), "v"(b)); return r; }
__device__ __forceinline__ float fadd_s(float a, float b) { float r; asm("v_add_f32_e32 %0, %1, %2" : "=v"(r) : "v"(a), "v"(b)); return r; }
__device__ __forceinline__ float fsub_s(float a, float b) { float r; asm("v_sub_f32_e32 %0, %1, %2" : "=v"(r) : "v"(a), "v"(b)); return r; }
typedef float f32x2_t __attribute__((ext_vector_type(2))); typedef __bf16 bf16x2_t __attribute__((ext_vector_type(2)));
__device__ __forceinline__ unsigned cvtpk_s(float lo, float hi) { f32x2_t v = {lo, hi}; bf16x2_t b = __builtin_convertvector(v, bf16x2_t); return __builtin_bit_cast(unsigned, b); }
#define WAIT_BAR(N) asm volatile("s_waitcnt vmcnt(" #N ") lgkmcnt(0)\n\ts_barrier" ::: "memory")
__device__ __forceinline__ void qkt(f32x16& p0, f32x16& p1, const char* Kslot, const bf16x8* qr, const f32x16& negm, int r32, int hi) {
    const char* kb = Kslot + hi * 1024 + r32 * 16;
#pragma unroll
    for (int d0 = 0; d0 < 4; ++d0) {
        const bf16x8 b0 = *reinterpret_cast<const bf16x8*>(kb + d0 * 2048);
        const bf16x8 b1 = *reinterpret_cast<const bf16x8*>(kb + d0 * 2048 + 512);
        if (d0 == 0) { p0 = __builtin_amdgcn_mfma_f32_32x32x16_bf16(b0, qr[0], negm, 0, 0, 0); p1 = __builtin_amdgcn_mfma_f32_32x32x16_bf16(b1, qr[0], negm, 0, 0, 0); }
        else { p0 = __builtin_amdgcn_mfma_f32_32x32x16_bf16(b0, qr[d0], p0, 0, 0, 0); p1 = __builtin_amdgcn_mfma_f32_32x32x16_bf16(b1, qr[d0], p1, 0, 0, 0); } }
}
typedef __attribute__((address_space(3))) const char* lds_cptr;
typedef short v4i16_t __attribute__((ext_vector_type(4)));
__device__ __forceinline__ void kload8(bf16x8* kf, lds_cptr kp) {
    kf[0] = *(const __attribute__((address_space(3))) bf16x8*)(kp);        kf[1] = *(const __attribute__((address_space(3))) bf16x8*)(kp + 512);
    kf[2] = *(const __attribute__((address_space(3))) bf16x8*)(kp + 2048); kf[3] = *(const __attribute__((address_space(3))) bf16x8*)(kp + 2560);
    kf[4] = *(const __attribute__((address_space(3))) bf16x8*)(kp + 4096); kf[5] = *(const __attribute__((address_space(3))) bf16x8*)(kp + 4608);
    kf[6] = *(const __attribute__((address_space(3))) bf16x8*)(kp + 6144); kf[7] = *(const __attribute__((address_space(3))) bf16x8*)(kp + 6656);
}
__device__ __forceinline__ void kload2(bf16x8* kf, lds_cptr kp, int j) { kf[2 * j] = *(const __attribute__((address_space(3))) bf16x8*)(kp + j * 2048); kf[2 * j + 1] = *(const __attribute__((address_space(3))) bf16x8*)(kp + j * 2048 + 512); }
__device__ __forceinline__ s16x4 vtr(lds_cptr p) { return __builtin_bit_cast(s16x4, __builtin_amdgcn_ds_read_tr16_b64_v4i16((__attribute__((address_space(3))) v4i16_t*)p)); }
__device__ __forceinline__ float rowmax(const f32x16& p0, const f32x16& p1) {
    float a = max3f(p0[0], p0[1], p1[0]), b = max3f(p0[2], p0[3], p1[1]); a = max3f(a, p1[2], p1[3]);
#pragma unroll
    for (int r = 4; r < 16; r += 4) { a = max3f(a, p0[r], p0[r + 1]); b = max3f(b, p0[r + 2], p0[r + 3]); a = max3f(a, p1[r], p1[r + 1]); b = max3f(b, p1[r + 2], p1[r + 3]); }
    const float m = max2f(a, b);
    auto rr = __builtin_amdgcn_permlane32_swap(__float_as_uint(m), __float_as_uint(m), false, false);
    return max2f(__uint_as_float(rr[0]), __uint_as_float(rr[1]));
}
__device__ __forceinline__ void pv(f32x16* o, int vb, bf16x8 pa0, bf16x8 pa1, bf16x8 pa2, bf16x8 pa3) {
#pragma unroll
    for (int d0 = 0; d0 < 2; ++d0) { s16x4 lo[4], hi[4];
#pragma unroll
        for (int ks = 0; ks < 4; ++ks) {
            asm volatile("ds_read_b64_tr_b16 %0,%1 offset:%c2" : "=&v"(lo[ks]) : "v"(vb), "i"(d0 * 4096 + ks * 1024) : "memory");
            asm volatile("ds_read_b64_tr_b16 %0,%1 offset:%c2" : "=&v"(hi[ks]) : "v"(vb), "i"(d0 * 4096 + ks * 1024 + 512) : "memory"); }
        asm volatile("s_waitcnt lgkmcnt(0)" ::: "memory"); SBAR();
#define PK(k) (bf16x8){lo[k][0], lo[k][1], lo[k][2], lo[k][3], hi[k][0], hi[k][1], hi[k][2], hi[k][3]}
        o[d0] = __builtin_amdgcn_mfma_f32_32x32x16_bf16(pa0, PK(0), o[d0], 0, 0, 0);
        o[d0] = __builtin_amdgcn_mfma_f32_32x32x16_bf16(pa1, PK(1), o[d0], 0, 0, 0);
        o[d0] = __builtin_amdgcn_mfma_f32_32x32x16_bf16(pa2, PK(2), o[d0], 0, 0, 0);
        o[d0] = __builtin_amdgcn_mfma_f32_32x32x16_bf16(pa3, PK(3), o[d0], 0, 0, 0);
#undef PK
    }
}
template <int THRL> __device__ __forceinline__ void attn_unit(int b, int h, int qb, const bf16_t* Q, const bf16_t* __restrict__ K, const bf16_t* __restrict__ V, bf16_t* O, char* shm) {
    const int tid = threadIdx.x, lane = tid & 63, r32 = lane & 31, hi = lane >> 5; const int wid = __builtin_amdgcn_readfirstlane(tid >> 6);
    const int q0 = qb * QB;
    const bf16_t* Qw = Q + ((long)b * SEQ + q0 + wid * QBLK) * QP + h * D;
    const bf16_t* Kh = K + (long)b * LK * KP + (h >> 2) * D, *Vh = V + (long)b * LK * KP + (h >> 2) * D;
    const unsigned lds0 = (unsigned)(uintptr_t)shm;
    float* wsf = (float*)(shm + LDS_WS) + wid * 64;
    const bf16_t* ksrc = Kh + (long)lane * KP + wid * 8;
    const bf16_t* vsrc = Vh + (long)(16 * (wid & 3) + (lane >> 2)) * KP + (wid >> 2) * 32 + (lane & 3) * 8;
    const unsigned kdst = lds0 + LDS_K + wid * 1024, vdst = lds0 + LDS_V + wid * 1024;
#define DMA_K(t, slot) glds16(ksrc + (long)(t) * KVBLK * KP, (unsigned)__builtin_amdgcn_readfirstlane(kdst + (slot)))
#define DMA_V(t, slot) glds16(vsrc + (long)(t) * KVBLK * KP, (unsigned)__builtin_amdgcn_readfirstlane(vdst + (slot)))
    const int vb0 = (int)(lds0 + LDS_V) + ((lane >> 4) & 1) * 32 + (lane & 3) * 8 + (4 * hi + ((lane & 15) >> 2)) * 64;
    const char* Kbase = shm + LDS_K; bf16x8 kf[8];
    const lds_cptr shm3 = (lds_cptr)shm; const lds_cptr kp0 = shm3 + LDS_K + hi * 1024 + r32 * 16; const lds_cptr vp0 = shm3 + LDS_V + ((lane >> 4) & 1) * 32 + (lane & 3) * 8 + (4 * hi + ((lane & 15) >> 2)) * 64;
    constexpr int NT = LK / KVBLK;
    DMA_K(0, 0); DMA_V(0, 0); DMA_K(1, SLOTB);
    bf16x8 qr[4];
#pragma unroll
    for (int d0 = 0; d0 < 4; ++d0) qr[d0] = *reinterpret_cast<const bf16x8*>(&Qw[(long)r32 * QP + d0 * 16 + hi * 8]);
    float mhat = 0.f, l_reg = 0.f; f32x16 o[2]; o[0] = f32x16{}; o[1] = f32x16{}; f32x16 negm = f32x16{}; asm volatile("" : "+v"(negm));
    bool resc = false;
#define START(P0, P1) do { const float rm = rowmax(P0, P1); resc = false; \
    { const float dl = rm; mhat = fadd_s(mhat, dl); \
      _Pragma("unroll") for (int r = 0; r < 16; ++r) { P0[r] = fsub_s(P0[r], dl); P1[r] = fsub_s(P1[r], dl); } \
      _Pragma("unroll") for (int r = 0; r < 16; ++r) negm[r] = -mhat; asm volatile("" : "+v"(negm)); } \
    _Pragma("unroll") for (int r = 0; r < 16; ++r) P0[r] = __builtin_amdgcn_exp2f(P0[r]); } while (0)
#define RESC() do { if (resc) { asm volatile("s_waitcnt lgkmcnt(0)" ::: "memory"); \
      _Pragma("unroll") for (int d_ = 0; d_ < 2; ++d_) _Pragma("unroll") for (int r = 0; r < 16; ++r) o[d_][r] *= wsf[crow(r, hi)]; } } while (0)
    f32x16 pA0, pA1, pB0, pB1;
    int sl_prev = 0, sl_cur = 0, sl_next = SLOTB;
#define ROT() do { sl_prev = sl_cur; sl_cur = sl_next; sl_next = (sl_next == (NSLOT - 1) * SLOTB) ? 0 : sl_next + SLOTB; } while (0)
    DMA_K(2, 2 * SLOTB);
    WAIT_BAR(3);
    qkt(pA0, pA1, Kbase, qr, negm, r32, hi); asm volatile("s_nop 15\n\ts_nop 7" : "+v"(pA0), "+v"(pA1));
    START(pA0, pA1);
    _Pragma("unroll") for (int r = 0; r < 16; ++r) pA1[r] = __builtin_amdgcn_exp2f(pA1[r]);
    WAIT_BAR(0);
    DMA_K(3, 0); DMA_V(1, SLOTB);
    ROT();
    kload8(kf, kp0 + sl_cur);
    WAIT_BAR(2);
    s16x4 vlo[8], vhi[8]; u32x4 pw0, pw1, pw2, pw3;
#define PKW(P, B) cvtpk_s(P[B], P[B + 1])
#define PAF(k) __builtin_bit_cast(bf16x8, pw##k)
#define VFR(i) (bf16x8){vlo[i][0], vlo[i][1], vlo[i][2], vlo[i][3], vhi[i][0], vhi[i][1], vhi[i][2], vhi[i][3]}
#define PIN(x) asm volatile("" : "+v"(x))
#define MX3(a, b, c) __builtin_fmaxf(__builtin_fmaxf((a), (b)), (c))
#define GAPA(MF, A0, A1, A2, A3, W0, W1, PW) do { MF; sacc += A0; sacc += A1; sacc += A2; sacc += A3; PIN(sacc); W0; W1; PIN(PW); SBAR(); } while (0)
#define EX(v) __builtin_amdgcn_exp2f(v)
#define GAPB(MF, X, B) do { MF; X[B] = EX(X[B]); X[B + 1] = EX(X[B + 1]); X[B + 2] = EX(X[B + 2]); X[B + 3] = EX(X[B + 3]); PIN(X); SBAR(); } while (0)
#define VRD(i) do { vlo[i] = vtr(vp_ + (((i) >> 2) * 4096 + ((i) & 3) * 1024)); vhi[i] = vtr(vp_ + (((i) >> 2) * 4096 + ((i) & 3) * 1024 + 512)); } while (0)
#define KRD(G, j) do { if (G) { kload2(kf, kp0 + sl_next, j); SBAR(); } } while (0)
#define STEP(C0, C1, P0, P1, t, GK, GV, GL) do { SBAR(); \
    const lds_cptr vp_ = vp0 + sl_prev; \
    VRD(0); SBAR(); float sacc = (P0[0] + P0[1]); \
    GAPA(C0 = __builtin_amdgcn_mfma_f32_32x32x16_bf16(kf[0], qr[0], negm, 0, 0, 0), P0[2], P0[3], P0[4], P0[5],     pw0[0] = PKW(P0, 0), pw0[1] = PKW(P0, 2), pw0); \
    VRD(4); SBAR(); GAPA(C1 = __builtin_amdgcn_mfma_f32_32x32x16_bf16(kf[1], qr[0], negm, 0, 0, 0), P0[6], P0[7], P0[8], P0[9],     pw0[2] = PKW(P0, 4), pw0[3] = PKW(P0, 6), pw0); \
    VRD(1); SBAR(); GAPA(C0 = __builtin_amdgcn_mfma_f32_32x32x16_bf16(kf[2], qr[1], C0, 0, 0, 0),   P0[10], P0[11], P0[12], P0[13], pw1[0] = PKW(P0, 8), pw1[1] = PKW(P0, 10), pw1); \
    VRD(5); SBAR(); GAPA(C1 = __builtin_amdgcn_mfma_f32_32x32x16_bf16(kf[3], qr[1], C1, 0, 0, 0),   P0[14], P0[15], P1[0], P1[1],   pw1[2] = PKW(P0, 12), pw1[3] = PKW(P0, 14), pw1); \
    VRD(2); SBAR(); GAPA(C0 = __builtin_amdgcn_mfma_f32_32x32x16_bf16(kf[4], qr[2], C0, 0, 0, 0),   P1[2], P1[3], P1[4], P1[5],     pw2[0] = PKW(P1, 0), pw2[1] = PKW(P1, 2), pw2); \
    VRD(6); SBAR(); GAPA(C1 = __builtin_amdgcn_mfma_f32_32x32x16_bf16(kf[5], qr[2], C1, 0, 0, 0),   P1[6], P1[7], P1[8], P1[9],     pw2[2] = PKW(P1, 4), pw2[3] = PKW(P1, 6), pw2); \
    VRD(3); SBAR(); GAPA(C0 = __builtin_amdgcn_mfma_f32_32x32x16_bf16(kf[6], qr[3], C0, 0, 0, 0),   P1[10], P1[11], P1[12], P1[13], pw3[0] = PKW(P1, 8), pw3[1] = PKW(P1, 10), pw3); \
    VRD(7); SBAR(); GAPA(C1 = __builtin_amdgcn_mfma_f32_32x32x16_bf16(kf[7], qr[3], C1, 0, 0, 0),   P1[14], P1[15], 0.f, 0.f,       pw3[2] = PKW(P1, 12), pw3[3] = PKW(P1, 14), pw3); \
    l_reg += sacc; \
    if (GK) { DMA_K((t) + 3, sl_cur); } if (GV) { DMA_V((t) + 1, sl_next); } \
    { float a = MX3(C0[0], C0[1], C1[0]), b = MX3(C0[2], C0[3], C1[1]); a = MX3(a, C1[2], C1[3]); \
      _Pragma("unroll") for (int r = 4; r < 16; r += 4) { a = MX3(a, C0[r], C0[r + 1]); b = MX3(b, C0[r + 2], C0[r + 3]); a = MX3(a, C1[r], C1[r + 1]); b = MX3(b, C1[r + 2], C1[r + 3]); } \
      float rm = __builtin_fmaxf(a, b); { auto rr = __builtin_amdgcn_permlane32_swap(__float_as_uint(rm), __float_as_uint(rm), false, false); rm = __builtin_fmaxf(__uint_as_float(rr[0]), __uint_as_float(rr[1])); } \
      resc = false; \
      if (__builtin_expect(__any(rm > (float)THRL), 0)) { const float dl = __builtin_fmaxf(rm, 0.f); mhat += dl; \
        _Pragma("unroll") for (int r = 0; r < 16; ++r) { C0[r] -= dl; C1[r] -= dl; } \
        _Pragma("unroll") for (int r = 0; r < 16; ++r) negm[r] = -mhat; asm volatile("" : "+v"(negm)); \
        const float f = __builtin_amdgcn_exp2f(-dl); l_reg *= f; if (hi == 0) wsf[r32] = f; resc = true; } } \
    SBAR(); \
    GAPB(o[0] = __builtin_amdgcn_mfma_f32_32x32x16_bf16(PAF(0), VFR(0), o[0], 0, 0, 0), C0, 0); \
    GAPB(o[1] = __builtin_amdgcn_mfma_f32_32x32x16_bf16(PAF(0), VFR(4), o[1], 0, 0, 0), C0, 4); \
    KRD(GL, 0); GAPB(o[0] = __builtin_amdgcn_mfma_f32_32x32x16_bf16(PAF(1), VFR(1), o[0], 0, 0, 0), C0, 8); \
    KRD(GL, 1); GAPB(o[1] = __builtin_amdgcn_mfma_f32_32x32x16_bf16(PAF(1), VFR(5), o[1], 0, 0, 0), C0, 12); \
    KRD(GL, 2); GAPB(o[0] = __builtin_amdgcn_mfma_f32_32x32x16_bf16(PAF(2), VFR(2), o[0], 0, 0, 0), C1, 0); \
    KRD(GL, 3); GAPB(o[1] = __builtin_amdgcn_mfma_f32_32x32x16_bf16(PAF(2), VFR(6), o[1], 0, 0, 0), C1, 4); \
    GAPB(o[0] = __builtin_amdgcn_mfma_f32_32x32x16_bf16(PAF(3), VFR(3), o[0], 0, 0, 0), C1, 8); \
    GAPB(o[1] = __builtin_amdgcn_mfma_f32_32x32x16_bf16(PAF(3), VFR(7), o[1], 0, 0, 0), C1, 12); \
    } while (0)
    int t = 1;
    for (; t + 5 < NT; t += 2) {
        STEP(pB0, pB1, pA0, pA1, t, true, true, true);     WAIT_BAR(2); RESC(); ROT();
        STEP(pA0, pA1, pB0, pB1, t + 1, true, true, true); WAIT_BAR(2); RESC(); ROT();
    }
#define ENDW(tt) do { if ((tt) + 3 < NT) { WAIT_BAR(2); } else if ((tt) + 2 < NT) { WAIT_BAR(1); } else { WAIT_BAR(0); } } while (0)
    for (; t + 1 < NT; t += 2) {
        STEP(pB0, pB1, pA0, pA1, t, (t + 3 < NT), (t + 1 < NT), (t + 1 < NT));         ENDW(t);     RESC(); ROT();
        STEP(pA0, pA1, pB0, pB1, t + 1, (t + 4 < NT), (t + 2 < NT), (t + 2 < NT));     ENDW(t + 1); RESC(); ROT();
    }
    STEP(pB0, pB1, pA0, pA1, NT - 1, false, false, false); RESC();
    { float sacc = pB0[0] + pB0[1]; _Pragma("unroll") for (int r = 2; r < 16; ++r) sacc += pB0[r]; _Pragma("unroll") for (int r = 0; r < 16; ++r) sacc += pB1[r]; l_reg += sacc;
      pw0 = (u32x4){PKW(pB0, 0), PKW(pB0, 2), PKW(pB0, 4), PKW(pB0, 6)}; pw1 = (u32x4){PKW(pB0, 8), PKW(pB0, 10), PKW(pB0, 12), PKW(pB0, 14)}; pw2 = (u32x4){PKW(pB1, 0), PKW(pB1, 2), PKW(pB1, 4), PKW(pB1, 6)}; pw3 = (u32x4){PKW(pB1, 8), PKW(pB1, 10), PKW(pB1, 12), PKW(pB1, 14)};
      SBAR(); pv(o, vb0 + sl_cur, PAF(0), PAF(1), PAF(2), PAF(3)); }
#undef PKW
#undef PAF
#undef VFR
#undef PIN
#undef MX3
#undef GAPA
#undef GAPB
#undef EX
#undef VRD
#undef KRD
#undef STEP
#undef ENDW
    { auto rr = __builtin_amdgcn_permlane32_swap(__float_as_uint(l_reg), __float_as_uint(l_reg), false, false); l_reg = __uint_as_float(rr[0]) + __uint_as_float(rr[1]); }
    if (hi == 0) wsf[32 + r32] = l_reg; asm volatile("s_waitcnt lgkmcnt(0)" ::: "memory");
    float rli[16];
#pragma unroll
    for (int r = 0; r < 16; ++r) rli[r] = __builtin_amdgcn_rcpf(wsf[32 + crow(r, hi)]);
    bf16_t* Ow = O + ((long)b * SEQ + q0 + wid * QBLK) * OP + h * D;
    { bf16_t* stg = (bf16_t*)(shm + LDS_OST) + wid * 2048;
#pragma unroll
      for (int r = 0; r < 16; ++r) { const int orow = crow(r, hi);
#pragma unroll
          for (int d0 = 0; d0 < 2; ++d0) stg[orow * 64 + d0 * 32 + r32] = (bf16_t)f2bf(o[d0][r] * rli[r]); }
      asm volatile("s_waitcnt lgkmcnt(0)" ::: "memory");
#pragma unroll
      for (int i = 0; i < 4; ++i) { const int row = i * 8 + (lane >> 3), ch = lane & 7; const u32x4 v = *(const u32x4*)(stg + row * 64 + ch * 8); *(u32x4*)(Ow + (long)row * OP + ch * 8) = v; } }
    asm volatile("s_waitcnt lgkmcnt(0)\n\ts_barrier" ::: "memory");
#undef DMA_K
#undef DMA_V
#undef START
#undef RESC
#undef ROT
}
#undef SBAR
#undef WAIT_BAR
}
__device__ __forceinline__ void ph_attn(const P& p, unsigned char* lds) {
    const int G = gridDim.x, bx = blockIdx.x;
    for (int i = 0;; ++i) {
        int b, h, qb;
        if (G == 256) { if (i >= 2) break; const int vcu = (bx & 7) * 32 + (bx >> 3), X = vcu >> 5, pi = X >> 1, u = (X & 1) * 64 + (vcu & 31) * 2 + i; b = pi >> 1; h = (pi & 1) * 4 + (u >> 5); qb = u & 31; }
        else { const int L = i * G + bx; if (L >= 512) break; b = L >> 8; h = (L >> 5) & 7; qb = L & 31; }
        attn_body::attn_unit<8>(b, h, qb, WSP(bf16_t, OFF_Q), WSP(bf16_t, OFF_K), WSP(bf16_t, OFF_V), WSP(bf16_t, OFF_AO), (char*)lds);
    }
}


#define LAS __attribute__((address_space(3)))
#define XB_TMO      128
#define XB_XCNT(j)  (256  + 64 * (j))
#define XB_XSUB(j)  (1280 + 64 * (j))
#define XB_XGEN(j)  (2304 + 64 * (j))
#define XB_TOP      3328
#define XB_TOPGEN   3392
#define XCD_BAR_WORDS 3456
#define XB_SPIN_CAP (1u << 18)
__device__ __forceinline__ unsigned xb_ld(unsigned* p)              { return __hip_atomic_load(p, __ATOMIC_RELAXED, __HIP_MEMORY_SCOPE_AGENT); }
__device__ __forceinline__ unsigned xb_add(unsigned* p, unsigned v) { return __hip_atomic_fetch_add(p, v, __ATOMIC_RELAXED, __HIP_MEMORY_SCOPE_AGENT); }
__device__ __forceinline__ unsigned xb_xcc_id() { return (unsigned)__builtin_amdgcn_s_getreg((3 << 11) | 20) & 0xFu; }
#define XB_SPIN(cond, bar) do { unsigned _sp = 0; while (cond) { __builtin_amdgcn_s_sleep(1); \
    if ((++_sp & 255u) == 0u) { if (xb_ld(&(bar)[XB_TMO])) break; if (_sp > XB_SPIN_CAP) { atomicAdd(&(bar)[XB_TMO], 1u); break; } } } } while (0)
struct XcdBarrier { unsigned* bar; unsigned x; volatile LAS unsigned* st; };
__device__ __forceinline__ XcdBarrier xcd_barrier_post(unsigned* bar, volatile LAS unsigned* st) {
    XcdBarrier b; b.bar = bar; b.x = xb_xcc_id(); b.st = st;
    if (threadIdx.x == 0) (void)xb_add(&bar[XB_XCNT(b.x)], 1u);
    return b;
}
__device__ __forceinline__ void xcd_barrier_complete(unsigned* bar, unsigned x, unsigned& nloc, unsigned& nx) {
    const unsigned G = gridDim.x * gridDim.y * gridDim.z;
    unsigned sum, cnt, mine, sp = 0u;
    for (;;) {
        sum = 0u; cnt = 0u; mine = 0u;
#pragma unroll
        for (unsigned j = 0; j < 16; ++j) { const unsigned c = xb_ld(&bar[XB_XCNT(j)]); sum += c; cnt += (c > 0u) ? 1u : 0u; mine = (j == x) ? c : mine; }
        if (sum == G) break;
        __builtin_amdgcn_s_sleep(1);
        if ((++sp & 255u) == 0u) { if (xb_ld(&bar[XB_TMO])) break; if (sp > XB_SPIN_CAP) { atomicAdd(&bar[XB_TMO], 1u); break; } }
    }
    nloc = mine > 0u ? mine : 1u; nx = cnt > 0u ? cnt : 1u;
}
__device__ __forceinline__ void xcd_barrier(const XcdBarrier& b) {
    asm volatile("s_waitcnt vmcnt(0)" ::: "memory");
    __syncthreads();
    if (threadIdx.x == 0) {
        unsigned* bar = b.bar;
        __builtin_amdgcn_s_waitcnt(0);
        unsigned nloc = b.st[0], nx = b.st[1];
        if (nloc == 0u) { xcd_barrier_complete(bar, b.x, nloc, nx); b.st[0] = nloc; b.st[1] = nx; }
        const unsigned old = xb_add(&bar[XB_XSUB(b.x)], 1u);
        const unsigned gen = old / nloc;
        if (old + 1u == (gen + 1u) * nloc) {
            __builtin_amdgcn_fence(__ATOMIC_RELEASE, "agent");
            asm volatile("s_waitcnt vmcnt(0)" ::: "memory");
            const unsigned og = xb_add(&bar[XB_TOP], 1u);
            const unsigned tg = og / nx;
            if (og + 1u == (tg + 1u) * nx) xb_add(&bar[XB_TOPGEN], 1u);
            else XB_SPIN(xb_ld(&bar[XB_TOPGEN]) == tg, bar);
            __builtin_amdgcn_fence(__ATOMIC_ACQUIRE, "agent");
            xb_add(&bar[XB_XGEN(b.x)], 1u);
            asm volatile("s_waitcnt vmcnt(0)" ::: "memory");
        } else {
            XB_SPIN(xb_ld(&bar[XB_XGEN(b.x)]) == gen, bar);
            __builtin_amdgcn_fence(__ATOMIC_ACQUIRE, "agent");
            asm volatile("s_waitcnt vmcnt(0)" ::: "memory");
        }
    }
    __syncthreads();
}
constexpr int CW_BAR = 4096;
constexpr int MISC_OFF = LDS_BYTES - 512;

enum { PH_P0 = 0, PH_P1, PH_INPROJ, PH_MIX, PH_HYT, PH_OUTPROJ, PH_ROUTER, PH_TOPK, PH_GATEUP, PH_DOWN, PH_COMBINE, PH_N };
__global__ void __launch_bounds__(NTHR, 2) k_phases(P p, int lo, int hi) {
    extern __shared__ __attribute__((aligned(16))) unsigned char lds[];
    volatile LAS unsigned* misc = (volatile LAS unsigned*)((LAS unsigned char*)lds + MISC_OFF);
    if (threadIdx.x < 16) misc[threadIdx.x] = 0u;
    __syncthreads();
    XcdBarrier bar; bar.bar = WSP(unsigned, OFF_CTL) + CW_BAR; bar.x = 0; bar.st = misc;
    if (hi - lo > 1) bar = xcd_barrier_post(WSP(unsigned, OFF_CTL) + CW_BAR, misc);
#define STAMP(i) do { if (PROBE_A >= 0 && threadIdx.x == 0) ((volatile LAS unsigned long long*)((LAS unsigned char*)lds + MISC_OFF + 64))[i] = __builtin_amdgcn_s_memrealtime(); } while (0)
    STAMP(0);
#define IN(k) (lo <= (k) && (k) < hi)
#define SEAM(k) do { if (IN(k) && IN((k) + 1)) xcd_barrier(bar); } while (0)
    if (IN(PH_P0)) DUP(PH_P0) { __syncthreads(); ph_mod(p, (float*)lds); __syncthreads(); ph_rope(p); ph_h2(p, (float*)lds); __syncthreads(); cvt_win(p, lds); cvt_range(p, lds, CV_NMOE, CV_IO, 0, 0, blockIdx.x, gridDim.x); }
    STAMP(1); SEAM(PH_P0); STAMP(2);
    if (IN(PH_P1)) DUP(PH_P1) { __syncthreads(); ph_xn(p); ph_ht(p, lds); }
    STAMP(3); SEAM(PH_P1); STAMP(4);
    if (IN(PH_INPROJ)) DUP(PH_INPROJ) { __syncthreads(); ph_inproj(p, lds);
    }
    STAMP(5); SEAM(PH_INPROJ); STAMP(6);
    if (IN(PH_MIX)) DUP(PH_MIX) { __syncthreads(); const int grp_ = blockIdx.x & 1;
        const int hb_ = blockIdx.x >> 1, nh_ = gridDim.x >> 1;
        if (grp_ == 0) { cvt_range(p, lds, 0, CV_IG, 2 * CV_IG, CV_ID / 2, hb_, nh_); zero_wgu_pad(p, hb_, nh_); __syncthreads(); }
        STAMP(7); ph_attn(p, lds); __syncthreads(); STAMP(8); ph_fft(p, lds); STAMP(9);
        if (grp_ == 1) { __syncthreads(); cvt_range(p, lds, CV_IG, CV_IG, 2 * CV_IG + CV_ID / 2, CV_ID / 2, hb_, nh_); zero_wd_pad(p, hb_, nh_); } }
    STAMP(10); SEAM(PH_MIX); STAMP(11);
    if (IN(PH_HYT)) DUP(PH_HYT) { __syncthreads(); ph_hyt(p, lds); }
    SEAM(PH_HYT); STAMP(12);
    if (IN(PH_OUTPROJ)) DUP(PH_OUTPROJ) { __syncthreads(); ph_outproj(p, lds); }
    SEAM(PH_OUTPROJ); STAMP(13);
    if (IN(PH_ROUTER)) DUP(PH_ROUTER) { __syncthreads(); ph_router(p, lds); }
    SEAM(PH_ROUTER); STAMP(14);
    if (IN(PH_TOPK)) DUP(PH_TOPK) { __syncthreads(); ph_topk(p, lds); }
    SEAM(PH_TOPK); STAMP(15);
    if (IN(PH_GATEUP)) DUP(PH_GATEUP) { __syncthreads(); ph_gateup(p, lds); }
    STAMP(16); SEAM(PH_GATEUP); STAMP(17);
    if (IN(PH_DOWN)) DUP(PH_DOWN) { __syncthreads(); ph_down(p, lds); }
    STAMP(18); SEAM(PH_DOWN); STAMP(19);
    if (IN(PH_COMBINE)) { ph_combine(p); }
    if (PROBE_A >= 0 && hi - lo > 1) {
        STAMP(20); xcd_barrier(bar);
        if ((int)blockIdx.x == PROBE_BLK && threadIdx.x == 0) { volatile LAS unsigned long long* st_ = (volatile LAS unsigned long long*)((LAS unsigned char*)lds + MISC_OFF + 64);
            const float us_ = (float)(long long)(st_[PROBE_B] - st_[PROBE_A]) * 0.01f; p.out[0] += us_ / PROBE_DIV; }
    }
    if (lo == PH_N) { ph_fft(p, lds); }
    if (lo == PH_N + 1) { ph_mod(p, (float*)lds); }
    if (lo == PH_N + 2) { ph_h2(p, (float*)lds); }

#undef IN
#undef SEAM
}

extern "C" void kernel_launch(void* const* d_in, const int* in_sizes, int n_in, void* d_out, int out_size, void* d_ws, size_t ws_size, hipStream_t stream) {
    static int init = 0;
    if (!init) {
        if (n_in != 25 || ws_size < WS_END) { fprintf(stderr, "kernel_launch: unexpected n_in %d / ws_size %zu\n", n_in, ws_size); init = -1; return; }
        if (hipFuncSetAttribute((const void*)k_phases, hipFuncAttributeMaxDynamicSharedMemorySize, LDS_BYTES) != hipSuccess) { fprintf(stderr, "hipFuncSetAttribute failed\n"); init = -1; return; }
        init = 1;
    }
    if (init < 0) return;
    P p{};
    const float** f = (const float**)&p.x;
    for (int i = 0; i < 25; ++i) f[i] = (const float*)d_in[i];
    p.out = (float*)d_out; p.ws = (unsigned char*)d_ws;
    for (int i = 0; i < 16; ++i) p.invf[i] = pow(10000.0, -(double)i / 16.0);
    (void)hipMemsetAsync((char*)d_ws + OFF_CTL + CW_BAR * 4, 0, XCD_BAR_WORDS * 4, stream);
    const int G = 256;
#define PHASES(lo, hi) hipLaunchKernelGGL(k_phases, dim3(G), dim3(NTHR), LDS_BYTES, stream, p, (lo), (hi))
#if ONE_LAUNCH
    PHASES(0, PH_N);
    if (EXTRA_PH >= 0) PHASES(EXTRA_PH, EXTRA_PH + 1);
#else
    for (int ph = 0; ph < PH_N; ++ph) PHASES(ph, ph + 1);
#endif
}
```

```cpp
#include <hip/hip_runtime.h>
#include <cstdio>
#include <cstdint>
#include <cmath>

#define ONE_LAUNCH 1
#ifndef PROBE_A
#define PROBE_A -1
#define PROBE_B -1
#define PROBE_BLK 0
#define PROBE_DIV 40.0f
#endif
#ifndef EXTRA_PH
#define EXTRA_PH -1
#endif
#ifndef DUP_MASK
#define DUP_MASK 0
#endif
#define DUP(k) for (int rep_ = 0; rep_ < 1 + ((DUP_MASK >> (k)) & 1); ++rep_)
constexpr int DM = 1024, NB = 2, SEQ = 8192, CTXL = 256, LK = SEQ + CTXL;
constexpr int MTOK = NB * SEQ, MCTX = NB * CTXL, MALL = MTOK + MCTX;
constexpr int INW = 2304, NEXP = 16, CAP = 1024, DEXP = 2752, DEXP_P = 2816;
constexpr int NFFT = 16384;
constexpr float EPS = 1e-6f;
constexpr float C2 = 0.125f * 1.4426950408889634f;

typedef unsigned short bf16_t;

constexpr size_t MiB = 1u << 20;
constexpr size_t OFF_CTL = 0, CTL_BYTES = 1 * MiB;
constexpr size_t OFF_MODV = 1 * MiB;
constexpr size_t OFF_ROPE = 1 * MiB + 128 * 1024;
constexpr size_t OFF_H2 = 2 * MiB;
constexpr size_t OFF_AFF = 4 * MiB;
constexpr size_t OFF_INV = 5 * MiB;
constexpr size_t OFF_IDX = 6 * MiB;
constexpr size_t OFF_GATE = 6 * MiB + 128 * 1024;
constexpr size_t OFF_WIN = 8 * MiB, OFF_WOUT = 13 * MiB, OFF_WGU = 16 * MiB, OFF_WD = 192 * MiB;
constexpr size_t OFF_XN2 = 280 * MiB;
constexpr size_t OFF_XN = 312 * MiB;
constexpr size_t OFF_Q = 345 * MiB;
constexpr size_t OFF_K = 361 * MiB;
constexpr size_t OFF_V = 366 * MiB;
constexpr size_t OFF_PT = 371 * MiB;
constexpr size_t OFF_HT = 467 * MiB;
constexpr size_t OFF_H = 312 * MiB;
constexpr size_t OFF_AO = 499 * MiB;
constexpr size_t OFF_HYT = 531 * MiB;
constexpr size_t OFF_Y = 499 * MiB;
constexpr size_t OFF_PROJ = 563 * MiB;
constexpr size_t OFF_KF = 613 * MiB;
constexpr size_t WS_END = 677 * MiB;

struct P {
    const float *x, *c, *ctx, *c_ctx, *w_mod, *b_mod, *n1g, *n2g, *w_in, *w_out, *qng, *kng, *conv_w, *conv_b;
    const float *fw1, *fb1, *fw2, *fb2, *fw3, *ffreq, *hbias, *w_router, *w_gate, *w_up, *w_down;
    float* out; unsigned char* ws;
    double invf[16];
};

#define WSP(T, off) ((T*)(p.ws + (off)))

__device__ __forceinline__ unsigned f2bf(float f) { unsigned u = __float_as_uint(f); return (u + 0x7fffu + ((u >> 16) & 1u)) >> 16; }
__device__ __forceinline__ float bf2f(unsigned h) { return __uint_as_float(h << 16); }
__device__ __forceinline__ unsigned pk2(float lo, float hi) { return f2bf(lo) | (f2bf(hi) << 16); }
__device__ __forceinline__ unsigned hw_pk2(float lo, float hi) { typedef float f2_t __attribute__((ext_vector_type(2))); typedef __bf16 b2_t __attribute__((ext_vector_type(2))); f2_t v = {lo, hi}; b2_t b = __builtin_convertvector(v, b2_t); return __builtin_bit_cast(unsigned, b); }
__device__ __forceinline__ float hw_sin_rev(float r) { return __builtin_amdgcn_sinf(r); }
__device__ __forceinline__ float hw_cos_rev(float r) { return __builtin_amdgcn_cosf(r); }
__device__ __forceinline__ float wave_sum(float v) {
#pragma unroll
    for (int o = 1; o < 64; o <<= 1) v += __shfl_xor(v, o);
    return v;
}

constexpr int NTHR = 512, NWAVE = 8;
constexpr int LDS_BYTES = 147456;

__device__ __forceinline__ void ph_mod(const P& p, float* lf) {
    const int tid = threadIdx.x, lane = tid & 63, wave = tid >> 6;
    float* sil = lf; float* red = lf + 3072;
    if ((int)blockIdx.x < 96) {
        for (int i = tid; i < 3072; i += NTHR) { const int r = i >> 10, k = i & 1023; const float v = r < 2 ? p.c[r * 1024 + k] : p.c_ctx[k]; sil[i] = v / (1.0f + expf(-v)); }
        __syncthreads();
        float* modv = WSP(float, OFF_MODV);
        for (int item = blockIdx.x; item < 96; item += gridDim.x) {
            const int col = item * 64 + lane, kb = wave * 128;
            float a0 = 0.f, a1 = 0.f, a2 = 0.f;
#pragma unroll 32
            for (int kk = 0; kk < 128; ++kk) { const float w = p.w_mod[(size_t)(kb + kk) * 6144 + col]; a0 += sil[kb + kk] * w; a1 += sil[1024 + kb + kk] * w; a2 += sil[2048 + kb + kk] * w; }
            red[(wave * 3 + 0) * 64 + lane] = a0; red[(wave * 3 + 1) * 64 + lane] = a1; red[(wave * 3 + 2) * 64 + lane] = a2;
            __syncthreads();
            if (wave < 3) { float s = p.b_mod[col];
#pragma unroll
                for (int w2 = 0; w2 < 8; ++w2) s += red[(w2 * 3 + wave) * 64 + lane];
                modv[wave * 6144 + col] = s; }
            __syncthreads();
        }
    }
}
__device__ __forceinline__ void ph_rope(const P& p) {
    float* rope = WSP(float, OFF_ROPE);
    for (int i = blockIdx.x * NTHR + threadIdx.x; i < 2048; i += gridDim.x * NTHR) {
        const int pos = i >> 4, f = i & 15;
        double r = (double)pos * p.invf[f] * 0.15915494309189535; r -= floor(r);
        rope[2 * i] = hw_cos_rev((float)r); rope[2 * i + 1] = hw_sin_rev((float)r);
    }
}
__device__ __forceinline__ void ph_h2(const P& p, float* lf) {
    const int tid = threadIdx.x, lane = tid & 63, wave = tid >> 6;
    float* zf = lf + wave * 40; float* h1 = lf + 8 * 40 + wave * 64;
    float* h2 = WSP(float, OFF_H2);
    const float fr = p.ffreq[lane];
    for (int item = blockIdx.x; item < 1024; item += gridDim.x) {
        const int t = item * 8 + wave;
        if (lane < 33) {
            float z;
            if (lane == 0) z = (float)t / 8191.0f;
            else { const int k = (lane - 1) & 15; const double fk = 1e-4 + (double)k * ((15.0 - 1e-4) / 15.0); double r = (double)t * fk / 8192.0; r -= floor(r);
                   z = lane <= 16 ? hw_cos_rev((float)r) : -hw_sin_rev((float)r); }
            zf[lane] = z;
        }
        __syncthreads();
        float a = p.fb1[lane];
#pragma unroll
        for (int i = 0; i < 33; ++i) a += zf[i] * p.fw1[i * 64 + lane];
        h1[lane] = hw_sin_rev(fr * a * 0.15915494309189535f);
        __syncthreads();
        float b = p.fb2[lane];
#pragma unroll 16
        for (int i = 0; i < 64; ++i) b += h1[i] * p.fw2[i * 64 + lane];
        h2[(size_t)t * 64 + lane] = hw_sin_rev(fr * b * 0.15915494309189535f);
        __syncthreads();
    }
}

__device__ __forceinline__ void ph_xn(const P& p) {
    const int tid = threadIdx.x, lane = tid & 63, wave = tid >> 6;
    const float* modv = WSP(float, OFF_MODV); bf16_t* xn = WSP(bf16_t, OFF_XN);
    for (int row0 = (blockIdx.x * NWAVE + wave) * 4; row0 < MALL; row0 += gridDim.x * NWAVE * 4) {
        const float* src = row0 < MTOK ? p.x + (size_t)row0 * DM : p.ctx + (size_t)(row0 - MTOK) * DM;
        const float* mv = modv + (row0 < MTOK ? (row0 >> 13) : 2) * 6144;
        float4 v[4][4];
#pragma unroll
        for (int r = 0; r < 4; ++r)
#pragma unroll
            for (int j = 0; j < 4; ++j) v[r][j] = *(const float4*)(src + (size_t)r * DM + 4 * lane + 256 * j);
        float4 g[4], sh[4], sc[4];
#pragma unroll
        for (int j = 0; j < 4; ++j) { const int c0 = 4 * lane + 256 * j; g[j] = *(const float4*)(p.n1g + c0); sh[j] = *(const float4*)(mv + c0); sc[j] = *(const float4*)(mv + 1024 + c0);
            g[j].x *= 1.f + sc[j].x; g[j].y *= 1.f + sc[j].y; g[j].z *= 1.f + sc[j].z; g[j].w *= 1.f + sc[j].w; }
#pragma unroll
        for (int r = 0; r < 4; ++r) {
            float ss = 0.f;
#pragma unroll
            for (int j = 0; j < 4; ++j) ss += v[r][j].x * v[r][j].x + v[r][j].y * v[r][j].y + v[r][j].z * v[r][j].z + v[r][j].w * v[r][j].w;
            const float rstd = rsqrtf(wave_sum(ss) * (1.0f / DM) + EPS);
#pragma unroll
            for (int j = 0; j < 4; ++j) {
                const int c0 = 4 * lane + 256 * j;
                uint2 o; o.x = hw_pk2(v[r][j].x * rstd * g[j].x + sh[j].x, v[r][j].y * rstd * g[j].y + sh[j].y); o.y = hw_pk2(v[r][j].z * rstd * g[j].z + sh[j].z, v[r][j].w * rstd * g[j].w + sh[j].w);
                *(uint2*)(xn + (size_t)(row0 + r) * DM + c0) = o;
            }
        }
    }
}
__device__ __forceinline__ void ph_ht(const P& p, unsigned char* lds) {
    typedef float f32x16_t __attribute__((ext_vector_type(16)));
    const int tid = threadIdx.x, lane = tid & 63, wave = tid >> 6, l31 = lane & 31, kh = lane >> 5;
    const float* h2 = WSP(float, OFF_H2); float* ht = WSP(float, OFF_HT);
    float* hs = (float*)lds + wave * (32 * 65);
    const float MIN_D = -3.0701134573253945f, MAX_D = -15.350567286626973f;
    for (int item = blockIdx.x * NWAVE + wave; item < 2048; item += gridDim.x * NWAVE) {
        const int tb = item >> 3, cg = item & 7, t0 = tb * 32;
        {
            float4 v[8];
#pragma unroll
            for (int i = 0; i < 8; ++i) v[i] = *(const float4*)(h2 + (size_t)t0 * 64 + (i * 64 + lane) * 4);
#pragma unroll
            for (int i = 0; i < 8; ++i) { const int id = i * 64 + lane, row = id >> 4, c4 = (id & 15) * 4; float* d = hs + row * 65 + c4; d[0] = v[i].x; d[1] = v[i].y; d[2] = v[i].z; d[3] = v[i].w; }
        }
        asm volatile("s_waitcnt lgkmcnt(0)" ::: "memory");
        float bv[32];
#pragma unroll
        for (int s2 = 0; s2 < 32; ++s2) bv[s2] = hs[l31 * 65 + 2 * s2 + kh];
        const float tn = (float)(t0 + l31) / 8191.0f;
#pragma unroll 1
        for (int ct = 0; ct < 4; ++ct) {
            const int col0 = cg * 128 + ct * 32;
            float av[32];
#pragma unroll
            for (int s2 = 0; s2 < 32; ++s2) av[s2] = p.fw3[(2 * s2 + kh) * 1024 + col0 + l31];
            f32x16_t acc = {0.f, 0.f, 0.f, 0.f, 0.f, 0.f, 0.f, 0.f, 0.f, 0.f, 0.f, 0.f, 0.f, 0.f, 0.f, 0.f};
#pragma unroll
            for (int s2 = 0; s2 < 32; ++s2) acc = __builtin_amdgcn_mfma_f32_32x32x2f32(av[s2], bv[s2], acc, 0, 0, 0);
#pragma unroll
            for (int r = 0; r < 16; ++r) {
                const int col = col0 + (r & 3) + 8 * (r >> 2) + 4 * kh;
                const float dl = MIN_D + (MAX_D - MIN_D) * (float)(col & 511) / 511.0f;
                ht[(size_t)col * 8192 + t0 + l31] = acc[r] * expf(-tn * fabsf(dl));
            }
        }
        asm volatile("s_waitcnt lgkmcnt(0)" ::: "memory");
    }
}

struct c2 { float x, y; };
__device__ __forceinline__ c2 cmul(c2 a, c2 b) { return c2{a.x * b.x - a.y * b.y, a.x * b.y + a.y * b.x}; }
#define FFT_DEV __device__ __forceinline__
#define FFT_LAUNDER(x) asm volatile("" : "+v"(x))
FFT_DEV int fsw(int i) { return i ^ (((i >> 4) & 7) << 1); }
FFT_DEV c2 cadd(c2 a, c2 b) { return c2{a.x + b.x, a.y + b.y}; }
FFT_DEV c2 csub(c2 a, c2 b) { return c2{a.x - b.x, a.y - b.y}; }
FFT_DEV void dft4(c2& a, c2& b, c2& c, c2& d) {
    const c2 apc = cadd(a, c), amc = csub(a, c), bpd = cadd(b, d), bmd = csub(b, d);
    const c2 jb{-bmd.y, bmd.x};
    a = cadd(apc, bpd); b = csub(amc, jb); c = csub(apc, bpd); d = cadd(amc, jb);
}
FFT_DEV void dft16(c2 (&x)[16]) {
#pragma unroll
    for (int m0 = 0; m0 < 4; ++m0) dft4(x[m0], x[m0 + 4], x[m0 + 8], x[m0 + 12]);
    const float C1 = 0.92387953251128674f, S1 = 0.38268343236508977f, R = 0.70710678118654752f;
    x[5]  = cmul(x[5],  c2{C1, -S1});
    x[6]  = c2{(x[6].x + x[6].y) * R, (x[6].y - x[6].x) * R};
    x[7]  = cmul(x[7],  c2{S1, -C1});
    x[9]  = c2{(x[9].x + x[9].y) * R, (x[9].y - x[9].x) * R};
    x[10] = c2{x[10].y, -x[10].x};
    x[11] = c2{(x[11].y - x[11].x) * R, -(x[11].x + x[11].y) * R};
    x[13] = cmul(x[13], c2{S1, -C1});
    x[14] = c2{(x[14].y - x[14].x) * R, -(x[14].x + x[14].y) * R};
    x[15] = cmul(x[15], c2{-C1, S1});
#pragma unroll
    for (int k1 = 0; k1 < 4; ++k1) dft4(x[4 * k1], x[4 * k1 + 1], x[4 * k1 + 2], x[4 * k1 + 3]);
#pragma unroll
    for (int a = 0; a < 4; ++a)
#pragma unroll
        for (int b = a + 1; b < 4; ++b) { const c2 t = x[a + 4 * b]; x[a + 4 * b] = x[b + 4 * a]; x[b + 4 * a] = t; }
}
template <int LOGS, bool ZHI> FFT_DEV void r16_compute(const c2* X, c2 (&y)[2][16], int tid) {
#pragma unroll
    for (int i = 0; i < 2; ++i) {
        const int j = tid + 512 * i, pj = fsw(j);
        c2 x[16];
#pragma unroll
        for (int m = 0; m < 16; ++m) x[m] = (ZHI && m >= 8) ? c2{0.f, 0.f} : X[pj + 1024 * m];
        dft16(x);
        const int ps = (j >> LOGS) << LOGS;
        float r = (float)ps * (1.0f / 16384.0f);
        FFT_LAUNDER(r);
        const c2 w1{hw_cos_rev(r), -hw_sin_rev(r)}, w2{hw_cos_rev(2.f * r), -hw_sin_rev(2.f * r)}, w4{hw_cos_rev(4.f * r), -hw_sin_rev(4.f * r)}, w8{hw_cos_rev(8.f * r), -hw_sin_rev(8.f * r)};
        const c2 w3 = cmul(w1, w2), w5 = cmul(w1, w4), w6 = cmul(w2, w4), w7 = cmul(w3, w4);
        y[i][0] = x[0]; y[i][1] = cmul(x[1], w1); y[i][2] = cmul(x[2], w2); y[i][3] = cmul(x[3], w3);
        y[i][4] = cmul(x[4], w4); y[i][5] = cmul(x[5], w5); y[i][6] = cmul(x[6], w6); y[i][7] = cmul(x[7], w7);
        y[i][8] = cmul(x[8], w8); y[i][9] = cmul(x[9], cmul(w1, w8)); y[i][10] = cmul(x[10], cmul(w2, w8)); y[i][11] = cmul(x[11], cmul(w3, w8));
        y[i][12] = cmul(x[12], cmul(w4, w8)); y[i][13] = cmul(x[13], cmul(w5, w8)); y[i][14] = cmul(x[14], cmul(w6, w8)); y[i][15] = cmul(x[15], cmul(w7, w8));
    }
}
template <int LOGS> FFT_DEV void r16_write(c2* X, const c2 (&y)[2][16], int tid) {
#pragma unroll
    for (int i = 0; i < 2; ++i) {
        const int j = tid + 512 * i;
        if (LOGS == 0) {
#pragma unroll
            for (int c = 0; c < 8; ++c) { float4* d = (float4*)(X + 16 * j + 2 * (c ^ (j & 7))); *d = float4{y[i][2 * c].x, y[i][2 * c].y, y[i][2 * c + 1].x, y[i][2 * c + 1].y}; }
        } else if (LOGS == 4) {
            const int q = j & 15, b = 256 * (j >> 4);
#pragma unroll
            for (int k = 0; k < 16; ++k) X[b + 16 * k + (q ^ ((k & 7) << 1))] = y[i][k];
        } else {
            const int b = fsw(j & 255) + 4096 * (j >> 8);
#pragma unroll
            for (int k = 0; k < 16; ++k) X[b + 256 * k] = y[i][k];
        }
    }
}
FFT_DEV void r4_last(const c2* X, c2 (&y4)[8][4], int tid) {
#pragma unroll
    for (int i = 0; i < 8; ++i) {
        const int pj = fsw(tid + 512 * i);
        c2 a = X[pj], b = X[pj + 4096], c = X[pj + 8192], d = X[pj + 12288];
        dft4(a, b, c, d);
        y4[i][0] = a; y4[i][1] = b; y4[i][2] = c; y4[i][3] = d;
    }
}

#define FFT_PASS16(L, Z) do { asm volatile("" : "+v"(tid)); r16_compute<L, Z>(X, y, tid); __syncthreads(); asm volatile("" : "+v"(tid)); r16_write<L>(X, y, tid); __syncthreads(); } while (0)
template <bool ZHI> __device__ __forceinline__ void fft16k(c2* X, c2 (&y4)[8][4], int tid) {
    { c2 y[2][16]; FFT_PASS16(0, ZHI); FFT_PASS16(4, false); FFT_PASS16(8, false); }
    asm volatile("" : "+v"(tid));
    r4_last(X, y4, tid);
}
__device__ __forceinline__ void conv3x16(const float* base, int t0, float w0, float w1, float w2, float cb, float (&o)[16]) {
    float in[18];
    in[0] = t0 > 0 ? base[t0 - 1] : 0.f; in[17] = t0 + 16 < SEQ ? base[t0 + 16] : 0.f;
#pragma unroll
    for (int q = 0; q < 4; ++q) { const float4 c = *(const float4*)(base + t0 + 4 * q); in[1 + 4 * q] = c.x; in[2 + 4 * q] = c.y; in[3 + 4 * q] = c.z; in[4 + 4 * q] = c.w; }
#pragma unroll
    for (int e = 0; e < 16; ++e) o[e] = w0 * in[e] + w1 * in[e + 1] + w2 * in[e + 2] + cb;
}
__device__ __forceinline__ unsigned pack_h2(float a, float b) { typedef _Float16 h2_t __attribute__((ext_vector_type(2))); typedef float f2_t __attribute__((ext_vector_type(2))); f2_t v = {a, b}; h2_t h = __builtin_convertvector(v, h2_t); return __builtin_bit_cast(unsigned, h); }
__device__ __forceinline__ c2 unpack_h2(unsigned u) { typedef _Float16 h2_t __attribute__((ext_vector_type(2))); const h2_t h = __builtin_bit_cast(h2_t, u); return c2{(float)h[0], (float)h[1]}; }
#define LAUNDER(v) asm volatile("" : "+v"(v))
__device__ __forceinline__ void ph_fft(const P& p, unsigned char* lds) {
    int tid = threadIdx.x; const int lane = tid & 63, wave = tid >> 6;
    c2* X = (c2*)lds; float* red = (float*)(lds + 131072);
    const float* ht = WSP(float, OFF_HT); const float* pt = WSP(float, OFF_PT); bf16_t* hyt = WSP(bf16_t, OFF_HYT);
    unsigned* kfg = WSP(unsigned, OFF_KF) + (size_t)blockIdx.x * NFFT;
    for (int ch = blockIdx.x; ch < 512; ch += gridDim.x) {
        LAUNDER(tid);
        const float* hf = ht + (size_t)ch * 8192; const float* hb = ht + (size_t)(512 + ch) * 8192;
        float asum = 0.f;
        { float kv[32];
#pragma unroll
          for (int m = 0; m < 16; ++m) kv[m] = hf[tid + 512 * m];
#pragma unroll
          for (int m = 16; m < 32; ++m) { const int n = tid + 512 * m; kv[m] = (n == 8192) ? 0.f : hb[16384 - (n == 8192 ? 8193 : n)]; }
#pragma unroll
          for (int m = 0; m < 32; ++m) { asum += fabsf(kv[m]); X[fsw(tid + 512 * m)] = c2{kv[m], 0.f}; } }
        asum = wave_sum(asum); if (lane == 0) red[wave] = asum;
        __syncthreads();
        float tot = 0.f;
#pragma unroll
        for (int w = 0; w < 8; ++w) tot += red[w];
        const float rtot = 1.0f / tot;
        c2 y[8][4];
        LAUNDER(tid);
        fft16k<false>(X, y, tid);
        LAUNDER(tid);
#pragma unroll
        for (int i = 0; i < 8; ++i)
#pragma unroll
            for (int k = 0; k < 4; ++k) kfg[tid + i * 2048 + k * 512] = pack_h2(y[i][k].x * rtot, y[i][k].y * rtot);
        __syncthreads();
        const float wa0 = p.conv_w[ch], wa1 = p.conv_w[1536 + ch], wa2 = p.conv_w[3072 + ch], ba = p.conv_b[ch];
        const float wx0 = p.conv_w[512 + ch], wx1 = p.conv_w[1536 + 512 + ch], wx2 = p.conv_w[3072 + 512 + ch], bx = p.conv_b[512 + ch];
        const float wv0 = p.conv_w[1024 + ch], wv1 = p.conv_w[1536 + 1024 + ch], wv2 = p.conv_w[3072 + 1024 + ch], bv = p.conv_b[1024 + ch];
        LAUNDER(tid);
        const float* p1 = pt + (size_t)ch * MTOK; const float* px = pt + (size_t)(512 + ch) * MTOK; const float* pv = pt + (size_t)(1024 + ch) * MTOK;
        unsigned us[16], xs[16];
        { const int t0 = 16 * tid; float a[16], u0[16], u1[16];
          conv3x16(pv, t0, wv0, wv1, wv2, bv, u0); conv3x16(p1, t0, wa0, wa1, wa2, ba, a);
#pragma unroll
          for (int e = 0; e < 16; ++e) u0[e] *= a[e];
          conv3x16(pv + SEQ, t0, wv0, wv1, wv2, bv, u1); conv3x16(p1 + SEQ, t0, wa0, wa1, wa2, ba, a);
#pragma unroll
          for (int e = 0; e < 16; ++e) { u1[e] *= a[e]; us[e] = hw_pk2(u0[e], u1[e]); }
#pragma unroll
          for (int c = 0; c < 8; ++c) *(float4*)(X + 16 * tid + 2 * (c ^ (tid & 7))) = float4{u0[2 * c], u1[2 * c], u0[2 * c + 1], u1[2 * c + 1]};
          conv3x16(px, t0, wx0, wx1, wx2, bx, u0); conv3x16(px + SEQ, t0, wx0, wx1, wx2, bx, u1);
#pragma unroll
          for (int e = 0; e < 16; ++e) xs[e] = hw_pk2(u0[e], u1[e]); }
        __syncthreads();
        LAUNDER(tid);
        fft16k<true>(X, y, tid);
        __syncthreads();
        LAUNDER(tid);
        { unsigned kq[8][4];
#pragma unroll
          for (int i = 0; i < 8; ++i)
#pragma unroll
              for (int k = 0; k < 4; ++k) kq[i][k] = kfg[tid + i * 2048 + k * 512];
#pragma unroll
          for (int i = 0; i < 8; ++i)
#pragma unroll
              for (int k = 0; k < 4; ++k) { const c2 w = cmul(y[i][k], unpack_h2(kq[i][k])); X[fsw(tid + 512 * i + 4096 * k)] = c2{w.x, -w.y}; } }
        __syncthreads();
        LAUNDER(tid);
        fft16k<false>(X, y, tid);
        __syncthreads();
        LAUNDER(tid);
#pragma unroll
        for (int i = 0; i < 8; ++i)
#pragma unroll
            for (int k = 0; k < 2; ++k) X[fsw(tid + 512 * i + 4096 * k)] = y[i][k];
        __syncthreads();
        LAUNDER(tid);
        const float bias = p.hbias[ch], scale = 1.0f / 16384.0f;
        { unsigned o0[8], o1[8];
#pragma unroll
          for (int c = 0; c < 8; ++c) { const float4 r = *(const float4*)(X + 16 * tid + 2 * (c ^ (tid & 7)));
              const float ua0 = bf2f(us[2 * c] & 0xFFFFu), ub0 = bf2f(us[2 * c] >> 16), ua1 = bf2f(us[2 * c + 1] & 0xFFFFu), ub1 = bf2f(us[2 * c + 1] >> 16);
              const float xa0 = bf2f(xs[2 * c] & 0xFFFFu), xb0 = bf2f(xs[2 * c] >> 16), xa1 = bf2f(xs[2 * c + 1] & 0xFFFFu), xb1 = bf2f(xs[2 * c + 1] >> 16);
              o0[c] = hw_pk2((r.x * scale + ua0 * bias) * xa0, (r.z * scale + ua1 * bias) * xa1);
              o1[c] = hw_pk2((-r.y * scale + ub0 * bias) * xb0, (-r.w * scale + ub1 * bias) * xb1); }
          uint4* d0 = (uint4*)(hyt + (size_t)ch * MTOK + 16 * tid); uint4* d1 = (uint4*)(hyt + (size_t)ch * MTOK + SEQ + 16 * tid);
          d0[0] = uint4{o0[0], o0[1], o0[2], o0[3]}; d0[1] = uint4{o0[4], o0[5], o0[6], o0[7]};
          d1[0] = uint4{o1[0], o1[1], o1[2], o1[3]}; d1[1] = uint4{o1[4], o1[5], o1[6], o1[7]}; }
        __syncthreads();
    }
}

__device__ __forceinline__ void ph_hyt(const P& p, unsigned char* lds) {
    const int tid = threadIdx.x;
    bf16_t* tile = (bf16_t*)lds;
    const bf16_t* hyt = WSP(bf16_t, OFF_HYT); bf16_t* ao = WSP(bf16_t, OFF_AO);
    for (int item = blockIdx.x; item < 2048; item += gridDim.x) {
        const int cg = item & 7, mg = item >> 3, c0 = cg * 64, m0 = mg * 64;
        { const int c = tid >> 3, ch = tid & 7; const uint4 v = *(const uint4*)(hyt + (size_t)(c0 + c) * MTOK + m0 + ch * 8); *(uint4*)(tile + c * 72 + ch * 8) = v; }
        __syncthreads();
        { const int m = tid >> 3, ch = tid & 7; unsigned w[4];
#pragma unroll
          for (int k = 0; k < 4; ++k) { const unsigned lo = tile[(ch * 8 + 2 * k) * 72 + m], hi = tile[(ch * 8 + 2 * k + 1) * 72 + m]; w[k] = lo | (hi << 16); }
          uint4 o; o.x = w[0]; o.y = w[1]; o.z = w[2]; o.w = w[3];
          *(uint4*)(ao + (size_t)(m0 + m) * DM + 512 + c0 + ch * 8) = o; }
        __syncthreads();
    }
}

__device__ __forceinline__ void ph_router(const P& p, unsigned char* lds) {
    typedef float f32x4_t __attribute__((ext_vector_type(4)));
    const int tid = threadIdx.x, lane = tid & 63, wave = tid >> 6, jr = lane & 15, kk = lane >> 4;
    float* wl = (float*)lds;
    float* xs = (float*)lds + 16384 + wave * (8 * 260);
    for (int i = tid; i < 4096; i += NTHR) ((float4*)wl)[i] = ((const float4*)p.w_router)[i];
    __syncthreads();
    const float* modv = WSP(float, OFF_MODV); bf16_t* xn2 = WSP(bf16_t, OFF_XN2); float* aff = WSP(float, OFF_AFF);
    for (int item = blockIdx.x * NWAVE + wave; item < MTOK / 8; item += gridDim.x * NWAVE) {
        const int row0 = item * 8, b = row0 >> 13, t0 = row0 & 8191;
        const float* mv = modv + b * 6144;
        float4 v[8][4];
#pragma unroll
        for (int r = 0; r < 8; ++r)
#pragma unroll
            for (int j = 0; j < 4; ++j) v[r][j] = *(const float4*)(p.out + (size_t)(row0 + r) * DM + 4 * lane + 256 * j);
        float rstd[8];
#pragma unroll
        for (int r = 0; r < 8; ++r) { float ss = 0.f;
#pragma unroll
            for (int j = 0; j < 4; ++j) ss += v[r][j].x * v[r][j].x + v[r][j].y * v[r][j].y + v[r][j].z * v[r][j].z + v[r][j].w * v[r][j].w;
            rstd[r] = rsqrtf(wave_sum(ss) * (1.0f / DM) + EPS); }
        f32x4_t acc = {0.f, 0.f, 0.f, 0.f};
#pragma unroll
        for (int j = 0; j < 4; ++j) {
            const int c0 = 4 * lane + 256 * j;
            float4 g = *(const float4*)(p.n2g + c0); const float4 sh = *(const float4*)(mv + 3072 + c0), sc = *(const float4*)(mv + 4096 + c0);
            g.x *= 1.f + sc.x; g.y *= 1.f + sc.y; g.z *= 1.f + sc.z; g.w *= 1.f + sc.w;
#pragma unroll
            for (int r = 0; r < 8; ++r) {
                float4 y; y.x = v[r][j].x * rstd[r] * g.x + sh.x; y.y = v[r][j].y * rstd[r] * g.y + sh.y; y.z = v[r][j].z * rstd[r] * g.z + sh.z; y.w = v[r][j].w * rstd[r] * g.w + sh.w;
                uint2 o; o.x = hw_pk2(y.x, y.y); o.y = hw_pk2(y.z, y.w);
                *(uint2*)(xn2 + (size_t)(row0 + r) * DM + c0) = o;
                *(float4*)(xs + r * 260 + 4 * lane) = y;
            }
            asm volatile("s_waitcnt lgkmcnt(0)" ::: "memory");
            const float* wp = wl + (256 * j + kk) * 16 + jr;
            const float* xp = xs + (jr & 7) * 260 + kk;
#pragma unroll 16
            for (int s2 = 0; s2 < 64; ++s2) acc = __builtin_amdgcn_mfma_f32_16x16x4f32(wp[s2 * 64], xp[s2 * 4], acc, 0, 0, 0);
            asm volatile("s_waitcnt lgkmcnt(0)" ::: "memory");
        }
        float mx = fmaxf(fmaxf(acc[0], acc[1]), fmaxf(acc[2], acc[3]));
        mx = fmaxf(mx, __shfl_xor(mx, 16)); mx = fmaxf(mx, __shfl_xor(mx, 32));
        const float e0 = expf(acc[0] - mx), e1 = expf(acc[1] - mx), e2 = expf(acc[2] - mx), e3 = expf(acc[3] - mx);
        float sm = (e0 + e1) + (e2 + e3);
        sm += __shfl_xor(sm, 16); sm += __shfl_xor(sm, 32);
        const float inv = 1.0f / sm;
        if (jr < 8) { float* ap = aff + (size_t)(b * 16 + 4 * kk) * 8192 + t0 + jr;
            ap[0] = e0 * inv; ap[8192] = e1 * inv; ap[2 * 8192] = e2 * inv; ap[3 * 8192] = e3 * inv; }
    }
}

__device__ __forceinline__ void ph_topk(const P& p, unsigned char* lds) {
    const int tid = threadIdx.x, lane = tid & 63, wave = tid >> 6;
    unsigned* hist = (unsigned*)lds; unsigned* wtot = hist + 256; unsigned* sel = hist + 272;
    const float* aff = WSP(float, OFF_AFF); int* idx = WSP(int, OFF_IDX); float* gate = WSP(float, OFF_GATE); int* inv = WSP(int, OFF_INV);
    for (int prob = blockIdx.x; prob < 32; prob += gridDim.x) {
        const float* a = aff + (size_t)prob * 8192 + tid * 16;
        float v[16]; unsigned key[16];
#pragma unroll
        for (int j = 0; j < 4; ++j) { const float4 q = *(const float4*)(a + 4 * j); v[4 * j] = q.x; v[4 * j + 1] = q.y; v[4 * j + 2] = q.z; v[4 * j + 3] = q.w; }
#pragma unroll
        for (int i = 0; i < 16; ++i) key[i] = __float_as_uint(v[i]);
        unsigned prefix = 0u, kk = CAP;
#pragma unroll
        for (int pass = 0; pass < 4; ++pass) {
            const int shift = 24 - 8 * pass;
            const unsigned mhi = pass == 0 ? 0u : (0xFFFFFFFFu << (shift + 8));
            if (tid < 256) hist[tid] = 0u;
            __syncthreads();
#pragma unroll
            for (int i = 0; i < 16; ++i) if ((key[i] & mhi) == prefix) atomicAdd(&hist[(key[i] >> shift) & 255u], 1u);
            __syncthreads();
            unsigned h = 0u, s = 0u;
            if (tid < 256) {
                h = hist[tid]; s = h;
#pragma unroll
                for (int o = 1; o < 64; o <<= 1) { const unsigned n = __shfl_down(s, o); if (lane + o < 64) s += n; }
                if (lane == 0) wtot[wave] = s;
            }
            __syncthreads();
            if (tid < 256) {
                for (int w2 = wave + 1; w2 < 4; ++w2) s += wtot[w2];
                const unsigned sex = s - h;
                if (s >= kk && sex < kk) { sel[0] = (unsigned)tid; sel[1] = kk - sex; }
            }
            __syncthreads();
            prefix |= sel[0] << shift; kk = sel[1];
            __syncthreads();
        }
        const unsigned thr = prefix, krem = kk;
        unsigned cnt = 0u;
#pragma unroll
        for (int i = 0; i < 16; ++i) cnt += (key[i] > thr ? 1u : 0u) + (key[i] == thr ? 0x10000u : 0u);
        unsigned inc = cnt;
#pragma unroll
        for (int o = 1; o < 64; o <<= 1) { const unsigned n = __shfl_up(inc, o); if (lane >= o) inc += n; }
        if (lane == 63) wtot[wave] = inc;
        __syncthreads();
        unsigned before = inc - cnt;
        for (int w2 = 0; w2 < wave; ++w2) before += wtot[w2];
        unsigned gtr = before & 0xFFFFu, eqr = before >> 16;
#pragma unroll
        for (int i = 0; i < 16; ++i) {
            const int t = tid * 16 + i;
            const bool g = key[i] > thr, q = key[i] == thr;
            const bool s = g || (q && eqr < krem);
            const unsigned pos = gtr + (eqr < krem ? eqr : krem);
            if (s) { idx[prob * CAP + pos] = t; gate[prob * CAP + pos] = v[i]; }
            inv[(size_t)prob * 8192 + t] = s ? (int)pos : -1;
            gtr += g ? 1u : 0u; eqr += q ? 1u : 0u;
        }
        __syncthreads();
    }
}

__device__ __forceinline__ void ph_combine(const P& p) {
    const int tid = threadIdx.x, lane = tid & 63, wave = tid >> 6;
    const float* modv = WSP(float, OFF_MODV); const int* inv = WSP(int, OFF_INV); const bf16_t* Y = WSP(bf16_t, OFF_Y);
    const int stride = gridDim.x * NWAVE;
    int row = blockIdx.x * NWAVE + wave;
    int myinv = -1; float4 xv[4];
    if (row < MTOK) { myinv = lane < 16 ? inv[(size_t)((row >> 13) * 16 + lane) * 8192 + (row & 8191)] : -1;
#pragma unroll
        for (int j = 0; j < 4; ++j) xv[j] = *(const float4*)(p.out + (size_t)row * DM + 512 * (j >> 1) + 8 * lane + 4 * (j & 1)); }
    for (; row < MTOK; row += stride) {
        const int b = row >> 13;
        unsigned long long mask = __ballot(myinv >= 0);
        const int curinv = myinv; float4 xc[4];
#pragma unroll
        for (int j = 0; j < 4; ++j) xc[j] = xv[j];
        const int nrow = row + stride;
        if (nrow < MTOK) { myinv = lane < 16 ? inv[(size_t)((nrow >> 13) * 16 + lane) * 8192 + (nrow & 8191)] : -1;
#pragma unroll
            for (int j = 0; j < 4; ++j) xv[j] = *(const float4*)(p.out + (size_t)nrow * DM + 512 * (j >> 1) + 8 * lane + 4 * (j & 1)); }
        float acc[16];
#pragma unroll
        for (int i = 0; i < 16; ++i) acc[i] = 0.f;
        while (mask) {
            const int e = __ffsll((long long)mask) - 1; mask &= mask - 1;
            const int pos = __shfl(curinv, e);
            const bf16_t* yr = Y + ((size_t)(e * 2048 + b * 1024 + pos)) * DM;
            const uint4 u0 = *(const uint4*)(yr + 8 * lane), u1 = *(const uint4*)(yr + 512 + 8 * lane);
            acc[0] += bf2f(u0.x & 0xFFFFu); acc[1] += bf2f(u0.x >> 16); acc[2] += bf2f(u0.y & 0xFFFFu); acc[3] += bf2f(u0.y >> 16);
            acc[4] += bf2f(u0.z & 0xFFFFu); acc[5] += bf2f(u0.z >> 16); acc[6] += bf2f(u0.w & 0xFFFFu); acc[7] += bf2f(u0.w >> 16);
            acc[8] += bf2f(u1.x & 0xFFFFu); acc[9] += bf2f(u1.x >> 16); acc[10] += bf2f(u1.y & 0xFFFFu); acc[11] += bf2f(u1.y >> 16);
            acc[12] += bf2f(u1.z & 0xFFFFu); acc[13] += bf2f(u1.z >> 16); acc[14] += bf2f(u1.w & 0xFFFFu); acc[15] += bf2f(u1.w >> 16);
        }
        const float* g2 = modv + b * 6144 + 5120;
        float* orow = p.out + (size_t)row * DM;
#pragma unroll
        for (int j = 0; j < 4; ++j) {
            const int c0 = 512 * (j >> 1) + 8 * lane + 4 * (j & 1);
            const float4 gv = *(const float4*)(g2 + c0);
            float4 o; o.x = xc[j].x + gv.x * acc[4 * j]; o.y = xc[j].y + gv.y * acc[4 * j + 1]; o.z = xc[j].z + gv.z * acc[4 * j + 2]; o.w = xc[j].w + gv.w * acc[4 * j + 3];
            *(float4*)(orow + c0) = o;
        }
    }
}

namespace pg8 {
#define PG8_LAS __attribute__((address_space(3)))
typedef short bf16x8 __attribute__((ext_vector_type(8)));
typedef float f32x4 __attribute__((ext_vector_type(4)));
typedef unsigned u32x4 __attribute__((ext_vector_type(4)));
constexpr int BM = 256, BK = 64, HALF = 128, HTB = HALF * BK * 2, STAGE_BYTES = 8 * HTB;
__host__ __device__ __forceinline__ int lds_byte(int r, int c) { const int st = (r >> 4) * 2 + (c >> 5), rr = r & 15, cc = c & 31, ob = rr * 64 + cc * 2; return st * 1024 + (ob ^ (((ob >> 9) & 1) << 5)); }
__host__ __device__ __forceinline__ void stage_rc(int b, int& R, int& C) { const int st = b / 1024, sb = b % 1024, swz = sb ^ (((sb >> 9) & 1) << 5); R = (st >> 1) * 16 + swz / 64; C = (st & 1) * 32 + (swz % 64) / 2; }
__host__ __device__ __forceinline__ int perm32(int rho) { const int n = rho >> 4, i = rho & 15; return 8 * (i >> 2) + 4 * n + (i & 3); }
struct Unit { int pm, pn, am, bn, e; };
struct Gemm { const bf16_t* A; const bf16_t* Bt; int K; const int* idx; };
__device__ __forceinline__ unsigned cvt_pk_bf16(float lo, float hi) { unsigned r; asm volatile("v_cvt_pk_bf16_f32 %0, %1, %2" : "=v"(r) : "v"(lo), "v"(hi)); return r; }

template <class Epi, class Sched, bool GATHER, bool ALIGN_EPI, bool SP2>
__device__ __forceinline__ void gemm_phase(PG8_LAS unsigned char* lds, const Gemm g, const Sched& S, const Epi& E) {
    const int tid = threadIdx.x, wid = __builtin_amdgcn_readfirstlane(tid >> 6), lane = tid & 63, wr = wid >> 2, wc = wid & 3, fr = lane & 15, fq = lane >> 4;
    const int K = g.K, nt = K / BK;
    unsigned voffA[2], voffB[2]; int Rr[2], Cc[2];
#pragma unroll
    for (int i = 0; i < 2; ++i) { int R, C; stage_rc(tid * 16 + i * 8192, R, C); const int Rb = Epi::PERM ? ((R & ~31) + perm32(R & 31)) : R;
        voffA[i] = (unsigned)(R * K + C) * 2u; voffB[i] = (unsigned)(Rb * K + C) * 2u; Rr[i] = R; Cc[i] = C; }
    const size_t kstep = (size_t)(BK * 2);
    const size_t hstep = (size_t)HALF * K * 2;
    const size_t tstep = 2 * hstep;
    const unsigned ldsw = (unsigned)wid * 1024u;
    const int aoff = lds_byte(wr * 64 + fr, fq * 8), boff = lds_byte(wc * 32 + fr, fq * 8);
    unsigned vg[2][2], nvg[2][2];
#define PG8_GV(dst, u) do { _Pragma("unroll") for (int h_ = 0; h_ < 2; ++h_) _Pragma("unroll") for (int i_ = 0; i_ < 2; ++i_) { const int m_ = (u).pm * 256 + h_ * 128 + Rr[i_]; const int b_ = m_ >> 10; \
        const int tok_ = g.idx[(b_ * 16 + (u).e) * 1024 + (m_ & 1023)]; dst[h_][i_] = (unsigned)((b_ * 8192 + tok_) * K + Cc[i_]) * 2u; } } while (0)
#define PG8_SA(b, h) (((b) * 2 + (h)) * HTB)
#define PG8_SB(b, h) ((4 + (b) * 2 + (h)) * HTB)
#define PG8_STAGE(bufoff, gbase, voff) do { _Pragma("unroll") for (int _i = 0; _i < 2; ++_i) \
        __builtin_amdgcn_global_load_lds((const unsigned*)((const char*)(gbase) + (voff)[_i]), (PG8_LAS unsigned*)(lds + (bufoff) + ldsw + _i * 8192), 16, 0, 0); } while (0)
#define PG8_STAGE_A(bufoff, kb, h, GV) do { if constexpr (GATHER) { PG8_STAGE(bufoff, kb, GV[h]); } else { PG8_STAGE(bufoff, (kb) + (h) * hstep, voffA); } } while (0)
#define PG8_LDA(dst, b, h) do { _Pragma("unroll") for (int m = 0; m < 4; ++m) _Pragma("unroll") for (int k = 0; k < 2; ++k) dst[m][k] = *(const PG8_LAS bf16x8*)(lds + PG8_SA(b, h) + aoff + m * 2048 + k * 1024); } while (0)
#define PG8_LDB(dst, b, h) do { _Pragma("unroll") for (int n = 0; n < 2; ++n) _Pragma("unroll") for (int k = 0; k < 2; ++k) dst[n][k] = *(const PG8_LAS bf16x8*)(lds + PG8_SB(b, h) + boff + n * 2048 + k * 1024); } while (0)
#define PG8_MMA(ai, bj, At, Bt) do { __builtin_amdgcn_s_setprio(1); _Pragma("unroll") for (int m = 0; m < 4; ++m) _Pragma("unroll") for (int n = 0; n < 2; ++n) _Pragma("unroll") for (int k = 0; k < 2; ++k) \
        acc[ai][bj][m][n] = __builtin_amdgcn_mfma_f32_16x16x32_bf16(Bt[n][k], At[m][k], acc[ai][bj][m][n], 0, 0, 0); __builtin_amdgcn_s_setprio(0); } while (0)
#define PG8_WAIT_V(n) asm volatile("s_waitcnt vmcnt(" #n ")" ::: "memory")
#define PG8_WAIT_L(n) asm volatile("s_waitcnt lgkmcnt(" #n ")" ::: "memory")
#define PG8_BAR __builtin_amdgcn_s_barrier()
#define PG8_SCHED __builtin_amdgcn_sched_barrier(0)
    Unit cur, nxt; int ui = 0;
    if (!S.next(0, cur)) return;
    f32x4 acc[2][2][4][2];
#pragma unroll
    for (int a = 0; a < 2; ++a)
#pragma unroll
        for (int b = 0; b < 2; ++b)
#pragma unroll
            for (int m = 0; m < 4; ++m)
#pragma unroll
                for (int n = 0; n < 2; ++n) acc[a][b][m][n] = (f32x4){0.f, 0.f, 0.f, 0.f};
    bf16x8 At[4][2], B0[2][2], B1[2][2];
    const char* cA = GATHER ? (const char*)g.A : (const char*)g.A + (size_t)cur.am * tstep; const char* cB = (const char*)g.Bt + (size_t)cur.bn * tstep;
    if constexpr (GATHER) { PG8_GV(vg, cur); }
    if constexpr (SP2) {
        PG8_STAGE(PG8_SB(0, 0), cB, voffB); PG8_STAGE(PG8_SB(0, 1), cB + hstep, voffB); PG8_STAGE_A(PG8_SA(0, 0), cA, 0, vg); PG8_STAGE_A(PG8_SA(0, 1), cA, 1, vg);
        if (wr == 1) PG8_BAR;
        PG8_WAIT_V(2); PG8_BAR;
        PG8_STAGE(PG8_SB(1, 0), cB + kstep, voffB); PG8_STAGE_A(PG8_SA(1, 0), cA + kstep, 0, vg); PG8_STAGE(PG8_SB(1, 1), cB + hstep + kstep, voffB);
        PG8_WAIT_V(6); PG8_BAR;
    } else {
        PG8_STAGE(PG8_SB(0, 0), cB, voffB); PG8_STAGE_A(PG8_SA(0, 0), cA, 0, vg); PG8_STAGE(PG8_SB(0, 1), cB + hstep, voffB); PG8_STAGE_A(PG8_SA(0, 1), cA, 1, vg);
        if (wr == 1) PG8_BAR;
        PG8_WAIT_V(4); PG8_BAR;
        PG8_STAGE(PG8_SB(1, 0), cB + kstep, voffB); PG8_STAGE_A(PG8_SA(1, 0), cA + kstep, 0, vg); PG8_STAGE(PG8_SB(1, 1), cB + hstep + kstep, voffB);
        PG8_WAIT_V(6); PG8_BAR;
    }
    for (;;) {
        const bool has_next = S.next(ui + 1, nxt);
        const char* nA = GATHER ? cA : (has_next ? (const char*)g.A + (size_t)nxt.am * tstep : cA); const char* nB = has_next ? (const char*)g.Bt + (size_t)nxt.bn * tstep : cB;
        if constexpr (GATHER) { if (has_next) { PG8_GV(nvg, nxt); } else { _Pragma("unroll") for (int h_ = 0; h_ < 2; ++h_) _Pragma("unroll") for (int i_ = 0; i_ < 2; ++i_) nvg[h_][i_] = vg[h_][i_]; } }
        for (int t = 0; t < nt; t += 2) {
            const bool last = (t == nt - 2);
            const char* a1 = cA + (size_t)(t + 1) * kstep;
            const char* a2 = last ? nA : cA + (size_t)(t + 2) * kstep; const char* b2 = last ? nB : cB + (size_t)(t + 2) * kstep;
            const char* a3 = a2 + kstep; const char* b3 = b2 + kstep;
            unsigned sv[2][2];
            if constexpr (GATHER) { _Pragma("unroll") for (int h_ = 0; h_ < 2; ++h_) _Pragma("unroll") for (int i_ = 0; i_ < 2; ++i_) sv[h_][i_] = last ? nvg[h_][i_] : vg[h_][i_]; }
            if constexpr (SP2) {
            PG8_LDB(B0, 0, 0); PG8_LDB(B1, 0, 1); PG8_SCHED; PG8_LDA(At, 0, 0); PG8_STAGE_A(PG8_SA(1, 1), a1, 1, vg);
            PG8_WAIT_V(8); PG8_WAIT_L(0); PG8_BAR; PG8_MMA(0, 0, At, B0); PG8_MMA(0, 1, At, B1); PG8_BAR; PG8_SCHED;
            PG8_LDA(At, 0, 1); PG8_STAGE(PG8_SB(0, 0), b2, voffB); PG8_STAGE(PG8_SB(0, 1), b2 + hstep, voffB); PG8_STAGE_A(PG8_SA(0, 0), a2, 0, sv);
            PG8_WAIT_V(8); PG8_WAIT_L(0); PG8_BAR; PG8_MMA(1, 0, At, B0); PG8_MMA(1, 1, At, B1); PG8_BAR; PG8_SCHED;
            PG8_LDB(B0, 1, 0); PG8_LDB(B1, 1, 1); PG8_SCHED; PG8_LDA(At, 1, 0); PG8_STAGE_A(PG8_SA(0, 1), a2, 1, sv);
            PG8_WAIT_V(8); PG8_WAIT_L(0); PG8_BAR; PG8_MMA(0, 0, At, B0); PG8_MMA(0, 1, At, B1); PG8_BAR; PG8_SCHED;
            PG8_LDA(At, 1, 1); PG8_STAGE(PG8_SB(1, 0), b3, voffB); PG8_STAGE(PG8_SB(1, 1), b3 + hstep, voffB); PG8_STAGE_A(PG8_SA(1, 0), a3, 0, sv);
            PG8_WAIT_V(8); PG8_WAIT_L(0); PG8_BAR; PG8_MMA(1, 0, At, B0); PG8_MMA(1, 1, At, B1); PG8_BAR; PG8_SCHED;
            } else {
            PG8_LDB(B0, 0, 0); PG8_SCHED; PG8_LDA(At, 0, 0); PG8_STAGE_A(PG8_SA(1, 1), a1, 1, vg);
            PG8_WAIT_L(8); PG8_BAR; PG8_WAIT_L(0); PG8_MMA(0, 0, At, B0); PG8_BAR; PG8_SCHED;
            PG8_LDB(B1, 0, 1); PG8_STAGE(PG8_SB(0, 0), b2, voffB);
            PG8_BAR; PG8_WAIT_L(0); PG8_MMA(0, 1, At, B1); PG8_BAR;
            PG8_LDA(At, 0, 1); PG8_STAGE_A(PG8_SA(0, 0), a2, 0, sv);
            PG8_BAR; PG8_WAIT_L(0); PG8_MMA(1, 0, At, B0); PG8_BAR; PG8_SCHED;
            PG8_STAGE(PG8_SB(0, 1), b2 + hstep, voffB);
            PG8_WAIT_V(6); PG8_BAR; PG8_MMA(1, 1, At, B1); PG8_BAR;
            PG8_LDB(B0, 1, 0); PG8_SCHED; PG8_LDA(At, 1, 0); PG8_STAGE_A(PG8_SA(0, 1), a2, 1, sv);
            PG8_WAIT_L(8); PG8_BAR; PG8_WAIT_L(0); PG8_MMA(0, 0, At, B0); PG8_BAR; PG8_SCHED;
            PG8_LDB(B1, 1, 1); PG8_STAGE(PG8_SB(1, 0), b3, voffB);
            PG8_BAR; PG8_WAIT_L(0); PG8_MMA(0, 1, At, B1); PG8_BAR;
            PG8_LDA(At, 1, 1); PG8_STAGE_A(PG8_SA(1, 0), a3, 0, sv);
            PG8_BAR; PG8_WAIT_L(0); PG8_MMA(1, 0, At, B0); PG8_BAR; PG8_SCHED;
            PG8_STAGE(PG8_SB(1, 1), b3 + hstep, voffB);
            PG8_WAIT_V(6); PG8_BAR; PG8_MMA(1, 1, At, B1); PG8_BAR;
            }
        }
        if constexpr (ALIGN_EPI) { if (wr == 0) PG8_BAR; }
        E(acc, cur, wr, wc, fr, fq);
        if (!has_next) break;
#pragma unroll
        for (int a = 0; a < 2; ++a)
#pragma unroll
            for (int b = 0; b < 2; ++b)
#pragma unroll
                for (int m = 0; m < 4; ++m)
#pragma unroll
                    for (int n = 0; n < 2; ++n) acc[a][b][m][n] = (f32x4){0.f, 0.f, 0.f, 0.f};
        cur = nxt; cA = nA; cB = nB; ++ui;
        if constexpr (GATHER) { _Pragma("unroll") for (int h_ = 0; h_ < 2; ++h_) _Pragma("unroll") for (int i_ = 0; i_ < 2; ++i_) vg[h_][i_] = nvg[h_][i_]; }
        if constexpr (ALIGN_EPI) { if (wr == 1) PG8_BAR; }
    }
    PG8_WAIT_V(0);
    if constexpr (!ALIGN_EPI) { if (wr == 0) PG8_BAR; }
    PG8_BAR;
#undef PG8_GV
#undef PG8_SA
#undef PG8_SB
#undef PG8_STAGE
#undef PG8_STAGE_A
#undef PG8_LDA
#undef PG8_LDB
#undef PG8_MMA
#undef PG8_WAIT_V
#undef PG8_WAIT_L
#undef PG8_BAR
#undef PG8_SCHED
}
}


struct SchedGrid {
    int nM, nN, nwg, G, c, extra, lo, hi;
    bool defer;
    __device__ void init(int nM_, int nN_, int G_, int c_, int extra_) { nM = nM_; nN = nN_; nwg = nM * nN; G = G_; c = c_; extra = extra_; defer = false; lo = 0; hi = nwg + extra; }
    __device__ bool next(int i, pg8::Unit& u) const {
        int L = i * G + c + lo; if (L >= hi) return false;
        if (defer) L = L < extra ? nwg + L : L - extra;
        if (L >= nwg) { u.pm = nM + (L - nwg); u.pn = 2; }
        else { int wgid = L; { const int q = nwg / 8, r = nwg % 8, xcd = wgid % 8, off = wgid / 8; wgid = (xcd < r ? xcd * (q + 1) : r * (q + 1) + (xcd - r) * q) + off; }
               const int nig = 8 * nN, gid = wgid / nig, fm = gid * 8, gsz = (nM - fm) < 8 ? (nM - fm) : 8;
               u.pm = fm + ((wgid % nig) % gsz); u.pn = (wgid % nig) / gsz; }
        u.am = u.pm; u.bn = u.pn; u.e = 0; return true;
    }
};
struct SchedGateUp {
    int G, c;
    __device__ bool next(int i, pg8::Unit& u) const {
        int bt, pm;
        if (G == 256) { if (i >= 11) return false; const int x = c & 7, s = c >> 3; bt = i * 32 + x * 4 + (s >> 3); pm = s & 7; }
        else { const int L = i * G + c; if (L >= 2816) return false; bt = L >> 3; pm = L & 7; }
        u.e = bt / 22; u.pn = bt % 22; u.pm = pm; u.am = 0; u.bn = bt; return true;
    }
};
struct SchedDown {
    int G, c;
    __device__ bool next(int i, pg8::Unit& u) const {
        if (G == 256) { if (i >= 2) return false; const int x = c & 7, s = c >> 3; u.e = i * 8 + x; u.pm = s & 7; u.pn = s >> 3; }
        else { const int L = i * G + c; if (L >= 512) return false; u.e = L >> 5; u.pm = L & 7; u.pn = (L >> 3) & 3; }
        u.am = u.e * 8 + u.pm; u.bn = u.e * 4 + u.pn; return true;
    }
};

using pg8::f32x4; using pg8::u32x4;
__device__ __forceinline__ u32x4 pack8(const f32x4& a, const f32x4& b) { u32x4 w; w.x = pg8::cvt_pk_bf16(a[0], a[1]); w.y = pg8::cvt_pk_bf16(a[2], a[3]); w.z = pg8::cvt_pk_bf16(b[0], b[1]); w.w = pg8::cvt_pk_bf16(b[2], b[3]); return w; }
struct EpiInproj {
    static constexpr bool PERM = true;
    bf16_t *Q, *Kb, *Vb; float* PT; const float *rope, *qng, *kng;
    __device__ __forceinline__ void operator()(const f32x4 (&acc)[2][2][4][2], const pg8::Unit& u, int wr, int wc, int fr, int fq) const {
        const int row0 = u.pm * 256 + wr * 64 + fr;
        if (u.pn >= 3) {
            const int colb = u.pn * 256 + wc * 32 + fq * 8 - 768;
#pragma unroll
            for (int ai = 0; ai < 2; ++ai)
#pragma unroll
                for (int m = 0; m < 4; ++m) { const int row = row0 + ai * 128 + m * 16;
#pragma unroll
                    for (int bj = 0; bj < 2; ++bj)
#pragma unroll
                        for (int n = 0; n < 2; ++n)
#pragma unroll
                            for (int e = 0; e < 4; ++e) PT[(size_t)(colb + bj * 128 + n * 4 + e) * MTOK + row] = acc[ai][bj][m][n][e]; }
        } else if (u.pn == 2 && wc >= 2) {
#pragma unroll
            for (int ai = 0; ai < 2; ++ai)
#pragma unroll
                for (int m = 0; m < 4; ++m) { const int row = row0 + ai * 128 + m * 16;
                    size_t kvrow; if (row < MTOK) kvrow = (size_t)(row >> 13) * LK + (row & 8191); else { const int j = row - MTOK; kvrow = (size_t)(j >> 8) * LK + SEQ + (j & 255); }
#pragma unroll
                    for (int bj = 0; bj < 2; ++bj) *(u32x4*)(Vb + kvrow * 128 + (wc - 2) * 64 + bj * 32 + fq * 8) = pack8(acc[ai][bj][m][0], acc[ai][bj][m][1]); }
        } else {
            const bool isq = u.pn < 2; const float* gn = isq ? qng : kng;
            f32x4 g[2][2];
#pragma unroll
            for (int bj = 0; bj < 2; ++bj)
#pragma unroll
                for (int n = 0; n < 2; ++n) g[bj][n] = *(const f32x4*)(gn + bj * 32 + n * 16 + fq * 4);
#pragma unroll
            for (int ai = 0; ai < 2; ++ai)
#pragma unroll
                for (int m = 0; m < 4; ++m) { const int row = row0 + ai * 128 + m * 16; const bool tok = row < MTOK; const int t = row & 8191;
                    float ss = 0.f;
#pragma unroll
                    for (int bj = 0; bj < 2; ++bj)
#pragma unroll
                        for (int n = 0; n < 2; ++n) { const f32x4 v = acc[ai][bj][m][n]; ss += v[0] * v[0] + v[1] * v[1] + v[2] * v[2] + v[3] * v[3]; }
                    ss += __shfl_xor(ss, 16); ss += __shfl_xor(ss, 32);
                    const float rstd = rsqrtf(ss * (1.0f / 64.0f) + EPS);
                    bf16_t* dst; if (isq) dst = Q + (size_t)row * 512 + (4 * u.pn + wc) * 64;
                    else { size_t kvrow; if (tok) kvrow = (size_t)(row >> 13) * LK + t; else { const int j = row - MTOK; kvrow = (size_t)(j >> 8) * LK + SEQ + (j & 255); } dst = Kb + kvrow * 128 + wc * 64; }
#pragma unroll
                    for (int bj = 0; bj < 2; ++bj) {
                        f32x4 x1 = acc[ai][bj][m][0] * rstd * g[bj][0], x2 = acc[ai][bj][m][1] * rstd * g[bj][1];
                        if (tok) { const int pos = bj == 0 ? (t >> 6) : (t & 63);
                            const f32x4 ra = *(const f32x4*)(rope + (pos * 16 + fq * 4) * 2), rb = *(const f32x4*)(rope + (pos * 16 + fq * 4) * 2 + 4);
                            const f32x4 cs = {ra[0], ra[2], rb[0], rb[2]}, sn = {ra[1], ra[3], rb[1], rb[3]};
                            const f32x4 o1 = x1 * cs - x2 * sn, o2 = x1 * sn + x2 * cs; x1 = o1; x2 = o2; }
                        if (isq) { x1 = x1 * C2; x2 = x2 * C2; }
                        *(u32x4*)(dst + bj * 32 + fq * 8) = pack8(x1, x2);
                    } }
        }
    }
};
struct EpiOutproj {
    static constexpr bool PERM = false;
    const float* x; const float* modv; float* out;
    __device__ __forceinline__ void operator()(const f32x4 (&acc)[2][2][4][2], const pg8::Unit& u, int wr, int wc, int fr, int fq) const {
#pragma unroll
        for (int ai = 0; ai < 2; ++ai)
#pragma unroll
            for (int m = 0; m < 4; ++m) { const int row = u.pm * 256 + ai * 128 + wr * 64 + m * 16 + fr; const float* g1 = modv + (row >> 13) * 6144 + 2048;
#pragma unroll
                for (int bj = 0; bj < 2; ++bj)
#pragma unroll
                    for (int n = 0; n < 2; ++n) { const int col = u.pn * 256 + bj * 128 + wc * 32 + n * 16 + fq * 4;
                        const f32x4 xv = *(const f32x4*)(x + (size_t)row * DM + col), gv = *(const f32x4*)(g1 + col);
                        *(f32x4*)(out + (size_t)row * DM + col) = xv + gv * acc[ai][bj][m][n]; } }
    }
};
struct EpiGateUp {
    static constexpr bool PERM = true;
    bf16_t* H;
    __device__ __forceinline__ void operator()(const f32x4 (&acc)[2][2][4][2], const pg8::Unit& u, int wr, int wc, int fr, int fq) const {
#pragma unroll
        for (int ai = 0; ai < 2; ++ai)
#pragma unroll
            for (int m = 0; m < 4; ++m) { const int row = u.pm * 256 + ai * 128 + wr * 64 + m * 16 + fr;
                f32x4 o[2];
#pragma unroll
                for (int n = 0; n < 2; ++n)
#pragma unroll
                    for (int e = 0; e < 4; ++e) { const float gv = acc[ai][0][m][n][e]; o[n][e] = gv * __builtin_amdgcn_rcpf(1.0f + __builtin_amdgcn_exp2f(-1.4426950408889634f * gv)) * acc[ai][1][m][n][e]; }
                *(u32x4*)(H + ((size_t)(u.e * 2048 + row)) * DEXP_P + u.pn * 128 + wc * 32 + fq * 8) = pack8(o[0], o[1]); }
    }
};
struct EpiDown {
    static constexpr bool PERM = true;
    bf16_t* Y; const float* gate;
    __device__ __forceinline__ void operator()(const f32x4 (&acc)[2][2][4][2], const pg8::Unit& u, int wr, int wc, int fr, int fq) const {
#pragma unroll
        for (int ai = 0; ai < 2; ++ai)
#pragma unroll
            for (int m = 0; m < 4; ++m) { const int row = u.pm * 256 + ai * 128 + wr * 64 + m * 16 + fr;
                const float gt = gate[((row >> 10) * 16 + u.e) * CAP + (row & 1023)];
#pragma unroll
                for (int bj = 0; bj < 2; ++bj)
                    *(u32x4*)(Y + ((size_t)(u.e * 2048 + row)) * DM + u.pn * 256 + bj * 128 + wc * 32 + fq * 8) = pack8(acc[ai][bj][m][0] * gt, acc[ai][bj][m][1] * gt); }
    }
};

__device__ __forceinline__ int win_src_col(int g) {
    const int pn = g >> 8;
    if (pn >= 3) return g;
    const int bj = (g >> 7) & 1, wc = (g >> 5) & 3, ci = g & 31, fq = ci >> 3, n = (ci >> 2) & 1, j = ci & 3;
    const int dim = bj * 32 + n * 16 + fq * 4 + j;
    if (pn < 2) return (4 * pn + wc) * 64 + dim;
    if (wc < 2) return 512 + wc * 64 + dim;
    return 640 + (wc - 2) * 64 + bj * 32 + ci;
}
struct CvtItem { const float* src; bf16_t* dst; size_t ldn, ldk; };
__device__ __forceinline__ void cvt_load(const CvtItem& c, float4 (&v)[16], int lane) {
    const int kq = lane >> 4, n4 = 4 * (lane & 15);
#pragma unroll
    for (int i = 0; i < 16; ++i) v[i] = *(const float4*)(c.src + (size_t)(4 * i + kq) * c.ldn + n4);
}
__device__ __forceinline__ void cvt_store_rows(bf16_t* dst, size_t ldk, const float* scr, int lane) {
    const int c = lane >> 3, np = lane & 7;
#pragma unroll
    for (int j = 0; j < 8; ++j) { const int n = np + 8 * j; const float* sp = scr + (8 * c) * 65 + n;
        uint4 o; o.x = hw_pk2(sp[0], sp[65]); o.y = hw_pk2(sp[2 * 65], sp[3 * 65]); o.z = hw_pk2(sp[4 * 65], sp[5 * 65]); o.w = hw_pk2(sp[6 * 65], sp[7 * 65]);
        *(uint4*)(dst + (size_t)n * ldk + 8 * c) = o; }
    asm volatile("s_waitcnt lgkmcnt(0)" ::: "memory");
}
__device__ __forceinline__ void cvt_finish(const CvtItem& c, const float4 (&v)[16], float* scr, int lane) {
    const int kq = lane >> 4, n4 = 4 * (lane & 15);
#pragma unroll
    for (int i = 0; i < 16; ++i) { float* d = scr + (4 * i + kq) * 65 + n4; d[0] = v[i].x; d[1] = v[i].y; d[2] = v[i].z; d[3] = v[i].w; }
    asm volatile("s_waitcnt lgkmcnt(0)" ::: "memory");
    cvt_store_rows(c.dst, c.ldk, scr, lane);
}
constexpr int CV_IG = 16 * 16 * 43, CV_ID = 16 * 43 * 16, CV_IO = 16 * 16, CV_II = 16 * 36, CV_NF = 2 * CV_IG + CV_ID + CV_IO;
__device__ __forceinline__ CvtItem cvt_decode(const P& p, int r) {
    CvtItem c;
    if (r < 2 * CV_IG) { const int up = r >= CV_IG; if (up) r -= CV_IG; const int e = r / (16 * 43), q = r % (16 * 43), kb = q / 43, nb = q % 43;
        c.src = (up ? p.w_up : p.w_gate) + (size_t)e * DM * DEXP + (size_t)(kb * 64) * DEXP + nb * 64; c.ldn = DEXP;
        c.dst = WSP(bf16_t, OFF_WGU) + ((size_t)e * 5632 + (nb >> 1) * 256 + up * 128 + (nb & 1) * 64) * DM + kb * 64; c.ldk = DM; return c; }
    r -= 2 * CV_IG;
    if (r < CV_ID) { const int e = r / (43 * 16), q = r % (43 * 16), kb = q / 16, nb = q % 16;
        c.src = p.w_down + (size_t)e * DEXP * DM + (size_t)(kb * 64) * DM + nb * 64; c.ldn = DM;
        c.dst = WSP(bf16_t, OFF_WD) + ((size_t)e * 1024 + nb * 64) * DEXP_P + kb * 64; c.ldk = DEXP_P; return c; }
    r -= CV_ID;
    { const int kb = r / 16, nb = r % 16; c.src = p.w_out + (size_t)(kb * 64) * DM + nb * 64; c.ldn = DM; c.dst = WSP(bf16_t, OFF_WOUT) + (size_t)(nb * 64) * DM + kb * 64; c.ldk = DM; }
    return c;
}
constexpr int CV_NMOE = 2 * CV_IG + CV_ID;
__device__ __forceinline__ void cvt_span(const P& p, unsigned char* lds, int it0, int it1) {
    int tidl = threadIdx.x; asm volatile("" : "+v"(tidl));
    const int lane = tidl & 63, wave = tidl >> 6;
    float* scr = (float*)lds + wave * (64 * 65);
    float4 va[16], vb[16]; CvtItem ca, cb;
    int v = it0 + wave;
    if (v < it1) { ca = cvt_decode(p, v); cvt_load(ca, va, lane); }
#pragma unroll 1
    while (v < it1) {
        const int v1 = v + NWAVE;
        if (v1 < it1) { cb = cvt_decode(p, v1); cvt_load(cb, vb, lane); }
        cvt_finish(ca, va, scr, lane);
        if (v1 >= it1) break;
        const int v2 = v1 + NWAVE;
        if (v2 < it1) { ca = cvt_decode(p, v2); cvt_load(ca, va, lane); }
        cvt_finish(cb, vb, scr, lane);
        v = v2;
    }
}
__device__ __forceinline__ void cvt_win(const P& p, unsigned char* lds) {
    const int lane = threadIdx.x & 63, wave = threadIdx.x >> 6;
    float* scr = (float*)lds + wave * (64 * 65);
    bf16_t* win = WSP(bf16_t, OFF_WIN);
    for (int r = blockIdx.x * NWAVE + wave; r < CV_II; r += gridDim.x * NWAVE) {
        const int kb = r / 36, nb = r % 36, sc = win_src_col(nb * 64 + lane);
#pragma unroll 16
        for (int k = 0; k < 64; ++k) scr[k * 65 + lane] = p.w_in[(size_t)(kb * 64 + k) * INW + sc];
        asm volatile("s_waitcnt lgkmcnt(0)" ::: "memory");
        cvt_store_rows(win + (size_t)(nb * 64) * DM + kb * 64, DM, scr, lane);
    }
}
__device__ __forceinline__ void zero_wgu_pad(const P& p, int bl, int nbl) {
    bf16_t* wgu = WSP(bf16_t, OFF_WGU); const uint4 z = {0u, 0u, 0u, 0u};
    for (int i = bl * NTHR + threadIdx.x; i < 16 * 128 * 128; i += nbl * NTHR) {
        const int e = i >> 14, rr = (i >> 7) & 127, ch = i & 127, row = 21 * 256 + (rr < 64 ? 64 + rr : 192 + (rr - 64));
        *(uint4*)(wgu + ((size_t)e * 5632 + row) * DM + ch * 8) = z; }
}
__device__ __forceinline__ void zero_wd_pad(const P& p, int bl, int nbl) {
    bf16_t* wd = WSP(bf16_t, OFF_WD); const uint4 z = {0u, 0u, 0u, 0u};
    for (int i = bl * NTHR + threadIdx.x; i < 16 * 1024 * 8; i += nbl * NTHR) *(uint4*)(wd + (size_t)(i >> 3) * DEXP_P + DEXP + (i & 7) * 8) = z;
}

#define PG8_SP2 true
__device__ __forceinline__ void ph_inproj(const P& p, unsigned char* lds) {
    pg8::Gemm g{WSP(bf16_t, OFF_XN), WSP(bf16_t, OFF_WIN), DM, nullptr};
    SchedGrid S; S.init(64, 9, gridDim.x, blockIdx.x, 2);
    if (gridDim.x == 256) { S.defer = true; S.lo = 0; S.hi = 512; }
    EpiInproj E{WSP(bf16_t, OFF_Q), WSP(bf16_t, OFF_K), WSP(bf16_t, OFF_V), WSP(float, OFF_PT), WSP(float, OFF_ROPE), p.qng, p.kng};
    pg8::gemm_phase<EpiInproj, SchedGrid, false, true, PG8_SP2>((PG8_LAS unsigned char*)lds, g, S, E);
}
constexpr int NDEFER = 66;
__device__ __forceinline__ void ph_inproj_deferred(const P& p, unsigned char* lds, int di) {
    pg8::Gemm g{WSP(bf16_t, OFF_XN), WSP(bf16_t, OFF_WIN), DM, nullptr};
    SchedGrid S; S.init(64, 9, 1 << 20, 0, 2); S.defer = true; S.lo = 512 + di; S.hi = 513 + di;
    EpiInproj E{WSP(bf16_t, OFF_Q), WSP(bf16_t, OFF_K), WSP(bf16_t, OFF_V), WSP(float, OFF_PT), WSP(float, OFF_ROPE), p.qng, p.kng};
    pg8::gemm_phase<EpiInproj, SchedGrid, false, true, PG8_SP2>((PG8_LAS unsigned char*)lds, g, S, E);
}
__device__ __forceinline__ void ph_outproj(const P& p, unsigned char* lds) {
    pg8::Gemm g{WSP(bf16_t, OFF_AO), WSP(bf16_t, OFF_WOUT), DM, nullptr};
    SchedGrid S; S.init(64, 4, gridDim.x, blockIdx.x, 0);
    EpiOutproj E{p.x, WSP(float, OFF_MODV), p.out};
    pg8::gemm_phase<EpiOutproj, SchedGrid, false, true, PG8_SP2>((PG8_LAS unsigned char*)lds, g, S, E);
}
__device__ __forceinline__ void ph_gateup(const P& p, unsigned char* lds) {
    pg8::Gemm g{WSP(bf16_t, OFF_XN2), WSP(bf16_t, OFF_WGU), DM, WSP(int, OFF_IDX)};
    SchedGateUp S{(int)gridDim.x, (int)blockIdx.x};
    EpiGateUp E{WSP(bf16_t, OFF_H)};
    pg8::gemm_phase<EpiGateUp, SchedGateUp, true, true, PG8_SP2>((PG8_LAS unsigned char*)lds, g, S, E);
}
__device__ __forceinline__ void ph_down(const P& p, unsigned char* lds) {
    pg8::Gemm g{WSP(bf16_t, OFF_H), WSP(bf16_t, OFF_WD), DEXP_P, nullptr};
    SchedDown S{(int)gridDim.x, (int)blockIdx.x};
    EpiDown E{WSP(bf16_t, OFF_Y), WSP(float, OFF_GATE)};
    pg8::gemm_phase<EpiDown, SchedDown, false, true, PG8_SP2>((PG8_LAS unsigned char*)lds, g, S, E);
}


namespace attn_body {
using bf16x8 = __attribute__((ext_vector_type(8))) short;
using s16x4 = __attribute__((ext_vector_type(4))) short;
using f32x16 = __attribute__((ext_vector_type(16))) float;
using u32x4 = __attribute__((ext_vector_type(4))) unsigned;
constexpr int D = 64, QP = 512, KP = 128, OP = 1024;
constexpr int NW = 8, QBLK = 32, QB = QBLK * NW, KVBLK = 64;
__device__ __forceinline__ int crow(int r, int hi) { return (r & 3) + 8 * (r >> 2) + 4 * hi; }
#define SBAR() __builtin_amdgcn_sched_barrier(0)
constexpr int NSLOT = 3, SLOTB = 8192;
constexpr int LDS_K = 0, LDS_V = NSLOT * SLOTB, LDS_WS = 2 * NSLOT * SLOTB, LDS_OST = LDS_WS + NW * 64 * 4, ATTN_LDS_BYTES = LDS_OST + NW * 4096;
__device__ __forceinline__ void glds16(const void* gsrc, unsigned lds_dst) { unsigned keep;
    asm volatile("s_mov_b32 %0, m0\n\ts_mov_b32 m0, %2\n\ts_nop 0\n\tglobal_load_lds_dwordx4 %1, off\n\ts_mov_b32 m0, %0" : "=&s"(keep) : "v"(gsrc), "s"(lds_dst) : "memory"); }
__device__ __forceinline__ float max3f(float a, float b, float c) { float r; asm("v_max3_f32 %0, %1, %2, %3" : "=v"(r) : "v"(a), "v"(b), "v"(c)); return r; }
__device__ __forceinline__ float max2f(float a, float b) { float r; asm("v_max_f32_e32 %0, %1, %2" : "=v"(r) : "v"(a), "v"(b)); return r; }
__device__ __forceinline__ float fadd_s(float a, float b) { float r; asm("v_add_f32_e32 %0, %1, %2" : "=v"(r) : "v"(a), "v"(b)); return r; }
__device__ __forceinline__ float fsub_s(float a, float b) { float r; asm("v_sub_f32_e32 %0, %1, %2" : "=v"(r) : "v"(a), "v"(b)); return r; }
typedef float f32x2_t __attribute__((ext_vector_type(2))); typedef __bf16 bf16x2_t __attribute__((ext_vector_type(2)));
__device__ __forceinline__ unsigned cvtpk_s(float lo, float hi) { f32x2_t v = {lo, hi}; bf16x2_t b = __builtin_convertvector(v, bf16x2_t); return __builtin_bit_cast(unsigned, b); }
#define WAIT_BAR(N) asm volatile("s_waitcnt vmcnt(" #N ") lgkmcnt(0)\n\ts_barrier" ::: "memory")
__device__ __forceinline__ void qkt(f32x16& p0, f32x16& p1, const char* Kslot, const bf16x8* qr, const f32x16& negm, int r32, int hi) {
    const char* kb = Kslot + hi * 1024 + r32 * 16;
#pragma unroll
    for (int d0 = 0; d0 < 4; ++d0) {
        const bf16x8 b0 = *reinterpret_cast<const bf16x8*>(kb + d0 * 2048);
        const bf16x8 b1 = *reinterpret_cast<const bf16x8*>(kb + d0 * 2048 + 512);
        if (d0 == 0) { p0 = __builtin_amdgcn_mfma_f32_32x32x16_bf16(b0, qr[0], negm, 0, 0, 0); p1 = __builtin_amdgcn_mfma_f32_32x32x16_bf16(b1, qr[0], negm, 0, 0, 0); }
        else { p0 = __builtin_amdgcn_mfma_f32_32x32x16_bf16(b0, qr[d0], p0, 0, 0, 0); p1 = __builtin_amdgcn_mfma_f32_32x32x16_bf16(b1, qr[d0], p1, 0, 0, 0); } }
}
typedef __attribute__((address_space(3))) const char* lds_cptr;
typedef short v4i16_t __attribute__((ext_vector_type(4)));
__device__ __forceinline__ void kload8(bf16x8* kf, lds_cptr kp) {
    kf[0] = *(const __attribute__((address_space(3))) bf16x8*)(kp);        kf[1] = *(const __attribute__((address_space(3))) bf16x8*)(kp + 512);
    kf[2] = *(const __attribute__((address_space(3))) bf16x8*)(kp + 2048); kf[3] = *(const __attribute__((address_space(3))) bf16x8*)(kp + 2560);
    kf[4] = *(const __attribute__((address_space(3))) bf16x8*)(kp + 4096); kf[5] = *(const __attribute__((address_space(3))) bf16x8*)(kp + 4608);
    kf[6] = *(const __attribute__((address_space(3))) bf16x8*)(kp + 6144); kf[7] = *(const __attribute__((address_space(3))) bf16x8*)(kp + 6656);
}
__device__ __forceinline__ void kload2(bf16x8* kf, lds_cptr kp, int j) { kf[2 * j] = *(const __attribute__((address_space(3))) bf16x8*)(kp + j * 2048); kf[2 * j + 1] = *(const __attribute__((address_space(3))) bf16x8*)(kp + j * 2048 + 512); }
__device__ __forceinline__ s16x4 vtr(lds_cptr p) { return __builtin_bit_cast(s16x4, __builtin_amdgcn_ds_read_tr16_b64_v4i16((__attribute__((address_space(3))) v4i16_t*)p)); }
__device__ __forceinline__ float rowmax(const f32x16& p0, const f32x16& p1) {
    float a = max3f(p0[0], p0[1], p1[0]), b = max3f(p0[2], p0[3], p1[1]); a = max3f(a, p1[2], p1[3]);
#pragma unroll
    for (int r = 4; r < 16; r += 4) { a = max3f(a, p0[r], p0[r + 1]); b = max3f(b, p0[r + 2], p0[r + 3]); a = max3f(a, p1[r], p1[r + 1]); b = max3f(b, p1[r + 2], p1[r + 3]); }
    const float m = max2f(a, b);
    auto rr = __builtin_amdgcn_permlane32_swap(__float_as_uint(m), __float_as_uint(m), false, false);
    return max2f(__uint_as_float(rr[0]), __uint_as_float(rr[1]));
}
__device__ __forceinline__ void pv(f32x16* o, int vb, bf16x8 pa0, bf16x8 pa1, bf16x8 pa2, bf16x8 pa3) {
#pragma unroll
    for (int d0 = 0; d0 < 2; ++d0) { s16x4 lo[4], hi[4];
#pragma unroll
        for (int ks = 0; ks < 4; ++ks) {
            asm volatile("ds_read_b64_tr_b16 %0,%1 offset:%c2" : "=&v"(lo[ks]) : "v"(vb), "i"(d0 * 4096 + ks * 1024) : "memory");
            asm volatile("ds_read_b64_tr_b16 %0,%1 offset:%c2" : "=&v"(hi[ks]) : "v"(vb), "i"(d0 * 4096 + ks * 1024 + 512) : "memory"); }
        asm volatile("s_waitcnt lgkmcnt(0)" ::: "memory"); SBAR();
#define PK(k) (bf16x8){lo[k][0], lo[k][1], lo[k][2], lo[k][3], hi[k][0], hi[k][1], hi[k][2], hi[k][3]}
        o[d0] = __builtin_amdgcn_mfma_f32_32x32x16_bf16(pa0, PK(0), o[d0], 0, 0, 0);
        o[d0] = __builtin_amdgcn_mfma_f32_32x32x16_bf16(pa1, PK(1), o[d0], 0, 0, 0);
        o[d0] = __builtin_amdgcn_mfma_f32_32x32x16_bf16(pa2, PK(2), o[d0], 0, 0, 0);
        o[d0] = __builtin_amdgcn_mfma_f32_32x32x16_bf16(pa3, PK(3), o[d0], 0, 0, 0);
#undef PK
    }
}
template <int THRL> __device__ __forceinline__ void attn_unit(int b, int h, int qb, const bf16_t* Q, const bf16_t* __restrict__ K, const bf16_t* __restrict__ V, bf16_t* O, char* shm) {
    const int tid = threadIdx.x, lane = tid & 63, r32 = lane & 31, hi = lane >> 5; const int wid = __builtin_amdgcn_readfirstlane(tid >> 6);
    const int q0 = qb * QB;
    const bf16_t* Qw = Q + ((long)b * SEQ + q0 + wid * QBLK) * QP + h * D;
    const bf16_t* Kh = K + (long)b * LK * KP + (h >> 2) * D, *Vh = V + (long)b * LK * KP + (h >> 2) * D;
    const unsigned lds0 = (unsigned)(uintptr_t)shm;
    float* wsf = (float*)(shm + LDS_WS) + wid * 64;
    const bf16_t* ksrc = Kh + (long)lane * KP + wid * 8;
    const bf16_t* vsrc = Vh + (long)(16 * (wid & 3) + (lane >> 2)) * KP + (wid >> 2) * 32 + (lane & 3) * 8;
    const unsigned kdst = lds0 + LDS_K + wid * 1024, vdst = lds0 + LDS_V + wid * 1024;
#define DMA_K(t, slot) glds16(ksrc + (long)(t) * KVBLK * KP, (unsigned)__builtin_amdgcn_readfirstlane(kdst + (slot)))
#define DMA_V(t, slot) glds16(vsrc + (long)(t) * KVBLK * KP, (unsigned)__builtin_amdgcn_readfirstlane(vdst + (slot)))
    const int vb0 = (int)(lds0 + LDS_V) + ((lane >> 4) & 1) * 32 + (lane & 3) * 8 + (4 * hi + ((lane & 15) >> 2)) * 64;
    const char* Kbase = shm + LDS_K; bf16x8 kf[8];
    const lds_cptr shm3 = (lds_cptr)shm; const lds_cptr kp0 = shm3 + LDS_K + hi * 1024 + r32 * 16; const lds_cptr vp0 = shm3 + LDS_V + ((lane >> 4) & 1) * 32 + (lane & 3) * 8 + (4 * hi + ((lane & 15) >> 2)) * 64;
    constexpr int NT = LK / KVBLK;
    DMA_K(0, 0); DMA_V(0, 0); DMA_K(1, SLOTB);
    bf16x8 qr[4];
#pragma unroll
    for (int d0 = 0; d0 < 4; ++d0) qr[d0] = *reinterpret_cast<const bf16x8*>(&Qw[(long)r32 * QP + d0 * 16 + hi * 8]);
    float mhat = 0.f, l_reg = 0.f; f32x16 o[2]; o[0] = f32x16{}; o[1] = f32x16{}; f32x16 negm = f32x16{}; asm volatile("" : "+v"(negm));
    bool resc = false;
#define START(P0, P1) do { const float rm = rowmax(P0, P1); resc = false; \
    { const float dl = rm; mhat = fadd_s(mhat, dl); \
      _Pragma("unroll") for (int r = 0; r < 16; ++r) { P0[r] = fsub_s(P0[r], dl); P1[r] = fsub_s(P1[r], dl); } \
      _Pragma("unroll") for (int r = 0; r < 16; ++r) negm[r] = -mhat; asm volatile("" : "+v"(negm)); } \
    _Pragma("unroll") for (int r = 0; r < 16; ++r) P0[r] = __builtin_amdgcn_exp2f(P0[r]); } while (0)
#define RESC() do { if (resc) { asm volatile("s_waitcnt lgkmcnt(0)" ::: "memory"); \
      _Pragma("unroll") for (int d_ = 0; d_ < 2; ++d_) _Pragma("unroll") for (int r = 0; r < 16; ++r) o[d_][r] *= wsf[crow(r, hi)]; } } while (0)
    f32x16 pA0, pA1, pB0, pB1;
    int sl_prev = 0, sl_cur = 0, sl_next = SLOTB;
#define ROT() do { sl_prev = sl_cur; sl_cur = sl_next; sl_next = (sl_next == (NSLOT - 1) * SLOTB) ? 0 : sl_next + SLOTB; } while (0)
    DMA_K(2, 2 * SLOTB);
    WAIT_BAR(3);
    qkt(pA0, pA1, Kbase, qr, negm, r32, hi); asm volatile("s_nop 15\n\ts_nop 7" : "+v"(pA0), "+v"(pA1));
    START(pA0, pA1);
    _Pragma("unroll") for (int r = 0; r < 16; ++r) pA1[r] = __builtin_amdgcn_exp2f(pA1[r]);
    WAIT_BAR(0);
    DMA_K(3, 0); DMA_V(1, SLOTB);
    ROT();
    kload8(kf, kp0 + sl_cur);
    WAIT_BAR(2);
    s16x4 vlo[8], vhi[8]; u32x4 pw0, pw1, pw2, pw3;
#define PKW(P, B) cvtpk_s(P[B], P[B + 1])
#define PAF(k) __builtin_bit_cast(bf16x8, pw##k)
#define VFR(i) (bf16x8){vlo[i][0], vlo[i][1], vlo[i][2], vlo[i][3], vhi[i][0], vhi[i][1], vhi[i][2], vhi[i][3]}
#define PIN(x) asm volatile("" : "+v"(x))
#define MX3(a, b, c) __builtin_fmaxf(__builtin_fmaxf((a), (b)), (c))
#define GAPA(MF, A0, A1, A2, A3, W0, W1, PW) do { MF; sacc += A0; sacc += A1; sacc += A2; sacc += A3; PIN(sacc); W0; W1; PIN(PW); SBAR(); } while (0)
#define EX(v) __builtin_amdgcn_exp2f(v)
#define GAPB(MF, X, B) do { MF; X[B] = EX(X[B]); X[B + 1] = EX(X[B + 1]); X[B + 2] = EX(X[B + 2]); X[B + 3] = EX(X[B + 3]); PIN(X); SBAR(); } while (0)
#define VRD(i) do { vlo[i] = vtr(vp_ + (((i) >> 2) * 4096 + ((i) & 3) * 1024)); vhi[i] = vtr(vp_ + (((i) >> 2) * 4096 + ((i) & 3) * 1024 + 512)); } while (0)
#define KRD(G, j) do { if (G) { kload2(kf, kp0 + sl_next, j); SBAR(); } } while (0)
#define STEP(C0, C1, P0, P1, t, GK, GV, GL) do { SBAR(); \
    const lds_cptr vp_ = vp0 + sl_prev; \
    VRD(0); SBAR(); float sacc = (P0[0] + P0[1]); \
    GAPA(C0 = __builtin_amdgcn_mfma_f32_32x32x16_bf16(kf[0], qr[0], negm, 0, 0, 0), P0[2], P0[3], P0[4], P0[5],     pw0[0] = PKW(P0, 0), pw0[1] = PKW(P0, 2), pw0); \
    VRD(4); SBAR(); GAPA(C1 = __builtin_amdgcn_mfma_f32_32x32x16_bf16(kf[1], qr[0], negm, 0, 0, 0), P0[6], P0[7], P0[8], P0[9],     pw0[2] = PKW(P0, 4), pw0[3] = PKW(P0, 6), pw0); \
    VRD(1); SBAR(); GAPA(C0 = __builtin_amdgcn_mfma_f32_32x32x16_bf16(kf[2], qr[1], C0, 0, 0, 0),   P0[10], P0[11], P0[12], P0[13], pw1[0] = PKW(P0, 8), pw1[1] = PKW(P0, 10), pw1); \
    VRD(5); SBAR(); GAPA(C1 = __builtin_amdgcn_mfma_f32_32x32x16_bf16(kf[3], qr[1], C1, 0, 0, 0),   P0[14], P0[15], P1[0], P1[1],   pw1[2] = PKW(P0, 12), pw1[3] = PKW(P0, 14), pw1); \
    VRD(2); SBAR(); GAPA(C0 = __builtin_amdgcn_mfma_f32_32x32x16_bf16(kf[4], qr[2], C0, 0, 0, 0),   P1[2], P1[3], P1[4], P1[5],     pw2[0] = PKW(P1, 0), pw2[1] = PKW(P1, 2), pw2); \
    VRD(6); SBAR(); GAPA(C1 = __builtin_amdgcn_mfma_f32_32x32x16_bf16(kf[5], qr[2], C1, 0, 0, 0),   P1[6], P1[7], P1[8], P1[9],     pw2[2] = PKW(P1, 4), pw2[3] = PKW(P1, 6), pw2); \
    VRD(3); SBAR(); GAPA(C0 = __builtin_amdgcn_mfma_f32_32x32x16_bf16(kf[6], qr[3], C0, 0, 0, 0),   P1[10], P1[11], P1[12], P1[13], pw3[0] = PKW(P1, 8), pw3[1] = PKW(P1, 10), pw3); \
    VRD(7); SBAR(); GAPA(C1 = __builtin_amdgcn_mfma_f32_32x32x16_bf16(kf[7], qr[3], C1, 0, 0, 0),   P1[14], P1[15], 0.f, 0.f,       pw3[2] = PKW(P1, 12), pw3[3] = PKW(P1, 14), pw3); \
    l_reg += sacc; \
    if (GK) { DMA_K((t) + 3, sl_cur); } if (GV) { DMA_V((t) + 1, sl_next); } \
    { float a = MX3(C0[0], C0[1], C1[0]), b = MX3(C0[2], C0[3], C1[1]); a = MX3(a, C1[2], C1[3]); \
      _Pragma("unroll") for (int r = 4; r < 16; r += 4) { a = MX3(a, C0[r], C0[r + 1]); b = MX3(b, C0[r + 2], C0[r + 3]); a = MX3(a, C1[r], C1[r + 1]); b = MX3(b, C1[r + 2], C1[r + 3]); } \
      float rm = __builtin_fmaxf(a, b); { auto rr = __builtin_amdgcn_permlane32_swap(__float_as_uint(rm), __float_as_uint(rm), false, false); rm = __builtin_fmaxf(__uint_as_float(rr[0]), __uint_as_float(rr[1])); } \
      resc = false; \
      if (__builtin_expect(__any(rm > (float)THRL), 0)) { const float dl = __builtin_fmaxf(rm, 0.f); mhat += dl; \
        _Pragma("unroll") for (int r = 0; r < 16; ++r) { C0[r] -= dl; C1[r] -= dl; } \
        _Pragma("unroll") for (int r = 0; r < 16; ++r) negm[r] = -mhat; asm volatile("" : "+v"(negm)); \
        const float f = __builtin_amdgcn_exp2f(-dl); l_reg *= f; if (hi == 0) wsf[r32] = f; resc = true; } } \
    SBAR(); \
    GAPB(o[0] = __builtin_amdgcn_mfma_f32_32x32x16_bf16(PAF(0), VFR(0), o[0], 0, 0, 0), C0, 0); \
    GAPB(o[1] = __builtin_amdgcn_mfma_f32_32x32x16_bf16(PAF(0), VFR(4), o[1], 0, 0, 0), C0, 4); \
    KRD(GL, 0); GAPB(o[0] = __builtin_amdgcn_mfma_f32_32x32x16_bf16(PAF(1), VFR(1), o[0], 0, 0, 0), C0, 8); \
    KRD(GL, 1); GAPB(o[1] = __builtin_amdgcn_mfma_f32_32x32x16_bf16(PAF(1), VFR(5), o[1], 0, 0, 0), C0, 12); \
    KRD(GL, 2); GAPB(o[0] = __builtin_amdgcn_mfma_f32_32x32x16_bf16(PAF(2), VFR(2), o[0], 0, 0, 0), C1, 0); \
    KRD(GL, 3); GAPB(o[1] = __builtin_amdgcn_mfma_f32_32x32x16_bf16(PAF(2), VFR(6), o[1], 0, 0, 0), C1, 4); \
    GAPB(o[0] = __builtin_amdgcn_mfma_f32_32x32x16_bf16(PAF(3), VFR(3), o[0], 0, 0, 0), C1, 8); \
    GAPB(o[1] = __builtin_amdgcn_mfma_f32_32x32x16_bf16(PAF(3), VFR(7), o[1], 0, 0, 0), C1, 12); \
    } while (0)
    int t = 1;
    for (; t + 5 < NT; t += 2) {
        STEP(pB0, pB1, pA0, pA1, t, true, true, true);     WAIT_BAR(2); RESC(); ROT();
        STEP(pA0, pA1, pB0, pB1, t + 1, true, true, true); WAIT_BAR(2); RESC(); ROT();
    }
#define ENDW(tt) do { if ((tt) + 3 < NT) { WAIT_BAR(2); } else if ((tt) + 2 < NT) { WAIT_BAR(1); } else { WAIT_BAR(0); } } while (0)
    for (; t + 1 < NT; t += 2) {
        STEP(pB0, pB1, pA0, pA1, t, (t + 3 < NT), (t + 1 < NT), (t + 1 < NT));         ENDW(t);     RESC(); ROT();
        STEP(pA0, pA1, pB0, pB1, t + 1, (t + 4 < NT), (t + 2 < NT), (t + 2 < NT));     ENDW(t + 1); RESC(); ROT();
    }
    STEP(pB0, pB1, pA0, pA1, NT - 1, false, false, false); RESC();
    { float sacc = pB0[0] + pB0[1]; _Pragma("unroll") for (int r = 2; r < 16; ++r) sacc += pB0[r]; _Pragma("unroll") for (int r = 0; r < 16; ++r) sacc += pB1[r]; l_reg += sacc;
      pw0 = (u32x4){PKW(pB0, 0), PKW(pB0, 2), PKW(pB0, 4), PKW(pB0, 6)}; pw1 = (u32x4){PKW(pB0, 8), PKW(pB0, 10), PKW(pB0, 12), PKW(pB0, 14)}; pw2 = (u32x4){PKW(pB1, 0), PKW(pB1, 2), PKW(pB1, 4), PKW(pB1, 6)}; pw3 = (u32x4){PKW(pB1, 8), PKW(pB1, 10), PKW(pB1, 12), PKW(pB1, 14)};
      SBAR(); pv(o, vb0 + sl_cur, PAF(0), PAF(1), PAF(2), PAF(3)); }
#undef PKW
#undef PAF
#undef VFR
#undef PIN
#undef MX3
#undef GAPA
#undef GAPB
#undef EX
#undef VRD
#undef KRD
#undef STEP
#undef ENDW
    { auto rr = __builtin_amdgcn_permlane32_swap(__float_as_uint(l_reg), __float_as_uint(l_reg), false, false); l_reg = __uint_as_float(rr[0]) + __uint_as_float(rr[1]); }
    if (hi == 0) wsf[32 + r32] = l_reg; asm volatile("s_waitcnt lgkmcnt(0)" ::: "memory");
    float rli[16];
#pragma unroll
    for (int r = 0; r < 16; ++r) rli[r] = __builtin_amdgcn_rcpf(wsf[32 + crow(r, hi)]);
    bf16_t* Ow = O + ((long)b * SEQ + q0 + wid * QBLK) * OP + h * D;
    { bf16_t* stg = (bf16_t*)(shm + LDS_OST) + wid * 2048;
#pragma unroll
      for (int r = 0; r < 16; ++r) { const int orow = crow(r, hi);
#pragma unroll
          for (int d0 = 0; d0 < 2; ++d0) stg[orow * 64 + d0 * 32 + r32] = (bf16_t)f2bf(o[d0][r] * rli[r]); }
      asm volatile("s_waitcnt lgkmcnt(0)" ::: "memory");
#pragma unroll
      for (int i = 0; i < 4; ++i) { const int row = i * 8 + (lane >> 3), ch = lane & 7; const u32x4 v = *(const u32x4*)(stg + row * 64 + ch * 8); *(u32x4*)(Ow + (long)row * OP + ch * 8) = v; } }
    asm volatile("s_waitcnt lgkmcnt(0)\n\ts_barrier" ::: "memory");
#undef DMA_K
#undef DMA_V
#undef START
#undef RESC
#undef ROT
}
#undef SBAR
#undef WAIT_BAR
}
__device__ __forceinline__ void ph_attn(const P& p, unsigned char* lds) {
    const int G = gridDim.x, bx = blockIdx.x;
    for (int i = 0;; ++i) {
        int b, h, qb;
        if (G == 256) { if (i >= 2) break; const int vcu = (bx & 7) * 32 + (bx >> 3), X = vcu >> 5, pi = X >> 1, u = (X & 1) * 64 + (vcu & 31) * 2 + i; b = pi >> 1; h = (pi & 1) * 4 + (u >> 5); qb = u & 31; }
        else { const int L = i * G + bx; if (L >= 512) break; b = L >> 8; h = (L >> 5) & 7; qb = L & 31; }
        attn_body::attn_unit<8>(b, h, qb, WSP(bf16_t, OFF_Q), WSP(bf16_t, OFF_K), WSP(bf16_t, OFF_V), WSP(bf16_t, OFF_AO), (char*)lds);
    }
}


#define LAS __attribute__((address_space(3)))
#define XB_TMO      128
#define XB_XCNT(j)  (256  + 64 * (j))
#define XB_XSUB(j)  (1280 + 64 * (j))
#define XB_XGEN(j)  (2304 + 64 * (j))
#define XB_TOP      3328
#define XB_TOPGEN   3392
#define XCD_BAR_WORDS 3456
#define XB_SPIN_CAP (1u << 18)
__device__ __forceinline__ unsigned xb_ld(unsigned* p)              { return __hip_atomic_load(p, __ATOMIC_RELAXED, __HIP_MEMORY_SCOPE_AGENT); }
__device__ __forceinline__ unsigned xb_add(unsigned* p, unsigned v) { return __hip_atomic_fetch_add(p, v, __ATOMIC_RELAXED, __HIP_MEMORY_SCOPE_AGENT); }
__device__ __forceinline__ unsigned xb_xcc_id() { return (unsigned)__builtin_amdgcn_s_getreg((3 << 11) | 20) & 0xFu; }
#define XB_SPIN(cond, bar) do { unsigned _sp = 0; while (cond) { __builtin_amdgcn_s_sleep(1); \
    if ((++_sp & 255u) == 0u) { if (xb_ld(&(bar)[XB_TMO])) break; if (_sp > XB_SPIN_CAP) { atomicAdd(&(bar)[XB_TMO], 1u); break; } } } } while (0)
struct XcdBarrier { unsigned* bar; unsigned x; volatile LAS unsigned* st; };
__device__ __forceinline__ XcdBarrier xcd_barrier_post(unsigned* bar, volatile LAS unsigned* st) {
    XcdBarrier b; b.bar = bar; b.x = xb_xcc_id(); b.st = st;
    if (threadIdx.x == 0) (void)xb_add(&bar[XB_XCNT(b.x)], 1u);
    return b;
}
__device__ __forceinline__ void xcd_barrier_complete(unsigned* bar, unsigned x, unsigned& nloc, unsigned& nx) {
    const unsigned G = gridDim.x * gridDim.y * gridDim.z;
    unsigned sum, cnt, mine, sp = 0u;
    for (;;) {
        sum = 0u; cnt = 0u; mine = 0u;
#pragma unroll
        for (unsigned j = 0; j < 16; ++j) { const unsigned c = xb_ld(&bar[XB_XCNT(j)]); sum += c; cnt += (c > 0u) ? 1u : 0u; mine = (j == x) ? c : mine; }
        if (sum == G) break;
        __builtin_amdgcn_s_sleep(1);
        if ((++sp & 255u) == 0u) { if (xb_ld(&bar[XB_TMO])) break; if (sp > XB_SPIN_CAP) { atomicAdd(&bar[XB_TMO], 1u); break; } }
    }
    nloc = mine > 0u ? mine : 1u; nx = cnt > 0u ? cnt : 1u;
}
__device__ __forceinline__ void xcd_barrier(const XcdBarrier& b) {
    asm volatile("s_waitcnt vmcnt(0)" ::: "memory");
    __syncthreads();
    if (threadIdx.x == 0) {
        unsigned* bar = b.bar;
        __builtin_amdgcn_s_waitcnt(0);
        unsigned nloc = b.st[0], nx = b.st[1];
        if (nloc == 0u) { xcd_barrier_complete(bar, b.x, nloc, nx); b.st[0] = nloc; b.st[1] = nx; }
        const unsigned old = xb_add(&bar[XB_XSUB(b.x)], 1u);
        const unsigned gen = old / nloc;
        if (old + 1u == (gen + 1u) * nloc) {
            __builtin_amdgcn_fence(__ATOMIC_RELEASE, "agent");
            asm volatile("s_waitcnt vmcnt(0)" ::: "memory");
            const unsigned og = xb_add(&bar[XB_TOP], 1u);
            const unsigned tg = og / nx;
            if (og + 1u == (tg + 1u) * nx) xb_add(&bar[XB_TOPGEN], 1u);
            else XB_SPIN(xb_ld(&bar[XB_TOPGEN]) == tg, bar);
            __builtin_amdgcn_fence(__ATOMIC_ACQUIRE, "agent");
            xb_add(&bar[XB_XGEN(b.x)], 1u);
            asm volatile("s_waitcnt vmcnt(0)" ::: "memory");
        } else {
            XB_SPIN(xb_ld(&bar[XB_XGEN(b.x)]) == gen, bar);
            __builtin_amdgcn_fence(__ATOMIC_ACQUIRE, "agent");
            asm volatile("s_waitcnt vmcnt(0)" ::: "memory");
        }
    }
    __syncthreads();
}
constexpr int CW_BAR = 4096;
constexpr int MISC_OFF = LDS_BYTES - 512;

enum { PH_P0 = 0, PH_P1, PH_INPROJ, PH_MIX, PH_HYT, PH_OUTPROJ, PH_ROUTER, PH_TOPK, PH_GATEUP, PH_DOWN, PH_COMBINE, PH_N };
__global__ void __launch_bounds__(NTHR, 2) k_phases(P p, int lo, int hi) {
    extern __shared__ __attribute__((aligned(16))) unsigned char lds[];
    volatile LAS unsigned* misc = (volatile LAS unsigned*)((LAS unsigned char*)lds + MISC_OFF);
    if (threadIdx.x < 16) misc[threadIdx.x] = 0u;
    __syncthreads();
    XcdBarrier bar; bar.bar = WSP(unsigned, OFF_CTL) + CW_BAR; bar.x = 0; bar.st = misc;
    if (hi - lo > 1) bar = xcd_barrier_post(WSP(unsigned, OFF_CTL) + CW_BAR, misc);
#define STAMP(i) do { if (PROBE_A >= 0 && threadIdx.x == 0) ((volatile LAS unsigned long long*)((LAS unsigned char*)lds + MISC_OFF + 64))[i] = __builtin_amdgcn_s_memrealtime(); } while (0)
    STAMP(0);
#define IN(k) (lo <= (k) && (k) < hi)
#define SEAM(k) do { if (IN(k) && IN((k) + 1)) xcd_barrier(bar); } while (0)
    if (IN(PH_P0)) DUP(PH_P0) { __syncthreads(); ph_mod(p, (float*)lds); __syncthreads(); ph_rope(p); ph_h2(p, (float*)lds); __syncthreads(); cvt_win(p, lds); { const int n0_ = CV_NMOE + (int)((long)CV_IO * blockIdx.x / gridDim.x), n1_ = CV_NMOE + (int)((long)CV_IO * (blockIdx.x + 1) / gridDim.x); cvt_span(p, lds, n0_, n1_); } }
    STAMP(1); SEAM(PH_P0); STAMP(2);
    if (IN(PH_P1)) DUP(PH_P1) { __syncthreads(); ph_xn(p); ph_ht(p, lds); }
    STAMP(3); SEAM(PH_P1); STAMP(4);
    if (IN(PH_INPROJ)) DUP(PH_INPROJ) { __syncthreads(); ph_inproj(p, lds);
    }
    STAMP(5); SEAM(PH_INPROJ); STAMP(6);
    if (IN(PH_MIX)) DUP(PH_MIX) { __syncthreads(); const int grp_ = blockIdx.x & 1;
        const int hb_ = blockIdx.x >> 1, nh_ = gridDim.x >> 1;
        unsigned* dctr_ = WSP(unsigned, OFF_CTL) + CW_BAR + 64;
        const bool has_def_ = gridDim.x == 256 && grp_ == 1 && hb_ < NDEFER;
        if (has_def_) {
            ph_inproj_deferred(p, lds, hb_);
            asm volatile("s_waitcnt vmcnt(0)" ::: "memory"); __syncthreads();
            if (threadIdx.x == 0) { __builtin_amdgcn_fence(__ATOMIC_RELEASE, "agent"); asm volatile("s_waitcnt vmcnt(0)" ::: "memory"); xb_add(dctr_, 1u); }
        }
        int cw0_, cw1_, cwt_;
        if (gridDim.x == 256) { constexpr int WA = 16, WB = 15, WC = 10; cwt_ = 128 * WA + NDEFER * WC + (128 - NDEFER) * WB;
            if (grp_ == 0) { cw0_ = WA * hb_; cw1_ = cw0_ + WA; } else if (hb_ < NDEFER) { cw0_ = 128 * WA + WC * hb_; cw1_ = cw0_ + WC; } else { cw0_ = 128 * WA + NDEFER * WC + WB * (hb_ - NDEFER); cw1_ = cw0_ + WB; } }
        else { cwt_ = gridDim.x; cw0_ = blockIdx.x; cw1_ = cw0_ + 1; }
        const int ci0_ = (int)((long)CV_NMOE * cw0_ / cwt_), ci1_ = (int)((long)CV_NMOE * cw1_ / cwt_);
        if (grp_ == 0) { cvt_span(p, lds, ci0_, ci1_); zero_wgu_pad(p, hb_, nh_); __syncthreads(); }
        STAMP(7); ph_attn(p, lds); __syncthreads(); STAMP(8);
        if (gridDim.x == 256) {
            if (threadIdx.x == 0) { unsigned sp_ = 0; while (xb_ld(dctr_) < (unsigned)NDEFER && ++sp_ < (1u << 22)) __builtin_amdgcn_s_sleep(2);
                __builtin_amdgcn_fence(__ATOMIC_ACQUIRE, "agent"); asm volatile("s_waitcnt vmcnt(0)" ::: "memory"); }
            __syncthreads();
        }
        if (grp_ == 1) { cvt_span(p, lds, ci0_, ci1_); zero_wd_pad(p, hb_, nh_); __syncthreads(); }
        ph_fft(p, lds); STAMP(9); }
    STAMP(10); SEAM(PH_MIX); STAMP(11);
    if (IN(PH_HYT)) DUP(PH_HYT) { __syncthreads(); ph_hyt(p, lds); }
    SEAM(PH_HYT); STAMP(12);
    if (IN(PH_OUTPROJ)) DUP(PH_OUTPROJ) { __syncthreads(); ph_outproj(p, lds); }
    SEAM(PH_OUTPROJ); STAMP(13);
    if (IN(PH_ROUTER)) DUP(PH_ROUTER) { __syncthreads(); ph_router(p, lds); }
    SEAM(PH_ROUTER); STAMP(14);
    if (IN(PH_TOPK)) DUP(PH_TOPK) { __syncthreads(); ph_topk(p, lds); }
    SEAM(PH_TOPK); STAMP(15);
    if (IN(PH_GATEUP)) DUP(PH_GATEUP) { __syncthreads(); ph_gateup(p, lds); }
    STAMP(16); SEAM(PH_GATEUP); STAMP(17);
    if (IN(PH_DOWN)) DUP(PH_DOWN) { __syncthreads(); ph_down(p, lds); }
    STAMP(18); SEAM(PH_DOWN); STAMP(19);
    if (IN(PH_COMBINE)) { ph_combine(p); }
    if (PROBE_A >= 0 && hi - lo > 1) {
        STAMP(20); xcd_barrier(bar);
        if ((int)blockIdx.x == PROBE_BLK && threadIdx.x == 0) { volatile LAS unsigned long long* st_ = (volatile LAS unsigned long long*)((LAS unsigned char*)lds + MISC_OFF + 64);
            const float us_ = (float)(long long)(st_[PROBE_B] - st_[PROBE_A]) * 0.01f; p.out[0] += us_ / PROBE_DIV; }
    }
    if (lo == PH_N) { ph_fft(p, lds); }
    if (lo == PH_N + 1) { ph_mod(p, (float*)lds); }
    if (lo == PH_N + 2) { ph_h2(p, (float*)lds); }

#undef IN
#undef SEAM
}

extern "C" void kernel_launch(void* const* d_in, const int* in_sizes, int n_in, void* d_out, int out_size, void* d_ws, size_t ws_size, hipStream_t stream) {
    static int init = 0;
    if (!init) {
        if (n_in != 25 || ws_size < WS_END) { fprintf(stderr, "kernel_launch: unexpected n_in %d / ws_size %zu\n", n_in, ws_size); init = -1; return; }
        if (hipFuncSetAttribute((const void*)k_phases, hipFuncAttributeMaxDynamicSharedMemorySize, LDS_BYTES) != hipSuccess) { fprintf(stderr, "hipFuncSetAttribute failed\n"); init = -1; return; }
        init = 1;
    }
    if (init < 0) return;
    P p{};
    const float** f = (const float**)&p.x;
    for (int i = 0; i < 25; ++i) f[i] = (const float*)d_in[i];
    p.out = (float*)d_out; p.ws = (unsigned char*)d_ws;
    for (int i = 0; i < 16; ++i) p.invf[i] = pow(10000.0, -(double)i / 16.0);
    (void)hipMemsetAsync((char*)d_ws + OFF_CTL + CW_BAR * 4, 0, XCD_BAR_WORDS * 4, stream);
    const int G = 256;
#define PHASES(lo, hi) hipLaunchKernelGGL(k_phases, dim3(G), dim3(NTHR), LDS_BYTES, stream, p, (lo), (hi))
#if ONE_LAUNCH
    PHASES(0, PH_N);
    if (EXTRA_PH >= 0) PHASES(EXTRA_PH, EXTRA_PH + 1);
#else
    for (int ph = 0; ph < PH_N; ++ph) PHASES(ph, ph + 1);
#endif
}
```
